# Optimizing an MI355X kernel written in HIP

```python
import jax, jax.numpy as jnp
from jax import lax
import numpy as np

D_MODEL = 1024
BATCH = 4
SEQ = 8192
DEPTH = 2

GRID_W = 64
CTX_LEN = 256
CHUNK = 64
EPS = 1e-6
ROPE_BASE = 10000.0

RET_HEADS = 4
RET_DK = 64
RET_DV = 128
MLSTM_HEADS = 4
MLSTM_DK = 64
MLSTM_DV = 128
HGRN_HEADS = 4
HGRN_DK = 128
HGRN_DV = 128
RWKV_HEADS = 8
RWKV_HD = 64
RWKV_W_RANK = 64
RWKV_A_RANK = 64
RWKV_G_RANK = 128
N_EXPERTS = 32
TOP_K = 4
D_FF = D_MODEL
SWIGLU_LIMIT = 7.0
SWIGLU_ALPHA = 1.702
MOE_BLOCK = 128

RET_QK = RET_HEADS * RET_DK
RET_W = RET_HEADS * RET_DV
ML_QK = MLSTM_HEADS * MLSTM_DK
ML_W = MLSTM_HEADS * MLSTM_DV
HG_K = HGRN_HEADS * HGRN_DK
HG_W = HGRN_HEADS * HGRN_DV
RW_W = RWKV_HEADS * RWKV_HD
AB_SPLITS = (RET_QK, RET_QK, RET_W, RET_W, 2 * ML_QK, ML_W, ML_W, 4 * MLSTM_HEADS)
RWKV_SPLITS = (RW_W, RW_W, RW_W, 2 * RWKV_W_RANK, 2 * RWKV_A_RANK, RWKV_G_RANK)
RWKV_IN = sum(RWKV_SPLITS)
CD_SPLITS = (HG_K, 2 * HG_K, HG_W, HG_W, RWKV_IN)
AB_IN = sum(AB_SPLITS)
CD_IN = sum(CD_SPLITS)
MIX_W_AB = RET_W + ML_W
MIX_W_CD = HG_W + RW_W
N_EVEN = (DEPTH + 1) // 2
N_ODD = DEPTH // 2
F32 = jnp.float32

kernel_name = 'hybrid_retnet_mlstm_hgrn2_rwkv7_moe_dit'


def _split(z, sizes):
    return jnp.split(z, [int(s) for s in np.cumsum(sizes)[:-1]], axis=-1)


def rms_norm(x, g):
    xf = x.astype(F32)
    y = xf * lax.rsqrt(jnp.mean(xf * xf, axis=-1, keepdims=True) + EPS)
    return (y * g.astype(F32)).astype(x.dtype)


def head_rms_norm(o, g):
    return o * lax.rsqrt(jnp.mean(o * o, axis=-1, keepdims=True) + EPS) * g.astype(F32)


def modulate(n, shift, scale):
    return n * (1.0 + scale[:, None]) + shift[:, None]


def dwconv3(x, w):
    xp = jnp.pad(x, ((0, 0), (1, 1), (0, 0)))
    return w[0] * xp[:, :-2] + w[1] * xp[:, 1:-1] + w[2] * xp[:, 2:]


def rope_tables(pos_r, pos_c):
    nf = RET_DK // 4
    inv = ROPE_BASE ** (-jnp.arange(nf, dtype=F32) / nf)
    ang = jnp.concatenate([pos_r[:, None] * inv, pos_c[:, None] * inv], axis=-1)
    return jnp.cos(ang), jnp.sin(ang)


def apply_rope(x, cos, sin):
    half = x.shape[-1] // 2
    x1, x2 = x[..., :half], x[..., half:]
    c, s = cos[None, :, None, :], sin[None, :, None, :]
    return jnp.concatenate([x1 * c - x2 * s, x1 * s + x2 * c], axis=-1)


def to_chunks(a):
    B, T, H = a.shape[:3]
    a = a.reshape((B, T // CHUNK, CHUNK, H) + a.shape[3:])
    return jnp.moveaxis(jnp.moveaxis(a, 1, 0), 3, 2)


def from_chunks(o):
    n, B, H, L, d = o.shape
    return jnp.moveaxis(jnp.moveaxis(o, 2, 3), 0, 1).reshape(B, n * L, H, d)


def gla_chunk_scan(q, k, v, g, s0):
    tri = jnp.tril(jnp.ones((CHUNK, CHUNK), bool))

    def step(S, inp):
        qc, kc, vc, gc = inp
        b = jnp.cumsum(gc, axis=2)
        rel = jnp.where(tri[:, :, None], b[:, :, :, None, :] - b[:, :, None, :, :], -jnp.inf)
        att = jnp.einsum('bhid,bhjd,bhijd->bhij', qc, kc, jnp.exp(rel))
        o = jnp.einsum('bhid,bhdv->bhiv', qc * jnp.exp(b), S) + jnp.einsum('bhij,bhjv->bhiv', att, vc)
        b_last = b[:, :, -1]
        k_dec = kc * jnp.exp(b_last[:, :, None, :] - b)
        S_new = jnp.exp(b_last)[..., None] * S + jnp.einsum('bhjd,bhjv->bhdv', k_dec, vc)
        return S_new, o

    S, o = lax.scan(step, s0, (to_chunks(q), to_chunks(k), to_chunks(v), to_chunks(g)))
    return from_chunks(o), S


def mlstm_chunk_scan(q, k, v, log_i, log_f, state):
    tri = jnp.tril(jnp.ones((CHUNK, CHUNK), bool))

    def step(carry, inp):
        C, nv, m = carry
        qc, kc, vc, ic, fc = inp
        b = jnp.cumsum(fc, axis=-1)
        log_d = jnp.where(tri, b[..., :, None] - b[..., None, :] + ic[..., None, :], -jnp.inf)
        inter = b + m[..., None]
        m_row = jnp.maximum(inter, jnp.max(log_d, axis=-1))
        s = jnp.einsum('bhid,bhjd->bhij', qc, kc) * jnp.exp(log_d - m_row[..., None])
        w_inter = jnp.exp(inter - m_row)
        num = w_inter[..., None] * jnp.einsum('bhvd,bhid->bhiv', C, qc) + jnp.einsum('bhij,bhjv->bhiv', s, vc)
        den = w_inter * jnp.einsum('bhd,bhid->bhi', nv, qc) + jnp.sum(s, axis=-1)
        h = num / jnp.maximum(jnp.abs(den), jnp.exp(-m_row))[..., None]
        b_last = b[..., -1]
        log_w = b_last[..., None] - b + ic
        m_new = jnp.maximum(b_last + m, jnp.max(log_w, axis=-1))
        w = jnp.exp(log_w - m_new[..., None])
        decay = jnp.exp(b_last + m - m_new)
        C_new = decay[..., None, None] * C + jnp.einsum('bhj,bhjv,bhjd->bhvd', w, vc, kc)
        n_new = decay[..., None] * nv + jnp.einsum('bhj,bhjd->bhd', w, kc)
        return (C_new, n_new, m_new), h

    state, h = lax.scan(step, state, (to_chunks(q), to_chunks(k), to_chunks(v), to_chunks(log_i), to_chunks(log_f)))
    return from_chunks(h), state


def rwkv7_scan(r, w, k, v, kk, a, s0):
    def step(S, inp):
        rt, wt, kt, vt, kkt, at = inp
        sk = jnp.einsum('bhvk,bhk->bhv', S, kkt)
        S = S * wt[:, :, None, :] - sk[..., None] * (kkt * at)[:, :, None, :] + vt[..., None] * kt[:, :, None, :]
        return S, jnp.einsum('bhvk,bhk->bhv', S, rt)

    xs = tuple(jnp.moveaxis(t, 1, 0) for t in (r, w, k, v, kk, a))
    S, y = lax.scan(step, s0, xs)
    return jnp.moveaxis(y, 0, 1), S


def prefix_scan(scan_fn, ctx_args, lat_args, init, reverse):
    if reverse:
        ctx_args = tuple(jnp.flip(t, 1) for t in ctx_args)
        lat_args = tuple(jnp.flip(t, 1) for t in lat_args)
    o_c, s_c = scan_fn(*ctx_args, init)
    o_l, _ = scan_fn(*lat_args, s_c)
    if reverse:
        o_c, o_l = jnp.flip(o_c, 1), jnp.flip(o_l, 1)
    return o_c, o_l


def mixer_ab(u_c, u_l, rope, w_in, w_out, ret_decay, ret_norm, ml_conv, ml_gate_b, ml_norm, need_ctx):
    def project(u, rope_cs):
        B, T, _ = u.shape
        rq, rk, rv, rg, mqk, mv, mo, mg = _split(u @ w_in, AB_SPLITS)
        rq = rq.astype(F32).reshape(B, T, RET_HEADS, RET_DK)
        rk = rk.astype(F32).reshape(B, T, RET_HEADS, RET_DK) * RET_DK ** -0.5
        if rope_cs is not None:
            rq, rk = apply_rope(rq, *rope_cs), apply_rope(rk, *rope_cs)
        mq, mk = _split(jax.nn.silu(dwconv3(mqk, ml_conv).astype(F32)), (ML_QK, ML_QK))
        return {'rq': rq, 'rk': rk, 'rv': rv.astype(F32).reshape(B, T, RET_HEADS, RET_DV), 'rg': rg.astype(F32),
                'mq': mq.reshape(B, T, MLSTM_HEADS, MLSTM_DK) * MLSTM_DK ** -0.5,
                'mk': mk.reshape(B, T, MLSTM_HEADS, MLSTM_DK),
                'mv': mv.astype(F32).reshape(B, T, MLSTM_HEADS, MLSTM_DV), 'mo': mo.astype(F32),
                'mg': (mg.astype(F32) + ml_gate_b.astype(F32)).reshape(B, T, 2, 2, MLSTM_HEADS)}

    def ret_args(p, d):
        log_gamma = jnp.log1p(-jnp.exp(ret_decay[d].astype(F32)))[:, None]
        return (p['rq'], p['rk'], p['rv'], jnp.broadcast_to(log_gamma, p['rq'].shape))

    def mlstm_args(p, d):
        return (p['mq'], p['mk'], p['mv'], p['mg'][:, :, d, 0], jax.nn.log_sigmoid(p['mg'][:, :, d, 1]))

    pc, pl = project(u_c, None), project(u_l, rope)
    B = u_l.shape[0]
    ret_c = ret_l = ml_c = ml_l = 0.0
    for d in range(2):
        s0 = jnp.zeros((B, RET_HEADS, RET_DK, RET_DV), F32)
        oc, ol = prefix_scan(gla_chunk_scan, ret_args(pc, d), ret_args(pl, d), s0, d == 1)
        ret_c, ret_l = ret_c + oc, ret_l + ol
        st0 = (jnp.zeros((B, MLSTM_HEADS, MLSTM_DV, MLSTM_DK), F32),
               jnp.zeros((B, MLSTM_HEADS, MLSTM_DK), F32), jnp.zeros((B, MLSTM_HEADS), F32))
        oc, ol = prefix_scan(mlstm_chunk_scan, mlstm_args(pc, d), mlstm_args(pl, d), st0, d == 1)
        ml_c, ml_l = ml_c + oc, ml_l + ol

    def merge(p, ret_sum, ml_sum):
        Bm, T = ret_sum.shape[:2]
        ret = head_rms_norm(ret_sum, ret_norm).reshape(Bm, T, RET_W) * jax.nn.silu(p['rg'])
        ml = head_rms_norm(ml_sum, ml_norm).reshape(Bm, T, ML_W) * jax.nn.sigmoid(p['mo'])
        return jnp.concatenate([ret, ml], axis=-1).astype(u_l.dtype) @ w_out

    y_c = merge(pc, ret_c, ml_c) if need_ctx else None
    return y_c, merge(pl, ret_l, ml_l)


def mixer_cd(u_c, u_l, w_in, w_out, lb, hg_norm, rw_shift, rw_w0, rw_w2, rw_a0, rw_a2, rw_g2,
             rw_kk_scale, rw_k_a, rw_r_k, rw_norm, need_ctx):
    lb = lb.reshape(HGRN_HEADS, HGRN_DK)

    def project(u):
        B, T, _ = u.shape
        hq, hf, hi, hg, zr = _split(u @ w_in, CD_SPLITS)
        p = {'hq': hq.astype(F32).reshape(B, T, HGRN_HEADS, HGRN_DK),
             'hf': hf.astype(F32).reshape(B, T, 2, HGRN_HEADS, HGRN_DK),
             'hi': hi.astype(F32).reshape(B, T, HGRN_HEADS, HGRN_DV),
             'hg': hg.astype(F32)}
        r, k, v, wl, al, gl = _split(dwconv3(zr, rw_shift).astype(F32), RWKV_SPLITS)
        p['r'] = r.reshape(B, T, RWKV_HEADS, RWKV_HD)
        p['k'] = k.reshape(B, T, RWKV_HEADS, RWKV_HD)
        p['v'] = v.reshape(B, T, RWKV_HEADS, RWKV_HD)
        kk = p['k'] * rw_kk_scale.astype(F32).reshape(RWKV_HEADS, RWKV_HD)
        p['kk'] = kk * lax.rsqrt(jnp.sum(kk * kk, axis=-1, keepdims=True) + EPS)
        p['wl'], p['al'] = wl, al
        p['g'] = jax.nn.sigmoid(gl) @ rw_g2.astype(F32)
        return p

    def hgrn_args(p, d):
        f = lb + (1.0 - lb) * jax.nn.sigmoid(p['hf'][:, :, d])
        return (p['hq'], 1.0 - f, p['hi'], jnp.log(f))

    def rwkv_args(p, d):
        B, T = p['r'].shape[:2]
        wl = p['wl'][..., d * RWKV_W_RANK:(d + 1) * RWKV_W_RANK]
        al = p['al'][..., d * RWKV_A_RANK:(d + 1) * RWKV_A_RANK]
        w_log = -jax.nn.softplus(-(rw_w0[d].astype(F32) + jnp.tanh(wl) @ rw_w2[d].astype(F32))) - 0.5
        decay = jnp.exp(-jnp.exp(w_log)).reshape(B, T, RWKV_HEADS, RWKV_HD)
        a = jax.nn.sigmoid(rw_a0[d].astype(F32) + al @ rw_a2[d].astype(F32)).reshape(B, T, RWKV_HEADS, RWKV_HD)
        k_eff = p['k'] * (1.0 + (a - 1.0) * rw_k_a.astype(F32).reshape(RWKV_HEADS, RWKV_HD))
        return (p['r'], decay, k_eff, p['v'], p['kk'], a)

    pc, pl = project(u_c), project(u_l)
    B = u_l.shape[0]
    hg_c = hg_l = rw_c = rw_l = 0.0
    dir_c, dir_l = [], []
    for d in range(2):
        s0 = jnp.zeros((B, HGRN_HEADS, HGRN_DK, HGRN_DV), F32)
        oc, ol = prefix_scan(gla_chunk_scan, hgrn_args(pc, d), hgrn_args(pl, d), s0, d == 1)
        hg_c, hg_l = hg_c + oc, hg_l + ol
        ac, al_ = rwkv_args(pc, d), rwkv_args(pl, d)
        dir_c.append(ac)
        dir_l.append(al_)
        s0 = jnp.zeros((B, RWKV_HEADS, RWKV_HD, RWKV_HD), F32)
        oc, ol = prefix_scan(rwkv7_scan, ac, al_, s0, d == 1)
        rw_c, rw_l = rw_c + oc, rw_l + ol

    def merge(p, hg_sum, rw_sum, dir_args):
        Bm, T = hg_sum.shape[:2]
        bonus = sum(jnp.sum(p['r'] * da[2] * rw_r_k.astype(F32), axis=-1, keepdims=True) * p['v'] for da in dir_args)
        hg = head_rms_norm(hg_sum, hg_norm).reshape(Bm, T, HG_W) * jax.nn.sigmoid(p['hg'])
        rw = (head_rms_norm(rw_sum, rw_norm) + bonus).reshape(Bm, T, RW_W) * p['g']
        return jnp.concatenate([hg, rw], axis=-1).astype(u_l.dtype) @ w_out

    y_c = merge(pc, hg_c, rw_c, dir_c) if need_ctx else None
    return y_c, merge(pl, hg_l, rw_l, dir_l)


def hgrn_lower_bound(p, layer):
    sm = jax.nn.softmax(p.astype(F32), axis=0)
    return jnp.cumsum(sm, axis=0)[layer] - sm[0]


def moe_ffn(t, router_w, router_b, w_gu, b_gu, w_dn, b_dn):
    N, D = t.shape
    logits = (t @ router_w).astype(F32) + router_b.astype(F32)
    top_logit, top_e = lax.top_k(logits, TOP_K)
    top_w = jax.nn.softmax(top_logit, axis=-1)
    flat_e = top_e.reshape(-1)
    order = jnp.argsort(flat_e)
    e_sorted = flat_e[order]
    tok_sorted = (order // TOP_K).astype(jnp.int32)
    counts = jnp.bincount(flat_e, length=N_EXPERTS)
    padded = (counts + MOE_BLOCK - 1) // MOE_BLOCK * MOE_BLOCK
    pad_end = jnp.cumsum(padded)
    pad_start = pad_end - padded
    grp_start = jnp.cumsum(counts) - counts
    dest = pad_start[e_sorted] + jnp.arange(N * TOP_K, dtype=jnp.int32) - grp_start[e_sorted]
    n_blocks = -(-(N * TOP_K) // MOE_BLOCK) + N_EXPERTS
    n_rows = n_blocks * MOE_BLOCK
    row_tok = jnp.full((n_rows,), N, jnp.int32).at[dest].set(tok_sorted)
    row_w = jnp.zeros((n_rows,), F32).at[dest].set(top_w.reshape(-1)[order])
    blk_e = jnp.minimum(jnp.searchsorted(pad_end, jnp.arange(n_blocks, dtype=jnp.int32) * MOE_BLOCK, side='right'),
                        N_EXPERTS - 1)
    t_pad = jnp.concatenate([t, jnp.zeros((1, D), t.dtype)], axis=0)
    xb = t_pad[row_tok].reshape(n_blocks, MOE_BLOCK, D)

    def expert_block(args):
        xe, e = args
        gu = (xe @ w_gu[e] + b_gu[e]).astype(F32)
        glu, lin = jnp.split(gu, 2, axis=-1)
        glu = jnp.minimum(glu, SWIGLU_LIMIT)
        lin = jnp.clip(lin, -SWIGLU_LIMIT, SWIGLU_LIMIT)
        act = glu * jax.nn.sigmoid(SWIGLU_ALPHA * glu) * (lin + 1.0)
        return act.astype(t.dtype) @ w_dn[e] + b_dn[e]

    yb = lax.map(expert_block, (xb, blk_e))
    y = jnp.zeros((N + 1, D), F32).at[row_tok].add(yb.reshape(n_rows, D).astype(F32) * row_w[:, None])
    return y[:N].astype(t.dtype)


def setup_inputs(seed: int = 0) -> dict:
    key = jax.random.key(seed)
    ks = iter(jax.random.split(key, 40))

    def nrm(shape, scale=1.0):
        return jax.random.normal(next(ks), shape, F32) * scale

    def gain(shape):
        return 1.0 + nrm(shape, 0.05)

    D = D_MODEL
    ret_base = -(5.0 + jnp.arange(RET_HEADS, dtype=F32)) * float(np.log(2.0))
    gate_base = jnp.stack([jnp.zeros((MLSTM_HEADS,), F32), jnp.linspace(3.0, 6.0, MLSTM_HEADS, dtype=F32)])
    return {
        'x': nrm((BATCH, SEQ, D)),
        'c': nrm((BATCH, D)),
        'ctx': nrm((BATCH, CTX_LEN, D)),
        'c_ctx': nrm((D,)),
        'mod_w': nrm((DEPTH, D, 6 * D), 0.5 * D ** -0.5),
        'mod_b': nrm((DEPTH, 6 * D), 0.02),
        'norm_mix': gain((DEPTH, D)),
        'norm_ffn': gain((DEPTH, D)),
        'norm_final': gain((D,)),
        'ab_w_in': nrm((N_EVEN, D, AB_IN), D ** -0.5),
        'ab_w_out': nrm((N_EVEN, MIX_W_AB, D), MIX_W_AB ** -0.5),
        'ret_decay': ret_base + nrm((N_EVEN, 2, RET_HEADS), 0.05),
        'ret_norm': gain((N_EVEN, RET_HEADS, RET_DV)),
        'mlstm_conv': jnp.array([0.0, 1.0, 0.0], F32)[:, None] + nrm((N_EVEN, 3, 2 * ML_QK), 0.3),
        'mlstm_gate_b': (gate_base + nrm((N_EVEN, 2, 2, MLSTM_HEADS), 0.1)).reshape(N_EVEN, 4 * MLSTM_HEADS),
        'mlstm_norm': gain((N_EVEN, MLSTM_HEADS, MLSTM_DV)),
        'cd_w_in': nrm((N_ODD, D, CD_IN), D ** -0.5),
        'cd_w_out': nrm((N_ODD, MIX_W_CD, D), MIX_W_CD ** -0.5),
        'hgrn_lb': nrm((DEPTH, HG_K), 0.5),
        'hgrn_norm': gain((N_ODD, HGRN_HEADS, HGRN_DV)),
        'rwkv_shift': jnp.array([0.25, 0.5, 0.25], F32)[:, None] + nrm((N_ODD, 3, RWKV_IN), 0.05),
        'rwkv_w0': jnp.linspace(-6.0, -1.0, RW_W, dtype=F32) + nrm((N_ODD, 2, RW_W), 0.1),
        'rwkv_w2': nrm((N_ODD, 2, RWKV_W_RANK, RW_W), 0.5 * RWKV_W_RANK ** -0.5),
        'rwkv_a0': nrm((N_ODD, 2, RW_W), 0.1),
        'rwkv_a2': nrm((N_ODD, 2, RWKV_A_RANK, RW_W), RWKV_A_RANK ** -0.5),
        'rwkv_g2': nrm((N_ODD, RWKV_G_RANK, RW_W), RWKV_G_RANK ** -0.5),
        'rwkv_kk_scale': 0.85 + nrm((N_ODD, RW_W), 0.05),
        'rwkv_k_a': 1.0 + nrm((N_ODD, RW_W), 0.05),
        'rwkv_r_k': nrm((N_ODD, RWKV_HEADS, RWKV_HD), 0.1),
        'rwkv_norm': gain((N_ODD, RWKV_HEADS, RWKV_HD)),
        'router_w': nrm((DEPTH, D, N_EXPERTS), D ** -0.5),
        'router_b': nrm((DEPTH, N_EXPERTS), 0.01),
        'exp_w_gate_up': nrm((DEPTH, N_EXPERTS, D, 2 * D_FF), D ** -0.5),
        'exp_b_gate_up': nrm((DEPTH, N_EXPERTS, 2 * D_FF), 0.01),
        'exp_w_down': nrm((DEPTH, N_EXPERTS, D_FF, D), D_FF ** -0.5),
        'exp_b_down': nrm((DEPTH, N_EXPERTS, D), 0.01),
    }


def reference(x, c, ctx, c_ctx, mod_w, mod_b, norm_mix, norm_ffn, norm_final,
              ab_w_in, ab_w_out, ret_decay, ret_norm, mlstm_conv, mlstm_gate_b, mlstm_norm,
              cd_w_in, cd_w_out, hgrn_lb, hgrn_norm, rwkv_shift, rwkv_w0, rwkv_w2, rwkv_a0,
              rwkv_a2, rwkv_g2, rwkv_kk_scale, rwkv_k_a, rwkv_r_k, rwkv_norm,
              router_w, router_b, exp_w_gate_up, exp_b_gate_up, exp_w_down, exp_b_down):
    T = x.shape[1]
    rows = T // GRID_W
    pos_r = jnp.repeat(jnp.arange(rows, dtype=F32), GRID_W)
    pos_c = jnp.tile(jnp.arange(GRID_W, dtype=F32), rows)
    rope = rope_tables(pos_r, pos_c)
    cond_l = jax.nn.silu(c)
    cond_c = jax.nn.silu(c_ctx)[None, :]
    h_l, h_c = x, ctx
    for i in range(DEPTH):
        last = i == DEPTH - 1
        j = i // 2
        m_l = jnp.split(cond_l @ mod_w[i] + mod_b[i], 6, axis=-1)
        m_c = jnp.split(cond_c @ mod_w[i] + mod_b[i], 6, axis=-1)
        u_l = modulate(rms_norm(h_l, norm_mix[i]), m_l[0], m_l[1])
        u_c = modulate(rms_norm(h_c, norm_mix[i]), m_c[0], m_c[1])
        if i % 2 == 0:
            y_c, y_l = mixer_ab(u_c, u_l, rope, ab_w_in[j], ab_w_out[j], ret_decay[j], ret_norm[j],
                                mlstm_conv[j], mlstm_gate_b[j], mlstm_norm[j], not last)
        else:
            y_c, y_l = mixer_cd(u_c, u_l, cd_w_in[j], cd_w_out[j], hgrn_lower_bound(hgrn_lb, i), hgrn_norm[j],
                                rwkv_shift[j], rwkv_w0[j], rwkv_w2[j], rwkv_a0[j], rwkv_a2[j], rwkv_g2[j],
                                rwkv_kk_scale[j], rwkv_k_a[j], rwkv_r_k[j], rwkv_norm[j], not last)
        moe_args = (router_w[i], router_b[i], exp_w_gate_up[i], exp_b_gate_up[i], exp_w_down[i], exp_b_down[i])
        h_l = h_l + m_l[2][:, None] * y_l
        v_l = modulate(rms_norm(h_l, norm_ffn[i]), m_l[3], m_l[4])
        if last:
            h_l = h_l + m_l[5][:, None] * moe_ffn(v_l.reshape(-1, D_MODEL), *moe_args).reshape(v_l.shape)
        else:
            h_c = h_c + m_c[2][:, None] * y_c
            v_c = modulate(rms_norm(h_c, norm_ffn[i]), m_c[3], m_c[4])
            n_c = v_c.shape[0] * v_c.shape[1]
            f = moe_ffn(jnp.concatenate([v_c.reshape(-1, D_MODEL), v_l.reshape(-1, D_MODEL)], axis=0), *moe_args)
            h_c = h_c + m_c[5][:, None] * f[:n_c].reshape(v_c.shape)
            h_l = h_l + m_l[5][:, None] * f[n_c:].reshape(v_l.shape)
    return rms_norm(h_l, norm_final)
```

```cpp
#include <hip/hip_runtime.h>
#include <stdint.h>
#include <stddef.h>

#define DM 1024
#define NB 4
#define TL 8192
#define TC 256
#define NCTX (NB * TC)
#define NLAT (NB * TL)
#define NTOK (NCTX + NLAT)
#define AB_IN 3088
#define CD_IN 4480
#define NEXP 32
#define EPSF 1e-6f

typedef unsigned short bf16_t;
typedef unsigned u32x2 __attribute__((ext_vector_type(2)));
typedef unsigned u32x4 __attribute__((ext_vector_type(4)));
__device__ __forceinline__ unsigned cvt_pk_bf16(float lo, float hi) { unsigned r; asm volatile("v_cvt_pk_bf16_f32 %0, %1, %2" : "=v"(r) : "v"(lo), "v"(hi)); return r; }
typedef __bf16 bf16x2_t __attribute__((ext_vector_type(2)));
typedef float f32x2_t __attribute__((ext_vector_type(2)));
__device__ __forceinline__ unsigned cvt_pk_bf16_nat(float lo, float hi) { const f32x2_t v = {lo, hi}; return __builtin_bit_cast(unsigned, __builtin_convertvector(v, bf16x2_t)); }
__device__ __forceinline__ void st_bf16x8(bf16_t* p, float a, float b, float c, float d, float e, float f, float g, float h) { u32x4 w; w.x = cvt_pk_bf16_nat(a, b); w.y = cvt_pk_bf16_nat(c, d); w.z = cvt_pk_bf16_nat(e, f); w.w = cvt_pk_bf16_nat(g, h); *(u32x4*)p = w; }
__device__ __forceinline__ void st_bf16x4(bf16_t* p, float a, float b, float c, float d) { u32x2 w; w.x = cvt_pk_bf16(a, b); w.y = cvt_pk_bf16(c, d); *(u32x2*)p = w; }
__device__ __forceinline__ float sigmoidf_(float x) { return 1.0f / (1.0f + expf(-x)); }
__device__ __forceinline__ float siluf_(float x) { return x / (1.0f + expf(-x)); }
__device__ __forceinline__ float logsigmoidf_(float x) { return fminf(x, 0.0f) - log1pf(expf(-fabsf(x))); }
__device__ __forceinline__ float softplusf_(float x) { return fmaxf(x, 0.0f) + log1pf(expf(-fabsf(x))); }

__device__ __forceinline__ float fexp_(float x) { return __expf(x); }
__device__ __forceinline__ float frcp_(float x) { return __builtin_amdgcn_rcpf(x); }
__device__ __forceinline__ float fsigmoid_(float x) { return frcp_(1.0f + __expf(-x)); }
__device__ __forceinline__ float flog_(float x) { return __logf(x); }
__device__ __forceinline__ float wave_sum(float v) {
#pragma unroll
    for (int o = 32; o > 0; o >>= 1) v += __shfl_xor(v, o);
    return v;
}
__device__ __forceinline__ float block_sum(float v, float* red) {
    v = wave_sum(v);
    const int w = threadIdx.x >> 6, nw = blockDim.x >> 6;
    __syncthreads();
    if ((threadIdx.x & 63) == 0) red[w] = v;
    __syncthreads();
    float s = 0.f;
    for (int i = 0; i < nw; ++i) s += red[i];
    return s;
}

struct RowInfo { int t, len, mrow; };
__device__ __forceinline__ RowInfo row_info(int r) {
    RowInfo ri;
    if (r < NCTX) { ri.t = r % TC; ri.len = TC; ri.mrow = 4; }
    else { const int rr = r - NCTX; ri.t = rr % TL; ri.len = TL; ri.mrow = rr / TL; }
    return ri;
}

typedef short bf16x8 __attribute__((ext_vector_type(8)));
typedef float f32x4 __attribute__((ext_vector_type(4)));
#define NTHR 512
__device__ __forceinline__ int tid_fresh() { int t = threadIdx.x; asm volatile("" : "+v"(t)); return t; }
#define LDS_BYTES 147456
#define LDS_TAB 131072
extern __shared__ __attribute__((aligned(16))) char g_shm[];

__device__ __forceinline__ float bf16_to_f32(bf16_t v) { return __uint_as_float(((unsigned)v) << 16); }
__device__ __forceinline__ float ldz(const bf16_t* p) { return bf16_to_f32(*p); }
__device__ __forceinline__ f32x4 ldz4(const bf16_t* p) { const u32x2 w = *(const u32x2*)p; f32x4 r; r[0] = __uint_as_float(w.x << 16); r[1] = __uint_as_float(w.x & 0xffff0000u); r[2] = __uint_as_float(w.y << 16); r[3] = __uint_as_float(w.y & 0xffff0000u); return r; }

template <int MODE>
__device__ __forceinline__ int src_col(int sn) {
    if (MODE == 2) { const int rho = sn & 31, nn = rho >> 4, ii = rho & 15; sn = (sn & ~31) + 8 * (ii >> 2) + 4 * nn + (ii & 3); }
    if (MODE == 1) {
        const int u = sn >> 8, within = sn & 255, bj = within >> 7, q = within & 127, rho = q & 31, nn = rho >> 4, ii = rho & 15;
        sn = (bj ? 1024 : 0) + u * 128 + (q & ~31) + 8 * (ii >> 2) + 4 * nn + (ii & 3);
    }
    return sn;
}
template <int MODE>
__device__ __forceinline__ void convert_tile(const float* __restrict__ W, int N, bf16_t* __restrict__ Wt, int n0, int k0) {
    float (*tile)[129] = (float (*)[129])g_shm;
    const int tid = tid_fresh();
    const int kr = tid >> 5, n4 = (tid & 31) * 4;
    const int sn = src_col<MODE>(n0 + n4);
    f32x4 v[4];
#pragma unroll
    for (int i = 0; i < 4; ++i) {
        v[i] = (f32x4){0.f, 0.f, 0.f, 0.f};
        if (sn < N) v[i] = *(const f32x4*)(W + (size_t)(k0 + kr + 16 * i) * N + sn);
    }
    __syncthreads();
#pragma unroll
    for (int i = 0; i < 4; ++i) { float* t = &tile[kr + 16 * i][n4]; t[0] = v[i][0]; t[1] = v[i][1]; t[2] = v[i][2]; t[3] = v[i][3]; }
    __syncthreads();
    const int n = tid >> 2, k16 = (tid & 3) * 16;
    u32x4 o0, o1;
    o0.x = cvt_pk_bf16(tile[k16 + 0][n], tile[k16 + 1][n]); o0.y = cvt_pk_bf16(tile[k16 + 2][n], tile[k16 + 3][n]);
    o0.z = cvt_pk_bf16(tile[k16 + 4][n], tile[k16 + 5][n]); o0.w = cvt_pk_bf16(tile[k16 + 6][n], tile[k16 + 7][n]);
    o1.x = cvt_pk_bf16(tile[k16 + 8][n], tile[k16 + 9][n]); o1.y = cvt_pk_bf16(tile[k16 + 10][n], tile[k16 + 11][n]);
    o1.z = cvt_pk_bf16(tile[k16 + 12][n], tile[k16 + 13][n]); o1.w = cvt_pk_bf16(tile[k16 + 14][n], tile[k16 + 15][n]);
    bf16_t* dst = Wt + (size_t)(n0 + n) * 1024 + k0 + k16;
    *(u32x4*)dst = o0; *(u32x4*)(dst + 8) = o1;
}
template <int MODE>
__device__ __forceinline__ int convert_matrix(const float* W, int N, int Npad, bf16_t* Wt, int base, int bi, int G) {
    const int ntiles = (Npad >> 7) * 16;
    for (int it = base + ((bi - base % G) + G) % G; it < base + ntiles; it += G) {
        const int l = it - base;
        convert_tile<MODE>(W, N, Wt, (l >> 4) * 128, (l & 15) * 64);
    }
    return base + ntiles;
}
__device__ __forceinline__ void lds_barrier() { asm volatile("s_waitcnt lgkmcnt(0)" ::: "memory"); __builtin_amdgcn_s_barrier(); asm volatile("" ::: "memory"); }
__device__ __forceinline__ void convert_experts(const float* __restrict__ wgu, const float* __restrict__ wdn, bf16_t* __restrict__ wguT, bf16_t* __restrict__ wdnT, int le0, int le1, int bi, int G) {
    float (*tile)[129] = (float (*)[129])g_shm;
    const int tid = tid_fresh();
    const int kr = tid >> 5, n4 = (tid & 31) * 4;
    const int n = tid >> 2, k16 = (tid & 3) * 16;
    const int total = (le1 - le0) * 384;
    f32x4 v[4];
    auto issue = [&](int item) {
        const int e = le0 + item / 384, t = item % 384;
        const bool gu = t < 256; const int l = gu ? t : t - 256;
        const int n0 = (l >> 4) * 128, k0 = (l & 15) * 64, N = gu ? 2048 : 1024;
        const float* W = gu ? wgu + (size_t)e * 1024 * 2048 : wdn + (size_t)e * 1024 * 1024;
        const int sn = gu ? src_col<1>(n0 + n4) : src_col<2>(n0 + n4);
#pragma unroll
        for (int i = 0; i < 4; ++i) v[i] = *(const f32x4*)(W + (size_t)(k0 + kr + 16 * i) * N + sn);
    };
    __syncthreads();
    int item = bi;
    if (item < total) issue(item);
    for (; item < total; item += G) {
        lds_barrier();
#pragma unroll
        for (int i = 0; i < 4; ++i) { float* t = &tile[kr + 16 * i][n4]; t[0] = v[i][0]; t[1] = v[i][1]; t[2] = v[i][2]; t[3] = v[i][3]; }
        const int e = le0 + item / 384, t = item % 384;
        const bool gu = t < 256; const int l = gu ? t : t - 256;
        bf16_t* dst = (gu ? wguT + (size_t)e * 2048 * 1024 : wdnT + (size_t)e * 1024 * 1024) + (size_t)((l >> 4) * 128 + n) * 1024 + (l & 15) * 64 + k16;
        if (item + G < total) issue(item + G);
        lds_barrier();
        u32x4 o0, o1;
        o0.x = cvt_pk_bf16(tile[k16 + 0][n], tile[k16 + 1][n]); o0.y = cvt_pk_bf16(tile[k16 + 2][n], tile[k16 + 3][n]);
        o0.z = cvt_pk_bf16(tile[k16 + 4][n], tile[k16 + 5][n]); o0.w = cvt_pk_bf16(tile[k16 + 6][n], tile[k16 + 7][n]);
        o1.x = cvt_pk_bf16(tile[k16 + 8][n], tile[k16 + 9][n]); o1.y = cvt_pk_bf16(tile[k16 + 10][n], tile[k16 + 11][n]);
        o1.z = cvt_pk_bf16(tile[k16 + 12][n], tile[k16 + 13][n]); o1.w = cvt_pk_bf16(tile[k16 + 14][n], tile[k16 + 15][n]);
        *(u32x4*)dst = o0; *(u32x4*)(dst + 8) = o1;
    }
    __syncthreads();
}

__device__ __forceinline__ int lds_byte(int r, int c) { const int st = (r >> 4) * 2 + (c >> 5), rr = r & 15, cc = c & 31, ob = rr * 64 + cc * 2; return st * 1024 + (ob ^ (((ob >> 9) & 1) << 5)); }
__device__ __forceinline__ void stage_rc(int b, int& R, int& C) { const int st = b / 1024, sb = b % 1024, swz = sb ^ (((sb >> 9) & 1) << 5); R = (st >> 1) * 16 + swz / 64; C = (st & 1) * 32 + (swz % 64) / 2; }

#define G_HT (128 * 64)
#define G_SA(b, h) (shm + ((b) * 2 + (h)) * G_HT)
#define G_SB(b, h) (shm + (4 + (b) * 2 + (h)) * G_HT)
#define G_GLDS(src, dst) __builtin_amdgcn_global_load_lds((const unsigned*)(src), (unsigned*)(dst), 16, 0, 0)
#define G_STAGE_A(P, h, kt) do { G_GLDS(Ab + (size_t)(unsigned)((h ? a10 : a00) + (unsigned)(kt) * 128u), (char*)(P) + tb); G_GLDS(Ab + (size_t)(unsigned)((h ? a11 : a01) + (unsigned)(kt) * 128u), (char*)(P) + tb + 8192); } while (0)
#define G_STAGE_B(P, h, kt) do { G_GLDS(Bb + (size_t)(unsigned)(bofs + (unsigned)((h) * (128 * 2048)) + (unsigned)(kt) * 128u), (char*)(P) + tb); G_GLDS(Bb + (size_t)(unsigned)(bofs + (unsigned)((h) * (128 * 2048) + 64 * 2048) + (unsigned)(kt) * 128u), (char*)(P) + tb + 8192); } while (0)
#define G_LDA(dst, b, h) for (int m = 0; m < 4; ++m) for (int k = 0; k < 2; ++k) dst[m][k] = *reinterpret_cast<const bf16x8*>((char*)G_SA(b, h) + lds_byte(wr * 64 + m * 16 + fr, k * 32 + fq * 8))
#define G_LDB(dst, b, h) for (int n = 0; n < 2; ++n) for (int k = 0; k < 2; ++k) dst[n][k] = *reinterpret_cast<const bf16x8*>((char*)G_SB(b, h) + lds_byte(wc * 32 + n * 16 + fr, k * 32 + fq * 8))
#define G_MMA(ai, bj, At_, Bt_) do { __builtin_amdgcn_s_setprio(1); \
    for (int m = 0; m < 4; ++m) for (int n = 0; n < 2; ++n) for (int k = 0; k < 2; ++k) \
        acc[ai][bj][m][n] = __builtin_amdgcn_mfma_f32_16x16x32_bf16(Bt_[n][k], At_[m][k], acc[ai][bj][m][n], 0, 0, 0); \
    __builtin_amdgcn_s_setprio(0); } while (0)
#define G_WAIT_V(n) asm volatile("s_waitcnt vmcnt(" #n ")" ::: "memory")
#define G_WAIT_L(n) asm volatile("s_waitcnt lgkmcnt(" #n ")" ::: "memory")
#define G_BAR __builtin_amdgcn_s_barrier()
#define G_SCHED __builtin_amdgcn_sched_barrier(0)

#define G_STAGE_AX(P, X0, X1, kt) do { G_GLDS(Ab + (size_t)(unsigned)((X0) + (unsigned)(kt) * 128u), (char*)(P) + tb); G_GLDS(Ab + (size_t)(unsigned)((X1) + (unsigned)(kt) * 128u), (char*)(P) + tb + 8192); } while (0)
#define G_STAGE_BX(P, XB, h, kt) do { G_GLDS(Bb + (size_t)(unsigned)((XB) + (unsigned)((h) * (128 * 2048)) + (unsigned)(kt) * 128u), (char*)(P) + tb); G_GLDS(Bb + (size_t)(unsigned)((XB) + (unsigned)((h) * (128 * 2048) + 64 * 2048) + (unsigned)(kt) * 128u), (char*)(P) + tb + 8192); } while (0)
template <class Sched>
__device__ __forceinline__ void gemm_stream(const bf16_t* __restrict__ A, const bf16_t* __restrict__ Bt, const Sched& S) {
    typename Sched::U cur, nxt;
    if (!S.get(0, cur)) return;
    bf16_t* shm = (bf16_t*)g_shm;
    const int tid = tid_fresh();
    const int tb = tid * 16;
    int R0, C0; stage_rc(tb, R0, C0);
    const char* Ab = (const char*)A; const char* Bb = (const char*)Bt;
    unsigned a00, a01, a10, a11, bofs;
    S.addrs(cur, R0, C0, a00, a01, a10, a11, bofs);
    const int wid = tid >> 6, lane = tid & 63, wr = wid >> 2, wc = wid & 3, fr = lane & 15, fq = lane >> 4;
    bf16x8 At[4][2], B0[2][2], B1[2][2];
    constexpr int nt = 16;
    G_STAGE_BX(G_SB(0, 0), bofs, 0, 0); G_STAGE_AX(G_SA(0, 0), a00, a01, 0);
    G_STAGE_BX(G_SB(0, 1), bofs, 1, 0); G_STAGE_AX(G_SA(0, 1), a10, a11, 0);
    if (wr == 1) G_BAR;
    G_WAIT_V(4); G_BAR;
    G_STAGE_BX(G_SB(1, 0), bofs, 0, 1); G_STAGE_AX(G_SA(1, 0), a00, a01, 1); G_STAGE_BX(G_SB(1, 1), bofs, 1, 1);
    G_WAIT_V(6); G_BAR;
    bool more = true;
    for (int ui = 0; more; ++ui) {
        more = S.get(ui + 1, nxt);
        unsigned n00 = a00, n01 = a01, n10 = a10, n11 = a11, nb = bofs;
        if (more) S.addrs(nxt, R0, C0, n00, n01, n10, n11, nb);
        f32x4 acc[2][2][4][2] = {};
        for (int t = 0; t < nt; t += 2) {
            const bool last = (t == nt - 2);
            const unsigned s00 = last ? n00 : a00, s01 = last ? n01 : a01, s10 = last ? n10 : a10, s11 = last ? n11 : a11, sb = last ? nb : bofs;
            const int k2 = last ? 0 : t + 2, k3 = last ? 1 : t + 3;
            G_LDB(B0, 0, 0); G_SCHED; G_LDA(At, 0, 0); G_STAGE_AX(G_SA(1, 1), a10, a11, t + 1);
            G_WAIT_L(8); G_BAR; G_WAIT_L(0); G_MMA(0, 0, At, B0); G_BAR; G_SCHED;
            G_LDB(B1, 0, 1); G_STAGE_BX(G_SB(0, 0), sb, 0, k2);
            G_BAR; G_WAIT_L(0); G_MMA(0, 1, At, B1); G_BAR;
            G_LDA(At, 0, 1); G_STAGE_AX(G_SA(0, 0), s00, s01, k2);
            G_BAR; G_WAIT_L(0); G_MMA(1, 0, At, B0); G_BAR; G_SCHED;
            G_STAGE_BX(G_SB(0, 1), sb, 1, k2);
            G_WAIT_V(6); G_BAR; G_MMA(1, 1, At, B1); G_BAR;
            G_LDB(B0, 1, 0); G_SCHED; G_LDA(At, 1, 0); G_STAGE_AX(G_SA(0, 1), s10, s11, k2);
            G_WAIT_L(8); G_BAR; G_WAIT_L(0); G_MMA(0, 0, At, B0); G_BAR; G_SCHED;
            G_LDB(B1, 1, 1); G_STAGE_BX(G_SB(1, 0), sb, 0, k3);
            G_BAR; G_WAIT_L(0); G_MMA(0, 1, At, B1); G_BAR;
            G_LDA(At, 1, 1); G_STAGE_AX(G_SA(1, 0), s00, s01, k3);
            G_BAR; G_WAIT_L(0); G_MMA(1, 0, At, B0); G_BAR; G_SCHED;
            G_STAGE_BX(G_SB(1, 1), sb, 1, k3);
            G_WAIT_V(6); G_BAR; G_MMA(1, 1, At, B1); G_BAR;
        }
        S.epi(cur, acc, wr, wc, fr, fq);
        cur = nxt; a00 = n00; a01 = n01; a10 = n10; a11 = n11; bofs = nb;
    }
    G_WAIT_V(0);
    if (wr == 0) G_BAR;
}

__device__ __forceinline__ bool dense_unit(int i, int nM, int nN, int& pm, int& pn) {
    const int G = gridDim.x, c = blockIdx.x;
    const int v = (G % 8 == 0) ? ((c % 8) * (G / 8) + c / 8) : c;
    const long L = (long)i * G + v;
    const int nwg = nM * nN;
    if (L >= nwg) return false;
    const int wgid = (int)L;
    const int nig = 16 * nN, gid = wgid / nig, fm = gid * 16, gsz = (nM - fm) < 16 ? (nM - fm) : 16;
    pm = fm + ((wgid % nig) % gsz); pn = (wgid % nig) / gsz;
    return true;
}
struct UDense { int pm, pn; };
template <class Derived> struct DenseBase {
    typedef UDense U;
    int nM, nN, row_base;
    __device__ __forceinline__ bool get(int i, U& u) const { return dense_unit(i, nM, nN, u.pm, u.pn); }
    __device__ __forceinline__ void addrs(const U& u, int R0, int C0, unsigned& a00, unsigned& a01, unsigned& a10, unsigned& a11, unsigned& bofs) const {
        const unsigned r = (unsigned)(row_base + u.pm * 256 + R0);
        a00 = (r * 1024u + C0) * 2u; a01 = a00 + 64u * 2048u; a10 = a00 + 128u * 2048u; a11 = a00 + 192u * 2048u;
        bofs = ((unsigned)(u.pn * 256 + R0) * 1024u + C0) * 2u;
    }
};
struct SchedBf16 : DenseBase<SchedBf16> {
    bf16_t* C; int ldc, N;
    __device__ __forceinline__ void epi(const UDense& u, const f32x4 (&acc)[2][2][4][2], int wr, int wc, int fr, int fq) const {
        const int row0 = row_base + u.pm * 256, col0 = u.pn * 256;
#pragma unroll
        for (int ai = 0; ai < 2; ++ai)
#pragma unroll
            for (int m = 0; m < 4; ++m) {
                bf16_t* rowp = C + (size_t)(row0 + ai * 128 + wr * 64 + m * 16 + fr) * ldc;
#pragma unroll
                for (int bj = 0; bj < 2; ++bj) {
                    const int c = col0 + bj * 128 + wc * 32 + fq * 8;
                    const f32x4 x = acc[ai][bj][m][0], y = acc[ai][bj][m][1];
                    if (c < N) st_bf16x8(rowp + c, x[0], x[1], x[2], x[3], y[0], y[1], y[2], y[3]);
                }
            }
    }
};
struct SchedResid : DenseBase<SchedResid> {
    const float* src_ctx; const float* src_lat; const float* gate; float* H;
    __device__ __forceinline__ void epi(const UDense& u, const f32x4 (&acc)[2][2][4][2], int wr, int wc, int fr, int fq) const {
        const int row0 = row_base + u.pm * 256, col0 = u.pn * 256;
#pragma unroll
        for (int ai = 0; ai < 2; ++ai)
#pragma unroll
            for (int m = 0; m < 4; ++m) {
                const int r = row0 + ai * 128 + wr * 64 + m * 16 + fr;
                const float* sp = r < NCTX ? src_ctx + (size_t)r * DM : src_lat + (size_t)(r - NCTX) * DM;
                const float* gp = gate + (size_t)(r < NCTX ? 4 : (r - NCTX) / TL) * 6144;
                float* hp = H + (size_t)r * DM;
#pragma unroll
                for (int bj = 0; bj < 2; ++bj)
#pragma unroll
                    for (int n = 0; n < 2; ++n) {
                        const int c = col0 + bj * 128 + wc * 32 + n * 16 + fq * 4;
                        const f32x4 x = *(const f32x4*)(sp + c), g = *(const f32x4*)(gp + c);
                        *(f32x4*)(hp + c) = x + g * acc[ai][bj][m][n];
                    }
            }
    }
};
__device__ __forceinline__ void ph_gemm_bf16out(const bf16_t* A, int row_base, int M, const bf16_t* Bt, int N, int Npad, bf16_t* C, int ldc) {
    SchedBf16 S; S.nM = M / 256; S.nN = Npad / 256; S.row_base = row_base; S.C = C; S.ldc = ldc; S.N = N;
    gemm_stream(A, Bt, S);
}
__device__ __forceinline__ void ph_gemm_resid(const bf16_t* A, int row_base, int M, const bf16_t* Bt, const float* src_ctx, const float* src_lat, const float* gate, float* H) {
    SchedResid S; S.nM = M / 256; S.nN = 4; S.row_base = row_base; S.src_ctx = src_ctx; S.src_lat = src_lat; S.gate = gate; S.H = H;
    gemm_stream(A, Bt, S);
}

struct UMoe { int e, pm, pn, off; };
__device__ __forceinline__ void moe_table(const int* __restrict__ meta, int nN) {
    int* TAB = (int*)(g_shm + LDS_TAB);
    __syncthreads();
    if (threadIdx.x == 0) {
        int us = 0;
        for (int x = 0; x < NEXP; ++x) { const int nrt = (meta[x] + 255) >> 8; TAB[x] = us; TAB[32 + x] = nrt; TAB[64 + x] = meta[64 + x]; us += nrt * nN; }
        TAB[96] = us;
    }
    __syncthreads();
}
__device__ __forceinline__ bool moe_unit(int i, int nN, UMoe& u) {
    const int* TAB = (const int*)(g_shm + LDS_TAB);
    const int G = gridDim.x, c = blockIdx.x;
    const int v = (G % 8 == 0) ? ((c % 8) * (G / 8) + c / 8) : c;
    const int L = i * G + v;
    if (L >= TAB[96]) return false;
    int x = 0;
#pragma unroll
    for (int st = 16; st > 0; st >>= 1) if (TAB[x + st] <= L) x += st;
    const int wgid = L - TAB[x], nrt = TAB[32 + x];
    const int nig = 8 * nN, gid = wgid / nig, fm = gid * 8, gsz = (nrt - fm) < 8 ? (nrt - fm) : 8;
    u.e = x; u.off = TAB[64 + x]; u.pm = fm + ((wgid % nig) % gsz); u.pn = (wgid % nig) / gsz;
    return true;
}
struct SchedGU {
    typedef UMoe U;
    const int* meta; const int* list; const float* bgu; bf16_t* act;
    __device__ __forceinline__ bool get(int i, U& u) const { return moe_unit(i, 8, u); }
    __device__ __forceinline__ void addrs(const U& u, int R0, int C0, unsigned& a00, unsigned& a01, unsigned& a10, unsigned& a11, unsigned& bofs) const {
        const int* lp = list + u.off + u.pm * 256 + R0;
        a00 = ((unsigned)lp[0] * 1024u + C0) * 2u; a01 = ((unsigned)lp[64] * 1024u + C0) * 2u; a10 = ((unsigned)lp[128] * 1024u + C0) * 2u; a11 = ((unsigned)lp[192] * 1024u + C0) * 2u;
        bofs = ((unsigned)(u.e * 2048 + u.pn * 256 + R0) * 1024u + C0) * 2u;
    }
    __device__ __forceinline__ void epi(const U& u, const f32x4 (&acc)[2][2][4][2], int wr, int wc, int fr, int fq) const {
        const int s0 = u.off + u.pm * 256;
        const float* bg_ = bgu + (size_t)u.e * 2048;
        const int ch = u.pn * 128 + wc * 32 + fq * 8;
        const f32x4 bg0 = *(const f32x4*)(bg_ + ch), bg1 = *(const f32x4*)(bg_ + ch + 4), bl0 = *(const f32x4*)(bg_ + 1024 + ch), bl1 = *(const f32x4*)(bg_ + 1024 + ch + 4);
#pragma unroll
        for (int ai = 0; ai < 2; ++ai)
#pragma unroll
            for (int m = 0; m < 4; ++m) {
                const int slot = s0 + ai * 128 + wr * 64 + m * 16 + fr;
                float o[8];
#pragma unroll
                for (int n = 0; n < 2; ++n)
#pragma unroll
                    for (int j = 0; j < 4; ++j) {
                        float g = acc[ai][0][m][n][j] + (n ? bg1[j] : bg0[j]), l = acc[ai][1][m][n][j] + (n ? bl1[j] : bl0[j]);
                        g = fminf(g, 7.0f); l = fminf(fmaxf(l, -7.0f), 7.0f);
                        o[n * 4 + j] = g * frcp_(1.0f + __expf(-1.702f * g)) * (l + 1.0f);
                    }
                st_bf16x8(act + (size_t)slot * 1024 + ch, o[0], o[1], o[2], o[3], o[4], o[5], o[6], o[7]);
            }
    }
};
struct SchedDN {
    typedef UMoe U;
    const int* meta; const float* bdn; bf16_t* ys; const float* slot_w;
    __device__ __forceinline__ bool get(int i, U& u) const { return moe_unit(i, 4, u); }
    __device__ __forceinline__ void addrs(const U& u, int R0, int C0, unsigned& a00, unsigned& a01, unsigned& a10, unsigned& a11, unsigned& bofs) const {
        const unsigned r = (unsigned)(u.off + u.pm * 256 + R0);
        a00 = (r * 1024u + C0) * 2u; a01 = a00 + 64u * 2048u; a10 = a00 + 128u * 2048u; a11 = a00 + 192u * 2048u;
        bofs = ((unsigned)(u.e * 1024 + u.pn * 256 + R0) * 1024u + C0) * 2u;
    }
    __device__ __forceinline__ void epi(const U& u, const f32x4 (&acc)[2][2][4][2], int wr, int wc, int fr, int fq) const {
        const int s0 = u.off + u.pm * 256, col0 = u.pn * 256;
        const float* bd_ = bdn + (size_t)u.e * 1024;
#pragma unroll
        for (int bj = 0; bj < 2; ++bj) {
            const int c = col0 + bj * 128 + wc * 32 + fq * 8;
            const f32x4 b0 = *(const f32x4*)(bd_ + c), b1 = *(const f32x4*)(bd_ + c + 4);
#pragma unroll
            for (int ai = 0; ai < 2; ++ai)
#pragma unroll
                for (int m = 0; m < 4; ++m) {
                    const int slot = s0 + ai * 128 + wr * 64 + m * 16 + fr;
                    const float w = slot_w[slot];
                    const f32x4 x = (acc[ai][bj][m][0] + b0) * w, y = (acc[ai][bj][m][1] + b1) * w;
                    st_bf16x8(ys + (size_t)slot * 1024 + c, x[0], x[1], x[2], x[3], y[0], y[1], y[2], y[3]);
                }
        }
    }
};
__device__ __forceinline__ void ph_moe_gu(const bf16_t* V, const int* meta, const int* list, const bf16_t* WguT, const float* bgu, bf16_t* act) {
    SchedGU S; S.meta = meta; S.list = list; S.bgu = bgu; S.act = act;
    moe_table(meta, 8);
    gemm_stream(V, WguT, S);
}
__device__ __forceinline__ void ph_moe_dn(const bf16_t* act, const int* meta, const bf16_t* WdnT, const float* bdn, bf16_t* ys, const float* slot_w) {
    SchedDN S; S.meta = meta; S.bdn = bdn; S.ys = ys; S.slot_w = slot_w;
    moe_table(meta, 4);
    gemm_stream(act, WdnT, S);
}

#define NCHUNK 528
#define REC 8320
#define LP 72
__device__ __forceinline__ size_t rec_off(int type, int dir, int h, int g) { return ((size_t)(((type * 2 + dir) * 4 + h) * NCHUNK + g)) * REC; }
__device__ __forceinline__ int chunk_g(int b, int dir, int s) {
    if (s < 4) return b * 4 + (dir ? 3 - s : s);
    const int s2 = s - 4; return 16 + b * 128 + (dir ? 127 - s2 : s2);
}
__device__ __forceinline__ float wave_incl_prefix(float v, int lane) {
#pragma unroll
    for (int o = 1; o < 64; o <<= 1) { const float t = __shfl_up(v, o); if (lane >= o) v += t; }
    return v;
}
__device__ __forceinline__ float wave_incl_suffix(float v, int lane) {
#pragma unroll
    for (int o = 1; o < 64; o <<= 1) { const float t = __shfl_down(v, o); if (lane + o < 64) v += t; }
    return v;
}
__device__ __forceinline__ float wave_prefix_max(float v, int lane) {
#pragma unroll
    for (int o = 1; o < 64; o <<= 1) { const float t = __shfl_up(v, o); if (lane >= o) v = fmaxf(v, t); }
    return v;
}
__device__ __forceinline__ float wave_suffix_max(float v, int lane) {
#pragma unroll
    for (int o = 1; o < 64; o <<= 1) { const float t = __shfl_down(v, o); if (lane + o < 64) v = fmaxf(v, t); }
    return v;
}
__device__ __forceinline__ float wave_max(float v) {
#pragma unroll
    for (int o = 32; o > 0; o >>= 1) v = fmaxf(v, __shfl_xor(v, o));
    return v;
}
__device__ __forceinline__ bf16x8 lds_frag(const bf16_t* base, int row, int kofs) { return *(const bf16x8*)(base + row * LP + kofs); }
__device__ __forceinline__ bf16_t f2bf(float x) { return (bf16_t)(cvt_pk_bf16(x, 0.f) & 0xffffu); }

struct L0Args {
    const bf16_t* z;
    const float* ml_conv; const float* gate_b; const float* ret_decay; const float* ret_norm; const float* ml_norm;
    bf16_t* RQ; bf16_t* RK; bf16_t* MQ; bf16_t* MK;
    float* LIF;
    bf16_t* ST;
    float* CM;
    float* MI;
    bf16_t* MG;
};

__device__ __forceinline__ void ph_l0_prep(const L0Args& a) {
    const int tfz = tid_fresh(); const int wid = tfz >> 6, lane = tfz & 63;
    for (int r = blockIdx.x * 8 + wid; r < NTOK; r += gridDim.x * 8) {
        const RowInfo ri = row_info(r);
        const bf16_t* zc = a.z + (size_t)r * AB_IN;
        {
            const int h = lane >> 4, hf = (lane >> 3) & 1, j0 = (lane & 7) * 4;
            const f32x4 q1 = ldz4(zc + h * 64 + j0), q2 = ldz4(zc + h * 64 + 32 + j0);
            const f32x4 k1 = ldz4(zc + 256 + h * 64 + j0), k2 = ldz4(zc + 256 + h * 64 + 32 + j0);
            f32x4 qo, ko;
            if (r >= NCTX) {
#pragma unroll
                for (int x = 0; x < 4; ++x) {
                    const int j = j0 + x;
                    const float pos = (j < 16) ? (float)(ri.t >> 6) : (float)(ri.t & 63);
                    const float inv = exp2f(-(float)(j & 15) * 0.83048202372184059f);
                    const float ang = pos * inv;
                    const float cs = __cosf(ang), sn = __sinf(ang);
                    qo[x] = hf ? (q1[x] * sn + q2[x] * cs) : (q1[x] * cs - q2[x] * sn);
                    ko[x] = hf ? (k1[x] * sn + k2[x] * cs) : (k1[x] * cs - k2[x] * sn);
                }
            } else { qo = hf ? q2 : q1; ko = hf ? k2 : k1; }
            const int d0 = h * 64 + hf * 32 + j0;
            st_bf16x4(a.RQ + (size_t)r * 256 + d0, qo[0], qo[1], qo[2], qo[3]);
            st_bf16x4(a.RK + (size_t)r * 256 + d0, ko[0] * 0.125f, ko[1] * 0.125f, ko[2] * 0.125f, ko[3] * 0.125f);
        }
#pragma unroll
        for (int rep = 0; rep < 2; ++rep) {
            const int ch = rep * 256 + lane * 4;
            f32x4 cv = ldz4(zc + 1536 + ch) * *(const f32x4*)(a.ml_conv + 512 + ch);
            if (ri.t > 0) cv += ldz4(zc + 1536 + ch - AB_IN) * *(const f32x4*)(a.ml_conv + ch);
            if (ri.t < ri.len - 1) cv += ldz4(zc + 1536 + ch + AB_IN) * *(const f32x4*)(a.ml_conv + 1024 + ch);
            float o[4];
#pragma unroll
            for (int x = 0; x < 4; ++x) o[x] = cv[x] * frcp_(1.0f + __expf(-cv[x])) * (rep == 0 ? 0.125f : 1.0f);
            st_bf16x4((rep == 0 ? a.MQ : a.MK) + (size_t)r * 256 + lane * 4, o[0], o[1], o[2], o[3]);
        }
        if (lane < 16) {
            const float val = ldz(zc + 3072 + lane) + a.gate_b[lane];
            const int d = lane >> 3, gi = (lane >> 2) & 1, h = lane & 3;
            a.LIF[(size_t)r * 16 + gi * 8 + d * 4 + h] = gi ? logsigmoidf_(val) : val;
        }
    }
}

__device__ __forceinline__ void ph_l0_local(const L0Args& a) {
    bf16_t* KT = (bf16_t*)g_shm;
    bf16_t* VT = (bf16_t*)(g_shm + 4 * 64 * LP * 2);
    float* SC = (float*)(g_shm + 4 * 64 * LP * 2 + 2 * 128 * LP * 2);
    const int tid = tid_fresh(), wid = tid >> 6, lane = tid & 63, fr = lane & 15, fq = lane >> 4;
    const int kd = tid & 63, jg = tid >> 6, dv = tid & 127, vg = tid >> 7;
    bf16_t pk[2][8], pv[2][16]; float pli = 0.f, plf = 0.f;
    auto prefetch = [&](int it) {
        const int g = it >> 2, h = it & 3, row0 = g * 64;
#pragma unroll
        for (int ty = 0; ty < 2; ++ty) {
            const bf16_t* src = (ty ? a.MK : a.RK) + (size_t)(row0 + jg * 8) * 256 + h * 64 + kd;
#pragma unroll
            for (int x = 0; x < 8; ++x) pk[ty][x] = src[(size_t)x * 256];
            const bf16_t* sv = a.z + (size_t)(row0 + vg * 16) * AB_IN + (ty ? 2048 : 512) + h * 128 + dv;
#pragma unroll
            for (int x = 0; x < 16; ++x) pv[ty][x] = sv[(size_t)x * AB_IN];
        }
        if (wid == 1 || wid == 2) { const int dir = wid - 1; pli = a.LIF[(size_t)(row0 + lane) * 16 + dir * 4 + h]; plf = a.LIF[(size_t)(row0 + lane) * 16 + 8 + dir * 4 + h]; }
    };
    if ((int)blockIdx.x < NCHUNK * 4) prefetch(blockIdx.x);
    for (int it = blockIdx.x; it < NCHUNK * 4; it += gridDim.x) {
        const int g = it >> 2, h = it & 3;
        __syncthreads();
        if (wid == 0) {
            const float l2f = log2f(1.0f - expf(a.ret_decay[h])), l2b = log2f(1.0f - expf(a.ret_decay[4 + h]));
            SC[lane] = exp2f((float)(63 - lane) * l2f);
            SC[64 + lane] = exp2f((float)lane * l2b);
        } else if (wid == 1 || wid == 2) {
            const int dir = wid - 1;
            const float bc = dir ? wave_incl_suffix(plf, lane) : wave_incl_prefix(plf, lane);
            const float btot = __shfl(bc, dir ? 0 : 63);
            const float lw = btot - bc + pli;
            const float mloc = wave_max(lw);
            SC[(2 + dir) * 64 + lane] = fexp_(lw - mloc);
            if (lane == 0) { float* cm = a.CM + ((size_t)(dir * 4 + h) * NCHUNK + g) * 2; cm[0] = btot; cm[1] = mloc; }
        }
        __syncthreads();
#pragma unroll
        for (int ty = 0; ty < 2; ++ty) {
#pragma unroll
            for (int dir = 0; dir < 2; ++dir) {
                const float* sc = SC + (ty * 2 + dir) * 64 + jg * 8;
                u32x4 o;
                o.x = cvt_pk_bf16(bf16_to_f32(pk[ty][0]) * sc[0], bf16_to_f32(pk[ty][1]) * sc[1]); o.y = cvt_pk_bf16(bf16_to_f32(pk[ty][2]) * sc[2], bf16_to_f32(pk[ty][3]) * sc[3]);
                o.z = cvt_pk_bf16(bf16_to_f32(pk[ty][4]) * sc[4], bf16_to_f32(pk[ty][5]) * sc[5]); o.w = cvt_pk_bf16(bf16_to_f32(pk[ty][6]) * sc[6], bf16_to_f32(pk[ty][7]) * sc[7]);
                *(u32x4*)(KT + (ty * 2 + dir) * 64 * LP + (((kd >> 2) & 3) * 16 + (kd >> 4) * 4 + (kd & 3)) * LP + jg * 8) = o;
            }
            u32x4 o0, o1;
            o0.x = (unsigned)pv[ty][0] | ((unsigned)pv[ty][1] << 16); o0.y = (unsigned)pv[ty][2] | ((unsigned)pv[ty][3] << 16);
            o0.z = (unsigned)pv[ty][4] | ((unsigned)pv[ty][5] << 16); o0.w = (unsigned)pv[ty][6] | ((unsigned)pv[ty][7] << 16);
            o1.x = (unsigned)pv[ty][8] | ((unsigned)pv[ty][9] << 16); o1.y = (unsigned)pv[ty][10] | ((unsigned)pv[ty][11] << 16);
            o1.z = (unsigned)pv[ty][12] | ((unsigned)pv[ty][13] << 16); o1.w = (unsigned)pv[ty][14] | ((unsigned)pv[ty][15] << 16);
            *(u32x4*)(VT + ty * 128 * LP + dv * LP + vg * 16) = o0;
            *(u32x4*)(VT + ty * 128 * LP + dv * LP + vg * 16 + 8) = o1;
        }
        if (it + (int)gridDim.x < NCHUNK * 4) prefetch(it + gridDim.x);
        __syncthreads();
#pragma unroll
        for (int ty = 0; ty < 2; ++ty) {
            const bf16x8 v0 = lds_frag(VT + ty * 128 * LP, wid * 16 + fr, fq * 8), v1 = lds_frag(VT + ty * 128 * LP, wid * 16 + fr, 32 + fq * 8);
#pragma unroll
            for (int dir = 0; dir < 2; ++dir) {
                const bf16_t* kt = KT + (ty * 2 + dir) * 64 * LP;
                bf16_t* st = a.ST + rec_off(ty, dir, h, g) + (size_t)(wid * 16 + fr) * 64 + fq * 16;
#pragma unroll
                for (int dp = 0; dp < 2; ++dp) {
                    f32x4 acc0 = {0.f, 0.f, 0.f, 0.f}, acc1 = {0.f, 0.f, 0.f, 0.f};
                    acc0 = __builtin_amdgcn_mfma_f32_16x16x32_bf16(lds_frag(kt, (2 * dp) * 16 + fr, fq * 8), v0, acc0, 0, 0, 0);
                    acc0 = __builtin_amdgcn_mfma_f32_16x16x32_bf16(lds_frag(kt, (2 * dp) * 16 + fr, 32 + fq * 8), v1, acc0, 0, 0, 0);
                    acc1 = __builtin_amdgcn_mfma_f32_16x16x32_bf16(lds_frag(kt, (2 * dp + 1) * 16 + fr, fq * 8), v0, acc1, 0, 0, 0);
                    acc1 = __builtin_amdgcn_mfma_f32_16x16x32_bf16(lds_frag(kt, (2 * dp + 1) * 16 + fr, 32 + fq * 8), v1, acc1, 0, 0, 0);
                    st_bf16x8(st + dp * 8, acc0[0], acc0[1], acc0[2], acc0[3], acc1[0], acc1[1], acc1[2], acc1[3]);
                }
            }
        }
        if (tid < 128) {
            const int dir = tid >> 6, d = tid & 63;
            const bf16_t* kt = KT + (2 + dir) * 64 * LP + (((d >> 2) & 3) * 16 + (d >> 4) * 4 + (d & 3)) * LP;
            float sum = 0.f;
#pragma unroll 16
            for (int j = 0; j < 64; ++j) sum += bf16_to_f32(kt[j]);
            ((float*)(a.ST + rec_off(1, dir, h, g) + 8192))[d] = sum;
        }
    }
}

__device__ __forceinline__ void ph_l0_prop(const L0Args& a) {
    for (int idx = blockIdx.x * NTHR + tid_fresh(); idx < 64 * 2064; idx += gridDim.x * NTHR) {
        const int seq = idx / 2064, e4 = idx % 2064;
        const int ty = seq >> 5, dir = (seq >> 4) & 1, h = (seq >> 2) & 3, b = seq & 3;
        if (ty == 0 && e4 >= 2048) continue;
        const bool isn = e4 >= 2048;
        f32x4 S = {0.f, 0.f, 0.f, 0.f};
        float m = 0.f;
        const float g64 = exp2f(64.0f * log2f(1.0f - expf(a.ret_decay[dir * 4 + h])));
        for (int s0 = 0; s0 < 132; s0 += 12) {
            f32x4 loc[12]; float bt[12], ml[12];
#pragma unroll
            for (int i = 0; i < 12; ++i) {
                const int g = chunk_g(b, dir, s0 + i);
                bf16_t* rp = a.ST + rec_off(ty, dir, h, g);
                if (isn) loc[i] = *(const f32x4*)((const float*)(rp + 8192) + (e4 - 2048) * 4); else loc[i] = ldz4(rp + (size_t)e4 * 4);
                if (ty == 1) { const float* cm = a.CM + ((size_t)(dir * 4 + h) * NCHUNK + g) * 2; bt[i] = cm[0]; ml[i] = cm[1]; } else { bt[i] = 0.f; ml[i] = 0.f; }
            }
#pragma unroll
            for (int i = 0; i < 12; ++i) {
                const int g = chunk_g(b, dir, s0 + i);
                float dec, wl;
                if (ty == 0) { dec = g64; wl = 1.0f; }
                else {
                    const float mn = fmaxf(bt[i] + m, ml[i]);
                    dec = expf(bt[i] + m - mn); wl = expf(ml[i] - mn);
                    if (e4 == 0) a.MI[(size_t)(dir * 4 + h) * NCHUNK + g] = m;
                    m = mn;
                }
                bf16_t* rp = a.ST + rec_off(ty, dir, h, g);
                if (isn) *(f32x4*)((float*)(rp + 8192) + (e4 - 2048) * 4) = S; else st_bf16x4(rp + (size_t)e4 * 4, S[0], S[1], S[2], S[3]);
                S = S * dec + loc[i] * wl;
            }
        }
    }
}

__device__ __forceinline__ void ph_l0_out(const L0Args& a) {
    bf16_t* Qs = (bf16_t*)g_shm;
    bf16_t* Ks = Qs + 64 * LP;
    bf16_t* ATT = Ks + 64 * LP;
    bf16_t* VT = ATT + 64 * LP;
    bf16_t* SF = VT + 128 * LP;
    bf16_t* SB = SF + 144 * LP;
    float* FV = (float*)(SB + 144 * LP);
    const int tid = tid_fresh(), wid = tid >> 6, lane = tid & 63, fr = lane & 15, fq = lane >> 4;
    u32x4 pq, pkk; bf16_t pv[16]; float pli = 0.f, plf = 0.f, pmi = 0.f;
    auto prefetch = [&](int it) {
        const int ty = it & 1, h = (it >> 1) & 3, g = it >> 3, row0 = g * 64;
        const int tp = tid_fresh();
        const int i = tp >> 3, c8 = tp & 7;
        const size_t go = (size_t)(row0 + i) * 256 + h * 64 + c8 * 8;
        pq = *(const u32x4*)((ty ? a.MQ : a.RQ) + go);
        pkk = *(const u32x4*)((ty ? a.MK : a.RK) + go);
        const int dv = tp & 127, vg = tp >> 7;
        const bf16_t* src = a.z + (size_t)(row0 + vg * 16) * AB_IN + (ty ? 2048 : 512) + h * 128 + dv;
#pragma unroll
        for (int x = 0; x < 16; ++x) pv[x] = src[(size_t)x * AB_IN];
        if (ty == 1 && tp < 128) {
            const int w2 = tp >> 6, l2 = tp & 63;
            pli = a.LIF[(size_t)(row0 + l2) * 16 + w2 * 4 + h]; plf = a.LIF[(size_t)(row0 + l2) * 16 + 8 + w2 * 4 + h];
            pmi = a.MI[(size_t)(w2 * 4 + h) * NCHUNK + g];
        }
    };
    if ((int)blockIdx.x < NCHUNK * 8) prefetch(blockIdx.x);
    for (int it = blockIdx.x; it < NCHUNK * 8; it += gridDim.x) {
        const int ty = it & 1, h = (it >> 1) & 3, g = it >> 3, row0 = g * 64;
        __syncthreads();
        {
            const int ts = tid_fresh();
            const int i = ts >> 3, c8 = ts & 7;
            *(u32x4*)(Qs + i * LP + c8 * 8) = pq;
            *(u32x4*)(Ks + i * LP + c8 * 8) = pkk;
            const int dv = ts & 127, vg = ts >> 7;
            u32x4 o0, o1;
            o0.x = (unsigned)pv[0] | ((unsigned)pv[1] << 16); o0.y = (unsigned)pv[2] | ((unsigned)pv[3] << 16); o0.z = (unsigned)pv[4] | ((unsigned)pv[5] << 16); o0.w = (unsigned)pv[6] | ((unsigned)pv[7] << 16);
            o1.x = (unsigned)pv[8] | ((unsigned)pv[9] << 16); o1.y = (unsigned)pv[10] | ((unsigned)pv[11] << 16); o1.z = (unsigned)pv[12] | ((unsigned)pv[13] << 16); o1.w = (unsigned)pv[14] | ((unsigned)pv[15] << 16);
            *(u32x4*)(VT + dv * LP + vg * 16) = o0;
            *(u32x4*)(VT + dv * LP + vg * 16 + 8) = o1;
            if (ts < 2 * 16 * 8) {
                const int dir = ts >> 7, rr = (ts >> 3) & 15, c = ts & 7;
                u32x4 o = {0u, 0u, 0u, 0u};
                if (ty == 1 && rr == 0) {
                    const float* np = (const float*)(a.ST + rec_off(1, dir, h, g) + 8192) + c * 8;
                    o.x = cvt_pk_bf16(np[0], np[1]); o.y = cvt_pk_bf16(np[2], np[3]); o.z = cvt_pk_bf16(np[4], np[5]); o.w = cvt_pk_bf16(np[6], np[7]);
                }
                *(u32x4*)((dir ? SB : SF) + (128 + rr) * LP + c * 8) = o;
            }
            if (ty == 1 && wid < 2) {
                const int dir = wid;
                const float bc = dir ? wave_incl_suffix(plf, lane) : wave_incl_prefix(plf, lane);
                const float aj = pli - bc;
                const float pm = dir ? wave_suffix_max(aj, lane) : wave_prefix_max(aj, lane);
                const float M = fmaxf(pmi, pm);
                float* fv = FV + dir * 256;
                fv[lane] = M; fv[64 + lane] = aj; fv[128 + lane] = fexp_(pmi - M); fv[192 + lane] = fexp_(-(bc + M));
            }
        }
        u32x4 ps[2][2];
        {
            const int tq = tid_fresh();
            const int sdv = tq >> 2, sd = (tq & 3) * 16;
#pragma unroll
            for (int dir = 0; dir < 2; ++dir) {
                const bf16_t* sp = a.ST + rec_off(ty, dir, h, g) + (size_t)sdv * 64 + sd;
                ps[dir][0] = *(const u32x4*)sp; ps[dir][1] = *(const u32x4*)(sp + 8);
            }
        }
        __syncthreads();
        const float l2f = (ty == 0) ? log2f(1.0f - expf(a.ret_decay[h])) : 0.f;
        const float l2b = (ty == 0) ? log2f(1.0f - expf(a.ret_decay[4 + h])) : 0.f;
        f32x4 otot[4];
#pragma unroll
        for (int x = 0; x < 4; ++x) otot[x] = (f32x4){0.f, 0.f, 0.f, 0.f};
        const int ndir = (ty == 0) ? 1 : 2;
        for (int pass = 0; pass < ndir; ++pass) {
            {
                const int itl = wid >> 1;
                const bf16x8 q0 = lds_frag(Qs, itl * 16 + fr, fq * 8), q1 = lds_frag(Qs, itl * 16 + fr, 32 + fq * 8);
                float rs = 0.f;
                const int i = itl * 16 + fr;
#pragma unroll
                for (int jj = 0; jj < 2; ++jj) {
                    const int jt = (wid & 1) * 2 + jj;
                    f32x4 acc = {0.f, 0.f, 0.f, 0.f};
                    acc = __builtin_amdgcn_mfma_f32_16x16x32_bf16(lds_frag(Ks, jt * 16 + fr, fq * 8), q0, acc, 0, 0, 0);
                    acc = __builtin_amdgcn_mfma_f32_16x16x32_bf16(lds_frag(Ks, jt * 16 + fr, 32 + fq * 8), q1, acc, 0, 0, 0);
                    float sv[4];
#pragma unroll
                    for (int r = 0; r < 4; ++r) {
                        const int j = jt * 16 + fq * 4 + r;
                        float dcy;
                        if (ty == 0) {
                            dcy = ((j <= i) ? exp2f((float)(i - j) * l2f) : 0.f) + ((j >= i) ? exp2f((float)(j - i) * l2b) : 0.f);
                        } else {
                            const float* fv = FV + pass * 256;
                            const bool ok = pass ? (j >= i) : (j <= i);
                            dcy = ok ? fexp_(fv[64 + j] - fv[i]) : 0.f;
                        }
                        sv[r] = acc[r] * dcy;
                        rs += sv[r];
                    }
                    u32x2 w; w.x = cvt_pk_bf16(sv[0], sv[1]); w.y = cvt_pk_bf16(sv[2], sv[3]);
                    *(u32x2*)(ATT + i * LP + jt * 16 + fq * 4) = w;
                }
                if (ty == 1) {
                    rs += __shfl_xor(rs, 16); rs += __shfl_xor(rs, 32);
                    if (fq == 0) FV[512 + (pass * 2 + (wid & 1)) * 64 + i] = rs;
                }
            }
            if (pass == 0) {
                const int tq = tid_fresh();
                const int sdv = tq >> 2, sd = (tq & 3) * 16;
#pragma unroll
                for (int dir = 0; dir < 2; ++dir) {
                    bf16_t* dst = (dir ? SB : SF) + sdv * LP + sd;
                    *(u32x4*)dst = ps[dir][0]; *(u32x4*)(dst + 8) = ps[dir][1];
                }
                if (it + (int)gridDim.x < NCHUNK * 8) prefetch(it + gridDim.x);
            }
            __syncthreads();
            {
                const bf16x8 v0 = lds_frag(VT, wid * 16 + fr, fq * 8), v1 = lds_frag(VT, wid * 16 + fr, 32 + fq * 8);
                const bf16_t* S1 = (ty == 0) ? SF : (pass ? SB : SF);
                const bf16x8 sf0 = lds_frag(S1, wid * 16 + fr, fq * 8), sf1 = lds_frag(S1, wid * 16 + fr, 32 + fq * 8);
                bf16x8 sb0 = sf0, sb1 = sf1;
                if (ty == 0) { sb0 = lds_frag(SB, wid * 16 + fr, fq * 8); sb1 = lds_frag(SB, wid * 16 + fr, 32 + fq * 8); }
                if (ty == 1 && wid == 0) {
                    const bf16x8 n0 = lds_frag(S1, 128 + fr, fq * 8), n1 = lds_frag(S1, 128 + fr, 32 + fq * 8);
#pragma unroll
                    for (int tt = 0; tt < 4; ++tt) {
                        f32x4 an = {0.f, 0.f, 0.f, 0.f};
                        an = __builtin_amdgcn_mfma_f32_16x16x32_bf16(n0, lds_frag(Qs, tt * 16 + fr, fq * 8), an, 0, 0, 0);
                        an = __builtin_amdgcn_mfma_f32_16x16x32_bf16(n1, lds_frag(Qs, tt * 16 + fr, 32 + fq * 8), an, 0, 0, 0);
                        if (fq == 0) FV[768 + pass * 64 + tt * 16 + fr] = an[0];
                    }
                }
                if (ty == 1) __syncthreads();
#pragma unroll
                for (int tt = 0; tt < 4; ++tt) {
                    const bf16x8 a0 = lds_frag(ATT, tt * 16 + fr, fq * 8), a1 = lds_frag(ATT, tt * 16 + fr, 32 + fq * 8);
                    const bf16x8 qq0 = lds_frag(Qs, tt * 16 + fr, fq * 8), qq1 = lds_frag(Qs, tt * 16 + fr, 32 + fq * 8);
                    f32x4 ao = {0.f, 0.f, 0.f, 0.f}, af = {0.f, 0.f, 0.f, 0.f}, ab = {0.f, 0.f, 0.f, 0.f};
                    ao = __builtin_amdgcn_mfma_f32_16x16x32_bf16(v0, a0, ao, 0, 0, 0);
                    ao = __builtin_amdgcn_mfma_f32_16x16x32_bf16(v1, a1, ao, 0, 0, 0);
                    af = __builtin_amdgcn_mfma_f32_16x16x32_bf16(sf0, qq0, af, 0, 0, 0);
                    af = __builtin_amdgcn_mfma_f32_16x16x32_bf16(sf1, qq1, af, 0, 0, 0);
                    const int i = tt * 16 + fr;
                    if (ty == 0) {
                        ab = __builtin_amdgcn_mfma_f32_16x16x32_bf16(sb0, qq0, ab, 0, 0, 0);
                        ab = __builtin_amdgcn_mfma_f32_16x16x32_bf16(sb1, qq1, ab, 0, 0, 0);
                        const float wf = exp2f((float)(i + 1) * l2f), wb = exp2f((float)(64 - i) * l2b);
                        otot[tt] += ao + af * wf + ab * wb;
                    } else {
                        const float* fv = FV + pass * 256;
                        const float wint = fv[128 + i], eden = fv[192 + i];
                        const float den = wint * FV[768 + pass * 64 + i] + FV[512 + (pass * 2) * 64 + i] + FV[512 + (pass * 2 + 1) * 64 + i];
                        const float inv = frcp_(fmaxf(fabsf(den), eden));
                        otot[tt] += (ao + af * wint) * inv;
                    }
                }
            }
            if (ty == 1) __syncthreads();
        }
        {
            float* ssw = FV + 896;
#pragma unroll
            for (int tt = 0; tt < 4; ++tt) {
                float ss = otot[tt][0] * otot[tt][0] + otot[tt][1] * otot[tt][1] + otot[tt][2] * otot[tt][2] + otot[tt][3] * otot[tt][3];
                ss += __shfl_xor(ss, 16); ss += __shfl_xor(ss, 32);
                if (fq == 0) ssw[wid * 64 + tt * 16 + fr] = ss;
            }
            __syncthreads();
            const float* nw = (ty ? a.ml_norm : a.ret_norm) + h * 128 + wid * 16 + fq * 4;
            const f32x4 nv = *(const f32x4*)nw;
#pragma unroll
            for (int tt = 0; tt < 4; ++tt) {
                const int i = tt * 16 + fr;
                float tot = 0.f;
#pragma unroll
                for (int w = 0; w < 8; ++w) tot += ssw[w * 64 + i];
                const float rsn = rsqrtf(tot * (1.0f / 128.0f) + EPSF);
                const f32x4 gz = ldz4(a.z + (size_t)(row0 + i) * AB_IN + (ty ? 2560 : 1024) + h * 128 + wid * 16 + fq * 4);
                float o[4];
#pragma unroll
                for (int r = 0; r < 4; ++r) {
                    const float gate = ty ? fsigmoid_(gz[r]) : gz[r] * fsigmoid_(gz[r]);
                    o[r] = otot[tt][r] * rsn * nv[r] * gate;
                }
                st_bf16x4(a.MG + (size_t)(row0 + i) * DM + ty * 512 + h * 128 + wid * 16 + fq * 4, o[0], o[1], o[2], o[3]);
            }
        }
    }
}


#define LP2 136
#define HREC 16384
struct L1Args {
    const bf16_t* z;
    const float* hgrn_lb; const float* hg_norm;
    bf16_t* HST;
    float* HDEC;
    bf16_t* MG;
    const float* shift; const float* w0; const float* w2; const float* a0; const float* a2; const float* g2;
    const float* kk_scale; const float* k_a; const float* r_k; const float* rw_norm;
    bf16_t* PKK; bf16_t* PV;
    float* PG;
    float* PW;
    bf16_t* PAB; bf16_t* PKE; bf16_t* PWR;
    float* PSC;
    float* PBON;
    float* RWO;
    bf16_t* WLR;
};
__device__ __forceinline__ size_t hrec_off(int dir, int h, int g) { return ((size_t)((dir * 4 + h) * NCHUNK + g)) * HREC; }
__device__ __forceinline__ bf16x8 lds_frag2(const bf16_t* base, int row, int kofs) { return *(const bf16x8*)(base + row * LP2 + kofs); }

__device__ __forceinline__ void ph_l1_local(const L1Args& a, int bi, int nb) {
    bf16_t* KD = (bf16_t*)g_shm;
    bf16_t* VT = KD + 2 * 128 * LP;
    bf16_t* RAW = VT + 128 * LP;
    const int tid = tid_fresh(), wid = tid >> 6, lane = tid & 63, fr = lane & 15, fq = lane >> 4;
    u32x4 praw[4]; bf16_t pv[16];
    auto prefetch = [&](int it) {
        const int g = it >> 2, h = it & 3, row0 = g * 64;
        const int tp = tid_fresh();
#pragma unroll
        for (int c = 0; c < 4; ++c) {
            const int idx = tp + NTHR * c, dir = idx >> 10, j = (idx >> 4) & 63, c8 = idx & 15;
            praw[c] = *(const u32x4*)(a.z + (size_t)(row0 + j) * CD_IN + 512 + dir * 512 + h * 128 + c8 * 8);
        }
        const int dv = tp & 127, vg = tp >> 7;
        const bf16_t* src = a.z + (size_t)(row0 + vg * 16) * CD_IN + 1536 + h * 128 + dv;
#pragma unroll
        for (int x = 0; x < 16; ++x) pv[x] = src[(size_t)x * CD_IN];
    };
    if (bi < NCHUNK * 4) prefetch(bi);
    for (int it = bi; it < NCHUNK * 4; it += nb) {
        const int g = it >> 2, h = it & 3;
        __syncthreads();
        {
            const int ts = tid_fresh();
#pragma unroll
            for (int c = 0; c < 4; ++c) {
                const int idx = ts + NTHR * c, dir = idx >> 10, j = (idx >> 4) & 63, c8 = idx & 15;
                *(u32x4*)(RAW + (dir * 64 + j) * 128 + c8 * 8) = praw[c];
            }
            const int dv = ts & 127, vg = ts >> 7;
            u32x4 o0, o1;
            o0.x = (unsigned)pv[0] | ((unsigned)pv[1] << 16); o0.y = (unsigned)pv[2] | ((unsigned)pv[3] << 16); o0.z = (unsigned)pv[4] | ((unsigned)pv[5] << 16); o0.w = (unsigned)pv[6] | ((unsigned)pv[7] << 16);
            o1.x = (unsigned)pv[8] | ((unsigned)pv[9] << 16); o1.y = (unsigned)pv[10] | ((unsigned)pv[11] << 16); o1.z = (unsigned)pv[12] | ((unsigned)pv[13] << 16); o1.w = (unsigned)pv[14] | ((unsigned)pv[15] << 16);
            *(u32x4*)(VT + dv * LP + vg * 16) = o0;
            *(u32x4*)(VT + dv * LP + vg * 16 + 8) = o1;
        }
        if (it + nb < NCHUNK * 4) prefetch(it + nb);
        __syncthreads();
        if (tid < 256) {
            const int dir = tid >> 7, d = tid & 127;
            const float p0 = a.hgrn_lb[h * 128 + d], p1 = a.hgrn_lb[512 + h * 128 + d];
            const float lb = 1.0f / (1.0f + expf(p0 - p1));
            const bf16_t* raw = RAW + dir * 64 * 128 + d;
            float E = 0.f;
            bf16_t* kd = KD + (dir * 128 + (((d >> 2) & 7) * 16 + (d >> 5) * 4 + (d & 3))) * LP;
#pragma unroll 8
            for (int s2 = 0; s2 < 64; ++s2) {
                const int j = dir ? s2 : 63 - s2;
                const float f = lb + (1.0f - lb) * fsigmoid_(bf16_to_f32(raw[j * 128]));
                kd[j] = f2bf((1.0f - f) * fexp_(E));
                E += flog_(f);
            }
            a.HDEC[((size_t)(dir * 4 + h) * NCHUNK + g) * 128 + d] = expf(E);
        }
        __syncthreads();
        const bf16x8 v0 = lds_frag(VT, wid * 16 + fr, fq * 8), v1 = lds_frag(VT, wid * 16 + fr, 32 + fq * 8);
#pragma unroll
        for (int dir = 0; dir < 2; ++dir) {
            bf16_t* st = a.HST + hrec_off(dir, h, g) + (size_t)(wid * 16 + fr) * 128 + fq * 32;
#pragma unroll
            for (int dp = 0; dp < 4; ++dp) {
                f32x4 acc0 = {0.f, 0.f, 0.f, 0.f}, acc1 = {0.f, 0.f, 0.f, 0.f};
                acc0 = __builtin_amdgcn_mfma_f32_16x16x32_bf16(lds_frag(KD + dir * 128 * LP, (2 * dp) * 16 + fr, fq * 8), v0, acc0, 0, 0, 0);
                acc0 = __builtin_amdgcn_mfma_f32_16x16x32_bf16(lds_frag(KD + dir * 128 * LP, (2 * dp) * 16 + fr, 32 + fq * 8), v1, acc0, 0, 0, 0);
                acc1 = __builtin_amdgcn_mfma_f32_16x16x32_bf16(lds_frag(KD + dir * 128 * LP, (2 * dp + 1) * 16 + fr, fq * 8), v0, acc1, 0, 0, 0);
                acc1 = __builtin_amdgcn_mfma_f32_16x16x32_bf16(lds_frag(KD + dir * 128 * LP, (2 * dp + 1) * 16 + fr, 32 + fq * 8), v1, acc1, 0, 0, 0);
                st_bf16x8(st + dp * 8, acc0[0], acc0[1], acc0[2], acc0[3], acc1[0], acc1[1], acc1[2], acc1[3]);
            }
        }
    }
}
__device__ __forceinline__ void ph_l1_prop(const L1Args& a, int bi, int nb) {
    const int stride = nb * NTHR;
    for (int idx = bi * NTHR + tid_fresh(); idx < 32 * (HREC / 4); idx += 2 * stride) {
        const int idx2 = idx + stride;
        const bool two = idx2 < 32 * (HREC / 4);
        const int seq = idx / (HREC / 4), e4 = idx % (HREC / 4);
        const int dir = seq >> 4, h = (seq >> 2) & 3, b = seq & 3;
        const int seq2 = two ? idx2 / (HREC / 4) : seq, e42 = two ? idx2 % (HREC / 4) : e4;
        const int dir2 = seq2 >> 4, h2 = (seq2 >> 2) & 3, b2 = seq2 & 3;
        const int d4 = (e4 & 31) * 4, d42 = (e42 & 31) * 4;
        f32x4 S = {0.f, 0.f, 0.f, 0.f}, T = {0.f, 0.f, 0.f, 0.f};
        for (int s0 = 0; s0 < 132; s0 += 12) {
            u32x2 la[12], lb[12]; f32x4 da[12], db[12];
#pragma unroll
            for (int i = 0; i < 12; ++i) {
                const int g = chunk_g(b, dir, s0 + i), g2 = chunk_g(b2, dir2, s0 + i);
                la[i] = *(const u32x2*)(a.HST + hrec_off(dir, h, g) + (size_t)e4 * 4);
                da[i] = *(const f32x4*)(a.HDEC + ((size_t)(dir * 4 + h) * NCHUNK + g) * 128 + d4);
                lb[i] = *(const u32x2*)(a.HST + hrec_off(dir2, h2, g2) + (size_t)e42 * 4);
                db[i] = *(const f32x4*)(a.HDEC + ((size_t)(dir2 * 4 + h2) * NCHUNK + g2) * 128 + d42);
            }
#pragma unroll
            for (int i = 0; i < 12; ++i) {
                const int g = chunk_g(b, dir, s0 + i), g2 = chunk_g(b2, dir2, s0 + i);
                f32x4 la4, lb4;
                la4[0] = __uint_as_float(la[i].x << 16); la4[1] = __uint_as_float(la[i].x & 0xffff0000u); la4[2] = __uint_as_float(la[i].y << 16); la4[3] = __uint_as_float(la[i].y & 0xffff0000u);
                lb4[0] = __uint_as_float(lb[i].x << 16); lb4[1] = __uint_as_float(lb[i].x & 0xffff0000u); lb4[2] = __uint_as_float(lb[i].y << 16); lb4[3] = __uint_as_float(lb[i].y & 0xffff0000u);
                st_bf16x4(a.HST + hrec_off(dir, h, g) + (size_t)e4 * 4, S[0], S[1], S[2], S[3]);
                S = S * da[i] + la4;
                if (two) st_bf16x4(a.HST + hrec_off(dir2, h2, g2) + (size_t)e42 * 4, T[0], T[1], T[2], T[3]);
                T = T * db[i] + lb4;
            }
        }
    }
}
__device__ __forceinline__ void ph_l1_out(const L1Args& a, int bi, int nb) {
    bf16_t* QA = (bf16_t*)g_shm;
    bf16_t* R2 = QA + 2 * 64 * LP2;
    bf16_t* ATT = R2 + 2 * 128 * LP2;
    bf16_t* VT = ATT + 64 * LP;
    float* ssw = (float*)(VT + 128 * LP);
    bf16_t* RAWF = R2 + 128 * LP2;
    bf16_t* RAWQ = ATT;
    const int tid = tid_fresh(), wid = tid >> 6, lane = tid & 63, fr = lane & 15, fq = lane >> 4;
    u32x4 praw[6]; bf16_t pv[16];
    auto prefetch = [&](int it) {
        const int g = it >> 2, h = it & 3, row0 = g * 64;
        const int tp = tid_fresh();
#pragma unroll
        for (int c = 0; c < 6; ++c) {
            const int idx = tp + NTHR * c, arr = idx >> 10, j = (idx >> 4) & 63, c8 = idx & 15;
            praw[c] = *(const u32x4*)(a.z + (size_t)(row0 + j) * CD_IN + (arr < 2 ? 512 + arr * 512 : 0) + h * 128 + c8 * 8);
        }
        const int dv = tp & 127, vg = tp >> 7;
        const bf16_t* src = a.z + (size_t)(row0 + vg * 16) * CD_IN + 1536 + h * 128 + dv;
#pragma unroll
        for (int x = 0; x < 16; ++x) pv[x] = src[(size_t)x * CD_IN];
    };
    if (bi < NCHUNK * 4) prefetch(bi);
    for (int it = bi; it < NCHUNK * 4; it += nb) {
        const int g = it >> 2, h = it & 3, row0 = g * 64;
        __syncthreads();
        {
            const int ts = tid_fresh();
#pragma unroll
            for (int c = 0; c < 6; ++c) {
                const int idx = ts + NTHR * c, arr = idx >> 10, j = (idx >> 4) & 63, c8 = idx & 15;
                bf16_t* dst = (arr < 2 ? RAWF + (arr * 64 + j) * 128 : RAWQ + j * 128) + c8 * 8;
                *(u32x4*)dst = praw[c];
            }
        }
        u32x4 ps[2][4];
        {
            const int tq = tid_fresh();
#pragma unroll
            for (int dir = 0; dir < 2; ++dir) {
                const bf16_t* sp = a.HST + hrec_off(dir, h, g);
#pragma unroll
                for (int c = 0; c < 4; ++c) { const int e = (c * NTHR + tq) * 8; ps[dir][c] = *(const u32x4*)(sp + e); }
            }
        }
        __syncthreads();
        if (tid < 256) {
            const int dir = tid >> 7, d = tid & 127;
            const float p0 = a.hgrn_lb[h * 128 + d], p1 = a.hgrn_lb[512 + h * 128 + d];
            const float lb = 1.0f / (1.0f + expf(p0 - p1));
            const bf16_t* rf = RAWF + dir * 64 * 128 + d;
            const bf16_t* rq = RAWQ + d;
            float B = 0.f;
#pragma unroll 8
            for (int s2 = 0; s2 < 64; ++s2) {
                const int j = dir ? 63 - s2 : s2;
                const float f = lb + (1.0f - lb) * fsigmoid_(bf16_to_f32(rf[j * 128]));
                B += flog_(f);
                QA[(dir * 64 + j) * LP2 + d] = f2bf(bf16_to_f32(rq[j * 128]) * fexp_(B));
                R2[(dir * 64 + j) * LP2 + d] = f2bf((1.0f - f) * fexp_(fminf(-B, 80.0f)));
            }
        }
        __syncthreads();
        {
            const int ts = tid_fresh();
            const int dv = ts & 127, vg = ts >> 7;
            u32x4 o0, o1;
            o0.x = (unsigned)pv[0] | ((unsigned)pv[1] << 16); o0.y = (unsigned)pv[2] | ((unsigned)pv[3] << 16); o0.z = (unsigned)pv[4] | ((unsigned)pv[5] << 16); o0.w = (unsigned)pv[6] | ((unsigned)pv[7] << 16);
            o1.x = (unsigned)pv[8] | ((unsigned)pv[9] << 16); o1.y = (unsigned)pv[10] | ((unsigned)pv[11] << 16); o1.z = (unsigned)pv[12] | ((unsigned)pv[13] << 16); o1.w = (unsigned)pv[14] | ((unsigned)pv[15] << 16);
            *(u32x4*)(VT + dv * LP + vg * 16) = o0;
            *(u32x4*)(VT + dv * LP + vg * 16 + 8) = o1;
        }
        {
            const int itl = wid >> 1, i = itl * 16 + fr;
#pragma unroll
            for (int jj = 0; jj < 2; ++jj) {
                const int jt = (wid & 1) * 2 + jj;
                f32x4 af = {0.f, 0.f, 0.f, 0.f}, ab = {0.f, 0.f, 0.f, 0.f};
#pragma unroll
                for (int ks = 0; ks < 4; ++ks) {
                    af = __builtin_amdgcn_mfma_f32_16x16x32_bf16(lds_frag2(R2, jt * 16 + fr, ks * 32 + fq * 8), lds_frag2(QA, itl * 16 + fr, ks * 32 + fq * 8), af, 0, 0, 0);
                    ab = __builtin_amdgcn_mfma_f32_16x16x32_bf16(lds_frag2(R2 + 64 * LP2, jt * 16 + fr, ks * 32 + fq * 8), lds_frag2(QA + 64 * LP2, itl * 16 + fr, ks * 32 + fq * 8), ab, 0, 0, 0);
                }
                float sv[4];
#pragma unroll
                for (int r = 0; r < 4; ++r) {
                    const int j = jt * 16 + fq * 4 + r;
                    sv[r] = ((j <= i) ? af[r] : 0.f) + ((j >= i) ? ab[r] : 0.f);
                }
                u32x2 w; w.x = cvt_pk_bf16(sv[0], sv[1]); w.y = cvt_pk_bf16(sv[2], sv[3]);
                *(u32x2*)(ATT + i * LP + jt * 16 + fq * 4) = w;
            }
        }
        __syncthreads();
        {
            const int tq = tid_fresh();
#pragma unroll
            for (int dir = 0; dir < 2; ++dir) {
#pragma unroll
                for (int c = 0; c < 4; ++c) {
                    const int e = (c * NTHR + tq) * 8;
                    const int dv = e >> 7, d = e & 127;
                    *(u32x4*)(R2 + (dir * 128 + dv) * LP2 + d) = ps[dir][c];
                }
            }
            if (it + nb < NCHUNK * 4) prefetch(it + nb);
        }
        __syncthreads();
        f32x4 o4[4];
        {
            const bf16x8 v0 = lds_frag(VT, wid * 16 + fr, fq * 8), v1 = lds_frag(VT, wid * 16 + fr, 32 + fq * 8);
#pragma unroll
            for (int tt = 0; tt < 4; ++tt) {
                f32x4 acc = {0.f, 0.f, 0.f, 0.f};
                acc = __builtin_amdgcn_mfma_f32_16x16x32_bf16(v0, lds_frag(ATT, tt * 16 + fr, fq * 8), acc, 0, 0, 0);
                acc = __builtin_amdgcn_mfma_f32_16x16x32_bf16(v1, lds_frag(ATT, tt * 16 + fr, 32 + fq * 8), acc, 0, 0, 0);
#pragma unroll
                for (int dir = 0; dir < 2; ++dir)
#pragma unroll
                    for (int ks = 0; ks < 4; ++ks)
                        acc = __builtin_amdgcn_mfma_f32_16x16x32_bf16(lds_frag2(R2 + dir * 128 * LP2, wid * 16 + fr, ks * 32 + fq * 8),
                                                                      lds_frag2(QA + dir * 64 * LP2, tt * 16 + fr, ks * 32 + fq * 8), acc, 0, 0, 0);
                o4[tt] = acc;
            }
        }
#pragma unroll
        for (int tt = 0; tt < 4; ++tt) {
            float ss = o4[tt][0] * o4[tt][0] + o4[tt][1] * o4[tt][1] + o4[tt][2] * o4[tt][2] + o4[tt][3] * o4[tt][3];
            ss += __shfl_xor(ss, 16); ss += __shfl_xor(ss, 32);
            if (fq == 0) ssw[wid * 64 + tt * 16 + fr] = ss;
        }
        __syncthreads();
        const f32x4 nv = *(const f32x4*)(a.hg_norm + h * 128 + wid * 16 + fq * 4);
#pragma unroll
        for (int tt = 0; tt < 4; ++tt) {
            const int i = tt * 16 + fr;
            float tot = 0.f;
#pragma unroll
            for (int w = 0; w < 8; ++w) tot += ssw[w * 64 + i];
            const float rsn = rsqrtf(tot * (1.0f / 128.0f) + EPSF);
            const f32x4 gz = ldz4(a.z + (size_t)(row0 + i) * CD_IN + 2048 + h * 128 + wid * 16 + fq * 4);
            st_bf16x4(a.MG + (size_t)(row0 + i) * DM + h * 128 + wid * 16 + fq * 4,
                      o4[tt][0] * rsn * nv[0] * fsigmoid_(gz[0]), o4[tt][1] * rsn * nv[1] * fsigmoid_(gz[1]),
                      o4[tt][2] * rsn * nv[2] * fsigmoid_(gz[2]), o4[tt][3] * rsn * nv[3] * fsigmoid_(gz[3]));
        }
    }
}

__device__ __forceinline__ void ph_l1_wlr(const L1Args& a) {
    const int gt = blockIdx.x * NTHR + tid_fresh(), gs = gridDim.x * NTHR;
    for (int i = gt; i < 4 * 32768 + 65536; i += gs) {
        float v;
        if (i < 4 * 32768) { const int m = i >> 15, e = i & 32767, n = e >> 6, k = e & 63; v = (m < 2 ? a.w2 : a.a2)[((size_t)(m & 1) * 64 + k) * 512 + n]; }
        else { const int e = i - 4 * 32768, n = e >> 7, k = e & 127; v = a.g2[(size_t)k * 512 + n]; }
        a.WLR[i] = f2bf(v);
    }
}
#define FP 392
__device__ __forceinline__ void ph_l1_rwprep(const L1Args& a) {
    bf16_t* F = (bf16_t*)g_shm;
    float* SH = (float*)(F + 32 * FP);
    float* PT = SH + 3 * 1920;
    const int tid = tid_fresh(), wid = tid >> 6, lane = tid & 63, fr = lane & 15, fq = lane >> 4;
    const int tt = wid & 1, hg = wid >> 1;
    __syncthreads();
    for (int i = tid; i < 3 * 1920; i += NTHR) SH[i] = a.shift[i];
    for (int i = tid; i < 512; i += NTHR) { PT[i] = a.kk_scale[i]; PT[512 + i] = a.k_a[i]; PT[1024 + i] = a.r_k[i]; }
    for (int i = tid; i < 1024; i += NTHR) { PT[1536 + i] = a.w0[i]; PT[2560 + i] = a.a0[i]; }
    constexpr int NIT = NTOK / 32;
    const int G = gridDim.x, nfull = (NIT / G) * G, rem = NIT - nfull;
    const bool split = 2 * rem <= G;
    const int nmine = (int)blockIdx.x < nfull ? (nfull / G) : 0;
    const int extra = split ? ((int)blockIdx.x < 2 * rem ? 1 : 0) : ((int)blockIdx.x < rem ? 1 : 0);
    for (int q = 0; q < nmine + extra; ++q) {
        const bool tail = q >= nmine;
        const int it = !tail ? (int)blockIdx.x + q * G : nfull + (split ? ((int)blockIdx.x >> 1) : (int)blockIdx.x);
        const int i0 = (tail && split) ? ((int)blockIdx.x & 1) * 4 : 0, i1 = (tail && split) ? i0 + 4 : 8;
        const int row0 = it * 32;
        __syncthreads();
#pragma unroll 1
        for (int jb = 0; jb < 2; ++jb) {
            u32x2 zz[3][3];
#pragma unroll
            for (int j = 0; j < 3; ++j) {
                const int idx = tid + NTHR * (jb * 3 + j), tk = idx / 96, cg = idx - tk * 96;
                const int r = row0 + tk;
                const RowInfo ri = row_info(r);
                const bf16_t* zp = a.z + (size_t)r * CD_IN + 2560 + 1536 + cg * 4;
                zz[j][0] = *(const u32x2*)(zp - (ri.t > 0 ? CD_IN : 0));
                zz[j][1] = *(const u32x2*)zp;
                zz[j][2] = *(const u32x2*)(zp + (ri.t < ri.len - 1 ? CD_IN : 0));
            }
#pragma unroll
            for (int j = 0; j < 3; ++j) {
                const int idx = tid + NTHR * (jb * 3 + j), tk = idx / 96, cg = idx - tk * 96;
                const RowInfo ri = row_info(row0 + tk);
                const float mp = ri.t > 0 ? 1.0f : 0.0f, mn = ri.t < ri.len - 1 ? 1.0f : 0.0f;
                const int ch = 1536 + cg * 4;
                float o[4];
#pragma unroll
                for (int x = 0; x < 4; ++x) {
                    const unsigned wp_ = x < 2 ? zz[j][0].x : zz[j][0].y, wc_ = x < 2 ? zz[j][1].x : zz[j][1].y, wn_ = x < 2 ? zz[j][2].x : zz[j][2].y;
                    const float pv_ = __uint_as_float((x & 1) ? (wp_ & 0xffff0000u) : (wp_ << 16)), cv_ = __uint_as_float((x & 1) ? (wc_ & 0xffff0000u) : (wc_ << 16)),
                                nv_ = __uint_as_float((x & 1) ? (wn_ & 0xffff0000u) : (wn_ << 16));
                    const float cv = SH[ch + x] * pv_ * mp + SH[1920 + ch + x] * cv_ + SH[3840 + ch + x] * nv_ * mn;
                    const float sg = frcp_(1.0f + __expf(cg < 32 ? -2.0f * cv : -cv));
                    o[x] = (cg < 32) ? (2.0f * sg - 1.0f) : ((cg < 64) ? cv : sg);
                }
                st_bf16x4(F + tk * FP + cg * 4, o[0], o[1], o[2], o[3]);
            }
        }
        __syncthreads();
        const int r = row0 + tt * 16 + fr;
        const RowInfo ri = row_info(r);
        const float mp = ri.t > 0 ? 1.0f : 0.0f, mn = ri.t < ri.len - 1 ? 1.0f : 0.0f;
        const bf16_t* zc = a.z + (size_t)r * CD_IN + 2560;
        const bf16_t* zpv = zc - (ri.t > 0 ? CD_IN : 0);
        const bf16_t* znx = zc + (ri.t < ri.len - 1 ? CD_IN : 0);
        const bf16_t* fbp = F + (tt * 16 + fr) * FP + fq * 8;
        auto conv_from = [&](const u32x2 (&zr)[3], int ch) -> f32x4 {
            f32x4 o;
#pragma unroll
            for (int x = 0; x < 4; ++x) {
                const unsigned wp_ = x < 2 ? zr[0].x : zr[0].y, wc_ = x < 2 ? zr[1].x : zr[1].y, wn_ = x < 2 ? zr[2].x : zr[2].y;
                const float pv_ = __uint_as_float((x & 1) ? (wp_ & 0xffff0000u) : (wp_ << 16)), cv_ = __uint_as_float((x & 1) ? (wc_ & 0xffff0000u) : (wc_ << 16)),
                            nv_ = __uint_as_float((x & 1) ? (wn_ & 0xffff0000u) : (wn_ << 16));
                o[x] = SH[ch + x] * pv_ * mp + SH[1920 + ch + x] * cv_ + SH[3840 + ch + x] * nv_ * mn;
            }
            return o;
        };
        bf16x8 wa[12]; u32x2 zr[3][3];
        auto issue = [&](int idx) {
            const int h = hg + 4 * (idx >> 2), nt = idx & 3;
            const int n = h * 64 + nt * 16 + fr, ch = h * 64 + nt * 16 + fq * 4;
#pragma unroll
            for (int m = 0; m < 4; ++m)
#pragma unroll
                for (int ks = 0; ks < 2; ++ks) wa[m * 2 + ks] = *(const bf16x8*)(a.WLR + (size_t)m * 32768 + n * 64 + ks * 32 + fq * 8);
#pragma unroll
            for (int ks = 0; ks < 4; ++ks) wa[8 + ks] = *(const bf16x8*)(a.WLR + 131072 + (size_t)n * 128 + ks * 32 + fq * 8);
#pragma unroll
            for (int arr = 0; arr < 3; ++arr) {
                zr[arr][0] = *(const u32x2*)(zpv + arr * 512 + ch); zr[arr][1] = *(const u32x2*)(zc + arr * 512 + ch); zr[arr][2] = *(const u32x2*)(znx + arr * 512 + ch);
            }
        };
        issue(i0);
        float rn = 0.f, br0 = 0.f, kr0 = 0.f, br1 = 0.f, kr1 = 0.f, bonus = 0.f;
#pragma unroll 1
        for (int idx = i0; idx < i1; ++idx) {
            const int h = hg + 4 * (idx >> 2), nt = idx & 3;
            if (nt == 0) {
                u32x2 zk[4][3];
#pragma unroll
                for (int q = 0; q < 4; ++q) { const int ch = 512 + h * 64 + q * 16 + fq * 4; zk[q][0] = *(const u32x2*)(zpv + ch); zk[q][1] = *(const u32x2*)(zc + ch); zk[q][2] = *(const u32x2*)(znx + ch); }
                float ssk = 0.f;
#pragma unroll
                for (int q = 0; q < 4; ++q) {
                    const int chh = h * 64 + q * 16 + fq * 4;
                    const f32x4 kq4 = conv_from(zk[q], 512 + chh) * *(const f32x4*)(PT + chh);
                    ssk += kq4[0] * kq4[0] + kq4[1] * kq4[1] + kq4[2] * kq4[2] + kq4[3] * kq4[3];
                }
                ssk += __shfl_xor(ssk, 16); ssk += __shfl_xor(ssk, 32);
                rn = rsqrtf(ssk + EPSF);
                br0 = 0.f; kr0 = 0.f; br1 = 0.f; kr1 = 0.f; bonus = 0.f;
            }
            f32x4 acc[5];
#pragma unroll
            for (int m = 0; m < 5; ++m) acc[m] = (f32x4){0.f, 0.f, 0.f, 0.f};
#pragma unroll
            for (int m = 0; m < 4; ++m)
#pragma unroll
                for (int ks = 0; ks < 2; ++ks) acc[m] = __builtin_amdgcn_mfma_f32_16x16x32_bf16(wa[m * 2 + ks], *(const bf16x8*)(fbp + (m * 2 + ks) * 32), acc[m], 0, 0, 0);
#pragma unroll
            for (int ks = 0; ks < 4; ++ks) acc[4] = __builtin_amdgcn_mfma_f32_16x16x32_bf16(wa[8 + ks], *(const bf16x8*)(fbp + (8 + ks) * 32), acc[4], 0, 0, 0);
            const int ch = h * 64 + nt * 16 + fq * 4;
            const f32x4 rv = conv_from(zr[0], ch), kv = conv_from(zr[1], 512 + ch), vv = conv_from(zr[2], 1024 + ch);
            if (idx + 1 < i1) issue(idx + 1);
            const f32x4 kn = kv * *(const f32x4*)(PT + ch) * rn;
            const size_t o = (size_t)r * 512 + ch;
            st_bf16x4(a.PV + o, vv[0], vv[1], vv[2], vv[3]);
            *(f32x4*)(a.PG + o) = acc[4];
            st_bf16x4(a.PKK + o, kn[0], kn[1], kn[2], kn[3]);
            const f32x4 kav = *(const f32x4*)(PT + 512 + ch), rkv = *(const f32x4*)(PT + 1024 + ch);
#pragma unroll
            for (int d = 0; d < 2; ++d) {
                const size_t od = (size_t)d * NTOK * 512 + o;
                const f32x4 w0v = *(const f32x4*)(PT + 1536 + d * 512 + ch), a0v = *(const f32x4*)(PT + 2560 + d * 512 + ch);
                f32x4 wv; float ab[4], ke[4], wr[4];
                float brs = 0.f, krs = 0.f;
#pragma unroll
                for (int x = 0; x < 4; ++x) {
                    const float pw = acc[d][x] + w0v[x], pa = acc[2 + d][x] + a0v[x];
                    const float sp_ = fmaxf(-pw, 0.0f) + flog_(1.0f + fexp_(-fabsf(pw)));
                    const float w = fexp_(-fexp_(-sp_ - 0.5f));
                    const float av = fsigmoid_(pa);
                    wv[x] = w;
                    ke[x] = kv[x] * (1.0f + (av - 1.0f) * kav[x]);
                    ab[x] = kn[x] * av;
                    wr[x] = w * rv[x];
                    brs += ab[x] * rv[x]; krs += ke[x] * rv[x]; bonus += rv[x] * ke[x] * rkv[x];
                }
                if (d == 0) { br0 += brs; kr0 += krs; } else { br1 += brs; kr1 += krs; }
                *(f32x4*)(a.PW + od) = wv;
                st_bf16x4(a.PAB + od, ab[0], ab[1], ab[2], ab[3]);
                st_bf16x4(a.PKE + od, ke[0], ke[1], ke[2], ke[3]);
                st_bf16x4(a.PWR + od, wr[0], wr[1], wr[2], wr[3]);
            }
            if (nt == 3) {
#pragma unroll
                for (int o2 = 16; o2 < 64; o2 <<= 1) { br0 += __shfl_xor(br0, o2); kr0 += __shfl_xor(kr0, o2); br1 += __shfl_xor(br1, o2); kr1 += __shfl_xor(kr1, o2); bonus += __shfl_xor(bonus, o2); }
                if (fq == 0) {
                    float* sc0 = a.PSC + ((size_t)r) * 16 + h * 2; sc0[0] = br0; sc0[1] = kr0;
                    float* sc1 = a.PSC + ((size_t)NTOK + r) * 16 + h * 2; sc1[0] = br1; sc1[1] = kr1;
                    a.PBON[(size_t)r * 8 + h] = bonus;
                }
            }
        }
    }
}

#define RW_NB 32
template <int CTRL> __device__ __forceinline__ float dppf(float v) { return __int_as_float(__builtin_amdgcn_update_dpp(0, __float_as_int(v), CTRL, 0xF, 0xF, true)); }
__device__ __forceinline__ int rw_row(int b, int dir, int s) {
    if (s < TC) return b * TC + (dir ? (TC - 1 - s) : s);
    const int s2 = s - TC; return NCTX + b * TL + (dir ? (TL - 1 - s2) : s2);
}
#define RW2_STR 400
__device__ __forceinline__ void ph_l1_rwkv2(const L1Args& a, int bi, int nblk) {
    float* OUT = (float*)g_shm;
    float* BUF = OUT + 2 * RW_NB * 32;
    const int tid = tid_fresh(), wid = tid >> 6, lane = tid & 63;
    constexpr int NBT = (TC + TL) / RW_NB;
    constexpr int NPC = 53;
    typedef float f32x2 __attribute__((ext_vector_type(2)));
    for (int u = bi; u < 128; u += nblk) {
        const int seq = u >> 1, half = u & 1;
        const int dir = seq & 1, h = (seq >> 1) & 7, b = seq >> 4;
        const size_t dof = (size_t)dir * NTOK * 512;
        const int lt = tid - 256, lw = lt >> 6, ll = lt & 63;
        const int sgn = dir ? -1 : 1;
        const char* gb0 = (const char*)a.PKK;
        const int p32 = lt & 31, qa = p32 >> 3, ca = p32 & 7, s0 = lt >> 5;
        const bf16_t* arrA = qa == 0 ? a.PKK : (qa == 1 ? a.PAB + dof : (qa == 2 ? a.PKE + dof : a.PWR + dof));
        const unsigned offA = (unsigned)(size_t)((const char*)(arrA + h * 64 + ca * 8) - gb0) + (unsigned)(sgn * s0) * 1024u;
        const int dA = s0 * RW2_STR + (qa == 0 ? 0 : 64 + qa * 64) + ca * 8;
        unsigned offX = 0u, offD = 0u; int dX = 0;
        if (lw < 2) { const int c = lt & 15, s1 = lt >> 4;
            offX = (unsigned)(size_t)((const char*)(a.PW + dof + h * 64 + c * 4) - gb0) + (unsigned)(sgn * s1) * 2048u; dX = s1 * RW2_STR + 64 + c * 4; }
        else if (lw == 2) { const int c = ll & 3, s3 = ll >> 2;
            offX = (unsigned)(size_t)((const char*)(a.PV + h * 64 + half * 32 + c * 8) - gb0) + (unsigned)(sgn * s3) * 1024u; dX = s3 * RW2_STR + 320 + c * 16;
            offD = (unsigned)(size_t)((const char*)(a.PSC + (size_t)dir * NTOK * 16 + h * 2) - gb0) + (unsigned)(sgn * ll) * 64u; }
        const unsigned offF = (unsigned)((dof + (size_t)h * 64 + half * 32 + (ll & 7) * 4) * 4) + (unsigned)(sgn * (ll >> 3)) * 2048u;
        u32x4 raw[8];
        auto issue = [&](int bt) {
            const unsigned rowb = (unsigned)rw_row(b, dir, bt * RW_NB);
            const unsigned oA = offA + rowb * 1024u, stA = (unsigned)(sgn * 8) * 1024u;
#pragma unroll
            for (int j = 0; j < 4; ++j) raw[j] = *(const u32x4*)(gb0 + (size_t)(oA + (unsigned)j * stA));
            if (lw < 2) {
                const unsigned oX = offX + rowb * 2048u, stX = (unsigned)(sgn * 8) * 2048u;
#pragma unroll
                for (int j = 0; j < 4; ++j) raw[4 + j] = *(const u32x4*)(gb0 + (size_t)(oX + (unsigned)j * stX));
            } else if (lw == 2) {
                const unsigned oX = offX + rowb * 1024u, stX = (unsigned)(sgn * 16) * 1024u;
#pragma unroll
                for (int j = 0; j < 2; ++j) raw[4 + j] = *(const u32x4*)(gb0 + (size_t)(oX + (unsigned)j * stX));
                if (ll < 32) { const u32x2 t2 = *(const u32x2*)(gb0 + (size_t)(offD + rowb * 64u)); raw[6].x = t2.x; raw[6].y = t2.y; }
            }
        };
        auto cvt8 = [&](const u32x4 w, f32x4& l4, f32x4& h4) {
            l4[0] = __uint_as_float(w.x << 16); l4[1] = __uint_as_float(w.x & 0xffff0000u); l4[2] = __uint_as_float(w.y << 16); l4[3] = __uint_as_float(w.y & 0xffff0000u);
            h4[0] = __uint_as_float(w.z << 16); h4[1] = __uint_as_float(w.z & 0xffff0000u); h4[2] = __uint_as_float(w.w << 16); h4[3] = __uint_as_float(w.w & 0xffff0000u);
        };
        auto commit = [&](int bt) {
            float* bb = BUF + (bt & 1) * RW_NB * RW2_STR;
#pragma unroll
            for (int j = 0; j < 4; ++j) {
                f32x4 l4, h4; cvt8(raw[j], l4, h4);
                float* d = bb + dA + 8 * j * RW2_STR;
                *(f32x4*)d = l4; *(f32x4*)(d + 4) = h4;
            }
            if (lw < 2) {
#pragma unroll
                for (int j = 0; j < 4; ++j) *(u32x4*)(bb + dX + 8 * j * RW2_STR) = raw[4 + j];
            } else if (lw == 2) {
#pragma unroll
                for (int j = 0; j < 2; ++j) {
                    f32x4 l4, h4; cvt8(raw[4 + j], l4, h4);
                    float* d = bb + dX + 16 * j * RW2_STR;
                    *(f32x4*)d = (f32x4){l4[0], l4[1], l4[1], l4[0]}; *(f32x4*)(d + 4) = (f32x4){l4[2], l4[3], l4[3], l4[2]};
                    *(f32x4*)(d + 8) = (f32x4){h4[0], h4[1], h4[1], h4[0]}; *(f32x4*)(d + 12) = (f32x4){h4[2], h4[3], h4[3], h4[2]};
                }
                if (ll < 32) { u32x2 t2; t2.x = raw[6].x; t2.y = raw[6].y; *(u32x2*)(bb + ll * RW2_STR + 384) = t2; }
            }
        };
        auto flush = [&](int bt) {
            if (lw == 3) {
                const unsigned rowb = (unsigned)rw_row(b, dir, bt * RW_NB);
                const unsigned oF = offF + rowb * 2048u, stF = (unsigned)(sgn * 8) * 2048u;
#pragma unroll
                for (int r = 0; r < 4; ++r) {
                    const f32x4 v4 = *(const f32x4*)(OUT + (bt & 1) * RW_NB * 32 + (ll + 64 * r) * 4);
                    *(f32x4*)((char*)a.RWO + (size_t)(oF + (unsigned)r * stF)) = v4;
                }
            }
        };
        __syncthreads();
        if (wid >= 4) { issue(0); commit(0); issue(1); }
        f32x2 S0 = {0.f, 0.f}, S1 = {0.f, 0.f}, S2 = {0.f, 0.f}, S3 = {0.f, 0.f};
        const int dr = lane >> 4, l16 = lane & 15, rp = (wid & 3) * 4 + dr, hi8 = l16 >> 3;
        const int vo = 320 + rp * 4 + hi8 * 2, oo = rp * 2 + hi8;
        for (int bt = 0; bt < NBT; ++bt) {
            asm volatile("s_waitcnt lgkmcnt(0)" ::: "memory");
            __builtin_amdgcn_s_barrier();
            asm volatile("" ::: "memory");
            if (wid >= 4) {
                if (bt + 1 < NBT) commit(bt + 1);
                if (bt + 2 < NBT) issue(bt + 2);
                if (bt > 0) flush(bt - 1);
            } else {
                const float* base = BUF + (bt & 1) * RW_NB * RW2_STR;
                float* outp = OUT + (bt & 1) * RW_NB * 32 + oo;
                const float* bs = base;
                f32x4 kk4 = *(const f32x4*)(bs + l16 * 4), w4 = *(const f32x4*)(bs + 64 + l16 * 4), ab4 = *(const f32x4*)(bs + 128 + l16 * 4),
                      ke4 = *(const f32x4*)(bs + 192 + l16 * 4), wr4 = *(const f32x4*)(bs + 256 + l16 * 4);
                f32x2 v2 = *(const f32x2*)(bs + vo), sc2 = *(const f32x2*)(bs + 384);
#pragma unroll
                for (int si = 0; si < RW_NB; ++si) {
                    const float* bn = base + (si + 1 < RW_NB ? si + 1 : si) * RW2_STR;
                    const f32x4 nkk4 = *(const f32x4*)(bn + l16 * 4), nw4 = *(const f32x4*)(bn + 64 + l16 * 4), nab4 = *(const f32x4*)(bn + 128 + l16 * 4),
                                nke4 = *(const f32x4*)(bn + 192 + l16 * 4), nwr4 = *(const f32x4*)(bn + 256 + l16 * 4);
                    const f32x2 nv2 = *(const f32x2*)(bn + vo), nsc2 = *(const f32x2*)(bn + 384);
                    float o;
                    asm volatile(
                        "v_pk_mul_f32 v[236:237], %[S0], %[kkl] op_sel_hi:[1,0]\n\t"
                        "v_pk_mul_f32 v[238:239], %[S0], %[wrl] op_sel_hi:[1,0]\n\t"
                        "v_pk_fma_f32 v[236:237], %[S1], %[kkl], v[236:237] op_sel:[0,1,0]\n\t"
                        "v_pk_fma_f32 v[238:239], %[S1], %[wrl], v[238:239] op_sel:[0,1,0]\n\t"
                        "v_pk_fma_f32 v[236:237], %[S2], %[kkh], v[236:237] op_sel_hi:[1,0,1]\n\t"
                        "v_pk_fma_f32 v[238:239], %[S2], %[wrh], v[238:239] op_sel_hi:[1,0,1]\n\t"
                        "v_pk_fma_f32 v[236:237], %[S3], %[kkh], v[236:237] op_sel:[0,1,0]\n\t"
                        "v_pk_fma_f32 v[238:239], %[S3], %[wrh], v[238:239] op_sel:[0,1,0]\n\t"
                        "v_pk_mul_f32 v[244:245], %[S0], %[wl] op_sel_hi:[1,0]\n\t"
                        "v_add_f32_dpp v240, v237, v236 row_ror:8 row_mask:0xf bank_mask:0xf bound_ctrl:1\n\t"
                        "v_add_f32_dpp v242, v239, v238 row_ror:8 row_mask:0xf bank_mask:0xf bound_ctrl:1\n\t"
                        "v_pk_mul_f32 v[246:247], %[S1], %[wl] op_sel:[0,1]\n\t"
                        "v_add_f32_dpp v240, v240, v240 quad_perm:[1,0,3,2] row_mask:0xf bank_mask:0xf bound_ctrl:1\n\t"
                        "v_add_f32_dpp v242, v242, v242 quad_perm:[1,0,3,2] row_mask:0xf bank_mask:0xf bound_ctrl:1\n\t"
                        "v_pk_mul_f32 v[248:249], %[S2], %[wh] op_sel_hi:[1,0]\n\t"
                        "v_add_f32_dpp v240, v240, v240 quad_perm:[2,3,0,1] row_mask:0xf bank_mask:0xf bound_ctrl:1\n\t"
                        "v_add_f32_dpp v242, v242, v242 quad_perm:[2,3,0,1] row_mask:0xf bank_mask:0xf bound_ctrl:1\n\t"
                        "v_pk_mul_f32 v[250:251], %[S3], %[wh] op_sel:[0,1]\n\t"
                        "v_add_f32_dpp v240, v240, v240 row_half_mirror row_mask:0xf bank_mask:0xf bound_ctrl:1\n\t"
                        "v_add_f32_dpp v242, v242, v242 row_half_mirror row_mask:0xf bank_mask:0xf bound_ctrl:1\n\t"
                        "v_pk_fma_f32 v[244:245], %[v2], %[kel], v[244:245] op_sel_hi:[1,0,1]\n\t"
                        "v_mov_b32_dpp v241, v240 row_ror:8 row_mask:0xf bank_mask:0xf bound_ctrl:1\n\t"
                        "v_pk_fma_f32 v[246:247], %[v2], %[kel], v[246:247] op_sel:[0,1,0]\n\t"
                        "v_pk_fma_f32 v[248:249], %[v2], %[keh], v[248:249] op_sel_hi:[1,0,1]\n\t"
                        "v_pk_fma_f32 %[S0], v[240:241], %[abl], v[244:245] op_sel_hi:[1,0,1] neg_lo:[1,0,0] neg_hi:[1,0,0]\n\t"
                        "v_pk_fma_f32 v[250:251], %[v2], %[keh], v[250:251] op_sel:[0,1,0]\n\t"
                        "v_pk_fma_f32 %[S1], v[240:241], %[abl], v[246:247] op_sel:[0,1,0] neg_lo:[1,0,0] neg_hi:[1,0,0]\n\t"
                        "v_fma_f32 v243, -v240, %[br], v242\n\t"
                        "v_pk_fma_f32 %[S2], v[240:241], %[abh], v[248:249] op_sel_hi:[1,0,1] neg_lo:[1,0,0] neg_hi:[1,0,0]\n\t"
                        "v_fma_f32 %[o], %[vx], %[kr], v243\n\t"
                        "v_pk_fma_f32 %[S3], v[240:241], %[abh], v[250:251] op_sel:[0,1,0] neg_lo:[1,0,0] neg_hi:[1,0,0]"
                        : [S0] "+v"(S0), [S1] "+v"(S1), [S2] "+v"(S2), [S3] "+v"(S3), [o] "=&v"(o)
                        : [kkl] "v"(__builtin_shufflevector(kk4, kk4, 0, 1)), [kkh] "v"(__builtin_shufflevector(kk4, kk4, 2, 3)),
                          [wrl] "v"(__builtin_shufflevector(wr4, wr4, 0, 1)), [wrh] "v"(__builtin_shufflevector(wr4, wr4, 2, 3)),
                          [wl] "v"(__builtin_shufflevector(w4, w4, 0, 1)), [wh] "v"(__builtin_shufflevector(w4, w4, 2, 3)),
                          [abl] "v"(__builtin_shufflevector(ab4, ab4, 0, 1)), [abh] "v"(__builtin_shufflevector(ab4, ab4, 2, 3)),
                          [kel] "v"(__builtin_shufflevector(ke4, ke4, 0, 1)), [keh] "v"(__builtin_shufflevector(ke4, ke4, 2, 3)),
                          [v2] "v"(v2), [vx] "v"(v2.x), [br] "v"(sc2.x), [kr] "v"(sc2.y)
                        : "v236", "v237", "v238", "v239", "v240", "v241", "v242", "v243", "v244", "v245", "v246", "v247", "v248", "v249", "v250", "v251");
                    outp[si * 32] = o;
                    kk4 = nkk4; w4 = nw4; ab4 = nab4; ke4 = nke4; wr4 = nwr4; v2 = nv2; sc2 = nsc2;
                }
            }
        }
        __syncthreads();
        if (wid >= 4) flush(NBT - 1);
    }
}
__device__ __forceinline__ void ph_l1_rwmerge(const L1Args& a) {
    const int tid = tid_fresh(), h = tid >> 6;
    for (int r = NCTX + blockIdx.x; r < NTOK; r += gridDim.x) {
        const size_t o = (size_t)r * 512 + tid;
        const float v = a.RWO[o] + a.RWO[(size_t)NTOK * 512 + o];
        const float ss = wave_sum(v * v);
        const float nv = v * rsqrtf(ss * (1.0f / 64.0f) + EPSF) * a.rw_norm[tid];
        const float outv = (nv + a.PBON[(size_t)r * 8 + h] * bf16_to_f32(a.PV[o])) * a.PG[o];
        a.MG[(size_t)r * DM + 512 + tid] = f2bf(outv);
    }
}

struct ConvArgs { const float* ab_in; const float* ab_out; const float* cd_in; const float* cd_out; const float* wgu; const float* wdn;
                  bf16_t* ab_inT; bf16_t* ab_outT; bf16_t* cd_inT; bf16_t* cd_outT; bf16_t* wguT; bf16_t* wdnT; };


#define XB_TMO      128
#define XB_XCNT(j)  (256  + 64 * (j))
#define XB_XSUB(j)  (1280 + 64 * (j))
#define XB_XGEN(j)  (2304 + 64 * (j))
#define XB_TOP      3328
#define XB_TOPGEN   3392
#define XCD_BAR_WORDS 3456
#define XB_SPIN_CAP (1u << 18)
#define LAS __attribute__((address_space(3)))

__device__ __forceinline__ unsigned xb_ld(unsigned* p)              { return __hip_atomic_load(p, __ATOMIC_RELAXED, __HIP_MEMORY_SCOPE_AGENT); }
__device__ __forceinline__ unsigned xb_add(unsigned* p, unsigned v) { return __hip_atomic_fetch_add(p, v, __ATOMIC_RELAXED, __HIP_MEMORY_SCOPE_AGENT); }
__device__ __forceinline__ unsigned xb_xcc_id() { return (unsigned)__builtin_amdgcn_s_getreg((3 << 11) | 20) & 0xFu; }
#define XB_SPIN(cond, bar) do { unsigned _sp = 0; while (cond) { __builtin_amdgcn_s_sleep(1); \
    if ((++_sp & 255u) == 0u) { if (xb_ld(&(bar)[XB_TMO])) break; if (_sp > XB_SPIN_CAP) { atomicAdd(&(bar)[XB_TMO], 1u); break; } } } } while (0)

struct XcdBarrier {
    unsigned* bar; unsigned x;
    volatile LAS unsigned* st;
};

__device__ __forceinline__ XcdBarrier xcd_barrier_post(unsigned* bar, volatile LAS unsigned* st) {
    XcdBarrier b; b.bar = bar; b.x = xb_xcc_id(); b.st = st;
    if (threadIdx.x == 0) (void)xb_add(&bar[XB_XCNT(b.x)], 1u);
    return b;
}
__device__ __forceinline__ void xcd_barrier_complete(unsigned* bar, unsigned x, unsigned& nloc, unsigned& nx) {
    const unsigned G = gridDim.x * gridDim.y * gridDim.z;
    unsigned sum, cnt, mine, sp = 0u;
    for (;;) {
        sum = 0u; cnt = 0u; mine = 0u;
#pragma unroll
        for (unsigned j = 0; j < 16; ++j) { const unsigned c = xb_ld(&bar[XB_XCNT(j)]); sum += c; cnt += (c > 0u) ? 1u : 0u; mine = (j == x) ? c : mine; }
        if (sum == G) break;
        __builtin_amdgcn_s_sleep(1);
        if ((++sp & 255u) == 0u) { if (xb_ld(&bar[XB_TMO])) break; if (sp > XB_SPIN_CAP) { atomicAdd(&bar[XB_TMO], 1u); break; } }
    }
    nloc = mine > 0u ? mine : 1u; nx = cnt > 0u ? cnt : 1u;
}

__device__ __forceinline__ void xcd_barrier(const XcdBarrier& b) {
    asm volatile("s_waitcnt vmcnt(0)" ::: "memory");
    __syncthreads();
    if (threadIdx.x == 0) {
        unsigned* bar = b.bar;
        __builtin_amdgcn_s_waitcnt(0);
        unsigned nloc = b.st[0], nx = b.st[1];
        if (nloc == 0u) { xcd_barrier_complete(bar, b.x, nloc, nx); b.st[0] = nloc; b.st[1] = nx; }
        const unsigned old = xb_add(&bar[XB_XSUB(b.x)], 1u);
        const unsigned gen = old / nloc;
        if (old + 1u == (gen + 1u) * nloc) {
            __builtin_amdgcn_fence(__ATOMIC_RELEASE, "agent");
            asm volatile("s_waitcnt vmcnt(0)" ::: "memory");
            const unsigned og = xb_add(&bar[XB_TOP], 1u);
            const unsigned tg = og / nx;
            if (og + 1u == (tg + 1u) * nx) xb_add(&bar[XB_TOPGEN], 1u);
            else XB_SPIN(xb_ld(&bar[XB_TOPGEN]) == tg, bar);
            __builtin_amdgcn_fence(__ATOMIC_ACQUIRE, "agent");
            xb_add(&bar[XB_XGEN(b.x)], 1u);
            asm volatile("s_waitcnt vmcnt(0)" ::: "memory");
        } else {
            XB_SPIN(xb_ld(&bar[XB_XGEN(b.x)]) == gen, bar);
            __builtin_amdgcn_fence(__ATOMIC_ACQUIRE, "agent");
            asm volatile("s_waitcnt vmcnt(0)" ::: "memory");
        }
    }
    __syncthreads();
}


__device__ __forceinline__ void sub_barrier(unsigned* bar, int word, unsigned n) {
    asm volatile("s_waitcnt vmcnt(0)" ::: "memory");
    __syncthreads();
    if (threadIdx.x == 0) {
        __builtin_amdgcn_s_waitcnt(0);
        __builtin_amdgcn_fence(__ATOMIC_RELEASE, "agent");
        asm volatile("s_waitcnt vmcnt(0)" ::: "memory");
        (void)xb_add(&bar[word], 1u);
        XB_SPIN(xb_ld(&bar[word]) < n, bar);
        __builtin_amdgcn_fence(__ATOMIC_ACQUIRE, "agent");
        asm volatile("s_waitcnt vmcnt(0)" ::: "memory");
    }
    __syncthreads();
}

struct FwdParams {
    const float* x; const float* c; const float* ctx; const float* c_ctx; const float* mod_w; const float* mod_b;
    const float* norm_mix; const float* norm_ffn; const float* norm_final;
    const float* router_w; const float* router_b; const float* bgu; const float* bdn;
    float* out;
    unsigned* bar; int* meta;
    float* mvec; float* H; bf16_t* Ub; bf16_t* ZB; float* P; float* Y;
    int* top_e; float* top_w; int* slot_of; int* list;
    float* slot_w;
    bf16_t* ab_inT; bf16_t* ab_outT; bf16_t* cd_inT; bf16_t* cd_outT; bf16_t* wguT; bf16_t* wdnT;
    ConvArgs cv; L0Args l0; L1Args l1;
};
#define LIST_INTS (NTOK * 4 + NEXP * 256)

__device__ __forceinline__ void ph_mod(const FwdParams& p) {
    float* sc = (float*)g_shm;
    float* part = sc + 5 * 1024;
    const int tid = tid_fresh();
    __syncthreads();
    for (int i = tid; i < 5 * 1024; i += NTHR) { const int b = i >> 10, k = i & 1023; sc[i] = siluf_(b < 4 ? p.c[b * 1024 + k] : p.c_ctx[k]); }
    __syncthreads();
    for (int cg = blockIdx.x; cg < 256; cg += gridDim.x) {
        const int colidx0 = cg * 48, layer = colidx0 / 6144, col0 = colidx0 % 6144;
        if (tid < 384) {
            const int cl = tid % 48, kp = tid / 48;
            const float* W = p.mod_w + (size_t)layer * 1024 * 6144 + col0 + cl;
            float a0 = 0.f, a1 = 0.f, a2 = 0.f, a3 = 0.f, a4 = 0.f;
#pragma unroll 8
            for (int k = kp * 128; k < kp * 128 + 128; ++k) {
                const float w = W[(size_t)k * 6144];
                a0 += sc[k] * w; a1 += sc[1024 + k] * w; a2 += sc[2048 + k] * w; a3 += sc[3072 + k] * w; a4 += sc[4096 + k] * w;
            }
            float* pp = part + (kp * 48 + cl) * 5;
            pp[0] = a0; pp[1] = a1; pp[2] = a2; pp[3] = a3; pp[4] = a4;
        }
        __syncthreads();
        if (tid < 240) {
            const int cl = tid / 5, rr = tid % 5;
            float sum = p.mod_b[layer * 6144 + col0 + cl];
#pragma unroll
            for (int kp = 0; kp < 8; ++kp) sum += part[(kp * 48 + cl) * 5 + rr];
            p.mvec[((size_t)layer * 5 + rr) * 6144 + col0 + cl] = sum;
        }
        __syncthreads();
    }
}
__device__ __forceinline__ const float* row_src(const float* src_ctx, const float* src_lat, int r) { return r < NCTX ? src_ctx + (size_t)r * DM : src_lat + (size_t)(r - NCTX) * DM; }
__device__ __forceinline__ int row_mrow(int r) { return r < NCTX ? 4 : (r - NCTX) / TL; }
__device__ __forceinline__ void ph_normmod(const float* src_ctx, const float* src_lat, const float* gain, const float* mvl, int row0, int row1, bf16_t* out) {
    const int tfz = tid_fresh(); const int wid = tfz >> 6, lane = tfz & 63;
    const int stride = gridDim.x * 8;
    int r = row0 + blockIdx.x * 8 + wid;
    float4 x[4], xn[4];
    if (r < row1) { const float4* src = (const float4*)row_src(src_ctx, src_lat, r);
#pragma unroll
        for (int i = 0; i < 4; ++i) x[i] = src[lane + 64 * i]; }
    for (; r < row1; r += stride) {
        const int rn = r + stride;
        if (rn < row1) { const float4* src = (const float4*)row_src(src_ctx, src_lat, rn);
#pragma unroll
            for (int i = 0; i < 4; ++i) xn[i] = src[lane + 64 * i]; }
        const float* mv = mvl + (size_t)row_mrow(r) * 6144;
        float ss = 0.f;
#pragma unroll
        for (int i = 0; i < 4; ++i) ss += x[i].x * x[i].x + x[i].y * x[i].y + x[i].z * x[i].z + x[i].w * x[i].w;
        const float rs = rsqrtf(wave_sum(ss) * (1.0f / DM) + EPSF);
#pragma unroll
        for (int i = 0; i < 4; ++i) {
            const int c4 = lane + 64 * i;
            const float4 g = ((const float4*)gain)[c4], sh = ((const float4*)mv)[c4], sc = ((const float4*)(mv + 1024))[c4];
            st_bf16x4(out + (size_t)r * DM + c4 * 4, x[i].x * rs * g.x * (1.0f + sc.x) + sh.x, x[i].y * rs * g.y * (1.0f + sc.y) + sh.y,
                      x[i].z * rs * g.z * (1.0f + sc.z) + sh.z, x[i].w * rs * g.w * (1.0f + sc.w) + sh.w);
        }
#pragma unroll
        for (int i = 0; i < 4; ++i) x[i] = xn[i];
    }
}
__device__ __forceinline__ void ph_norm_router(const FwdParams& p, int layer, int row0, int row1) {
    float* RW = (float*)g_shm;
    float* lgs = RW + 1024 * 32;
    int* hist = (int*)(lgs + 8 * 32);
    const int tid = tid_fresh(), wid = tid >> 6, lane = tid & 63;
    const float* mvl = p.mvec + (size_t)layer * 5 * 6144;
    const float* gain = p.norm_ffn + layer * DM;
    const float* rw = p.router_w + (size_t)layer * 1024 * 32;
    const float* rb = p.router_b + layer * 32;
    int* meta = p.meta + layer * 128;
    __syncthreads();
    if (tid < 32) hist[tid] = 0;
    for (int i = tid; i < 1024 * 8; i += NTHR) {
        const int k = i >> 3, c8 = i & 7;
        const int i2 = k >> 5, kq = (k >> 2) & 7, c = k & 3;
        *(float4*)(RW + (32 * i2 + 8 * c + kq) * 32 + c8 * 4) = *(const float4*)(rw + k * 32 + c8 * 4);
    }
    __syncthreads();
    const int e4 = lane & 7, kq = lane >> 3;
    const int stride = gridDim.x * 8;
    int r = row0 + blockIdx.x * 8 + wid;
    float4 hn[4];
    if (r < row1) {
#pragma unroll
        for (int i = 0; i < 4; ++i) hn[i] = ((const float4*)(p.H + (size_t)r * DM))[lane + 64 * i]; }
    for (; r < row1; r += stride) {
        const float* mv = mvl + (size_t)row_mrow(r) * 6144;
        float4 hh[4]; float ss = 0.f;
#pragma unroll
        for (int i = 0; i < 4; ++i) {
            hh[i] = hn[i];
            ss += hh[i].x * hh[i].x + hh[i].y * hh[i].y + hh[i].z * hh[i].z + hh[i].w * hh[i].w;
        }
        if (r + stride < row1) {
#pragma unroll
            for (int i = 0; i < 4; ++i) hn[i] = ((const float4*)(p.H + (size_t)(r + stride) * DM))[lane + 64 * i]; }
        const float rs = rsqrtf(wave_sum(ss) * (1.0f / DM) + EPSF);
#pragma unroll
        for (int i = 0; i < 4; ++i) {
            const int c4 = lane + 64 * i;
            const float4 g = ((const float4*)gain)[c4], sh = ((const float4*)(mv + 3072))[c4], sc = ((const float4*)(mv + 4096))[c4];
            hh[i].x = hh[i].x * rs * g.x * (1.0f + sc.x) + sh.x; hh[i].y = hh[i].y * rs * g.y * (1.0f + sc.y) + sh.y;
            hh[i].z = hh[i].z * rs * g.z * (1.0f + sc.z) + sh.z; hh[i].w = hh[i].w * rs * g.w * (1.0f + sc.w) + sh.w;
            st_bf16x4(p.Ub + (size_t)r * DM + c4 * 4, hh[i].x, hh[i].y, hh[i].z, hh[i].w);
        }
        float l0 = 0.f, l1 = 0.f, l2 = 0.f, l3 = 0.f;
#pragma unroll
        for (int i2 = 0; i2 < 32; ++i2) {
            const int srcl = kq + 8 * (i2 & 7);
            const float4 hv = hh[i2 >> 3];
            const float x0 = __shfl(hv.x, srcl), x1 = __shfl(hv.y, srcl), x2 = __shfl(hv.z, srcl), x3 = __shfl(hv.w, srcl);
            const float* wp = RW + (32 * i2 + kq) * 32 + e4 * 4;
            const float4 w0 = *(const float4*)wp, w1 = *(const float4*)(wp + 8 * 32), w2 = *(const float4*)(wp + 16 * 32), w3 = *(const float4*)(wp + 24 * 32);
            l0 += x0 * w0.x + x1 * w1.x + x2 * w2.x + x3 * w3.x;
            l1 += x0 * w0.y + x1 * w1.y + x2 * w2.y + x3 * w3.y;
            l2 += x0 * w0.z + x1 * w1.z + x2 * w2.z + x3 * w3.z;
            l3 += x0 * w0.w + x1 * w1.w + x2 * w2.w + x3 * w3.w;
        }
#pragma unroll
        for (int o = 8; o < 64; o <<= 1) { l0 += __shfl_xor(l0, o); l1 += __shfl_xor(l1, o); l2 += __shfl_xor(l2, o); l3 += __shfl_xor(l3, o); }
        if (lane < 8) { float* lg = lgs + wid * 32 + e4 * 4; lg[0] = l0 + rb[e4 * 4]; lg[1] = l1 + rb[e4 * 4 + 1]; lg[2] = l2 + rb[e4 * 4 + 2]; lg[3] = l3 + rb[e4 * 4 + 3]; }
        float val = (lane < 32) ? lgs[wid * 32 + lane] : -INFINITY;
        float tv[4]; int ti[4];
#pragma unroll
        for (int k = 0; k < 4; ++k) {
            float bv = val; int bi = lane;
#pragma unroll
            for (int o = 1; o < 64; o <<= 1) {
                const float ov = __shfl_xor(bv, o); const int oi = __shfl_xor(bi, o);
                if (ov > bv || (ov == bv && oi < bi)) { bv = ov; bi = oi; }
            }
            tv[k] = bv; ti[k] = bi;
            if (lane == bi) val = -INFINITY;
        }
        const float w0 = 1.0f, w1 = expf(tv[1] - tv[0]), w2 = expf(tv[2] - tv[0]), w3 = expf(tv[3] - tv[0]);
        const float inv = 1.0f / (w0 + w1 + w2 + w3);
        if (lane == 0) {
            *(int4*)(p.top_e + (size_t)r * 4) = make_int4(ti[0], ti[1], ti[2], ti[3]);
            *(float4*)(p.top_w + (size_t)r * 4) = make_float4(w0 * inv, w1 * inv, w2 * inv, w3 * inv);
            atomicAdd(&hist[ti[0]], 1); atomicAdd(&hist[ti[1]], 1); atomicAdd(&hist[ti[2]], 1); atomicAdd(&hist[ti[3]], 1);
        }
    }
    __syncthreads();
    if (tid < 32 && hist[tid] != 0) atomicAdd(&meta[tid], hist[tid]);
}
__device__ __forceinline__ void ph_assign(const FwdParams& p, int layer, int row0, int row1) {
    int* hist = (int*)g_shm; int* base = hist + 32; int* lcur = base + 32;
    const int tid = tid_fresh();
    int* meta = p.meta + layer * 128;
    int* list = p.list + (size_t)layer * LIST_INTS;
    __syncthreads();
    if (tid < 32) { hist[tid] = 0; lcur[tid] = 0; }
    __syncthreads();
    const int npairs = (row1 - row0) * 4;
    for (int i = blockIdx.x * NTHR + tid; i < npairs; i += gridDim.x * NTHR) atomicAdd(&hist[p.top_e[(size_t)row0 * 4 + i]], 1);
    __syncthreads();
    if (tid < 32) {
        int off = 0;
        for (int e = 0; e < tid; ++e) off += (meta[e] + 255) & ~255;
        if (blockIdx.x == 0) meta[64 + tid] = off;
        base[tid] = off + (hist[tid] ? atomicAdd(&meta[32 + tid], hist[tid]) : 0);
    }
    __syncthreads();
    for (int i = blockIdx.x * NTHR + tid; i < npairs; i += gridDim.x * NTHR) {
        const int e = p.top_e[(size_t)row0 * 4 + i];
        const int slot = base[e] + atomicAdd(&lcur[e], 1);
        list[slot] = row0 + (i >> 2);
        p.slot_of[(size_t)row0 * 4 + i] = slot;
        p.slot_w[slot] = p.top_w[(size_t)row0 * 4 + i];
    }
}
template <bool FINAL>
__device__ __forceinline__ void ph_combine(const FwdParams& p, int layer, int row0, int row1) {
    const int tfz = tid_fresh(); const int wid = tfz >> 6, lane = tfz & 63;
    const float* mvl = p.mvec + (size_t)layer * 5 * 6144;
    const bf16_t* YS = (const bf16_t*)p.P;
    const int stride = gridDim.x * 8;
    int r = row0 + blockIdx.x * 8 + wid;
    int4 sl_n = make_int4(0, 0, 0, 0);
    u32x2 ya[4][4], yn[4][4]; float4 ha[4], hnx[4];
    auto load_rows = [&](int rr, const int4& sl, u32x2 (&y)[4][4], float4 (&h)[4]) {
#pragma unroll
        for (int i = 0; i < 4; ++i) {
            const int c4 = lane + 64 * i;
            y[0][i] = *(const u32x2*)(YS + (size_t)sl.x * DM + c4 * 4); y[1][i] = *(const u32x2*)(YS + (size_t)sl.y * DM + c4 * 4);
            y[2][i] = *(const u32x2*)(YS + (size_t)sl.z * DM + c4 * 4); y[3][i] = *(const u32x2*)(YS + (size_t)sl.w * DM + c4 * 4);
            h[i] = ((const float4*)(p.H + (size_t)rr * DM))[c4];
        }
    };
    if (r < row1) {
        const int4 sl0 = *(const int4*)(p.slot_of + (size_t)r * 4);
        load_rows(r, sl0, ya, ha);
        if (r + stride < row1) sl_n = *(const int4*)(p.slot_of + (size_t)(r + stride) * 4);
    }
    for (; r < row1; r += stride) {
        const int rn = r + stride;
        if (rn < row1) {
            load_rows(rn, sl_n, yn, hnx);
            if (rn + stride < row1) sl_n = *(const int4*)(p.slot_of + (size_t)(rn + stride) * 4);
        }
        const float* mv = mvl + (size_t)row_mrow(r) * 6144;
        float4 hh[4]; float ss = 0.f;
#pragma unroll
        for (int i = 0; i < 4; ++i) {
            const int c4 = lane + 64 * i;
            float ys4[4];
#pragma unroll
            for (int x = 0; x < 4; ++x) {
                float acc = 0.f;
#pragma unroll
                for (int k = 0; k < 4; ++k) { const unsigned w = x < 2 ? ya[k][i].x : ya[k][i].y; acc += __uint_as_float((x & 1) ? (w & 0xffff0000u) : (w << 16)); }
                ys4[x] = acc;
            }
            const float4 gt = ((const float4*)(mv + 5120))[c4];
            float4 h = ha[i];
            h.x += gt.x * ys4[0]; h.y += gt.y * ys4[1]; h.z += gt.z * ys4[2]; h.w += gt.w * ys4[3];
            hh[i] = h;
            if (!FINAL) ((float4*)(p.H + (size_t)r * DM))[c4] = h;
            ss += h.x * h.x + h.y * h.y + h.z * h.z + h.w * h.w;
        }
        const float rs = rsqrtf(wave_sum(ss) * (1.0f / DM) + EPSF);
        if (FINAL) {
#pragma unroll
            for (int i = 0; i < 4; ++i) {
                const int c4 = lane + 64 * i;
                const float4 g = ((const float4*)p.norm_final)[c4];
                ((float4*)(p.out + (size_t)(r - NCTX) * DM))[c4] = make_float4(hh[i].x * rs * g.x, hh[i].y * rs * g.y, hh[i].z * rs * g.z, hh[i].w * rs * g.w);
            }
        } else {
            const float* mv1 = p.mvec + (size_t)(layer + 1) * 5 * 6144 + (size_t)row_mrow(r) * 6144;
            const float* gain = p.norm_mix + (layer + 1) * DM;
#pragma unroll
            for (int i = 0; i < 4; ++i) {
                const int c4 = lane + 64 * i;
                const float4 g = ((const float4*)gain)[c4], sh = ((const float4*)mv1)[c4], sc = ((const float4*)(mv1 + 1024))[c4];
                st_bf16x4(p.Ub + (size_t)r * DM + c4 * 4, hh[i].x * rs * g.x * (1.0f + sc.x) + sh.x, hh[i].y * rs * g.y * (1.0f + sc.y) + sh.y,
                          hh[i].z * rs * g.z * (1.0f + sc.z) + sh.z, hh[i].w * rs * g.w * (1.0f + sc.w) + sh.w);
            }
        }
#pragma unroll
        for (int k = 0; k < 4; ++k)
#pragma unroll
            for (int i = 0; i < 4; ++i) ya[k][i] = yn[k][i];
#pragma unroll
        for (int i = 0; i < 4; ++i) ha[i] = hnx[i];
    }
}

__global__ void __launch_bounds__(NTHR, 2) k_fwd(FwdParams p) {
    volatile LAS unsigned* xbw = (volatile LAS unsigned*)(g_shm + LDS_BYTES - 16);
    if (threadIdx.x == 0) { xbw[0] = 0u; xbw[1] = 0u; xbw[2] = 0u; xbw[3] = 0u; }
    __syncthreads();
    XcdBarrier bar = xcd_barrier_post(p.bar, xbw);
    {
        int base = 0;
        const int bi = blockIdx.x, nb = gridDim.x;
        base = convert_matrix<2>(p.cv.ab_in, AB_IN, 3328, p.cv.ab_inT, base, bi, nb);
        base = convert_matrix<0>(p.cv.ab_out, 1024, 1024, p.cv.ab_outT, base, bi, nb);
        base = convert_matrix<2>(p.cv.cd_in, CD_IN, 4608, p.cv.cd_inT, base, bi, nb);
        base = convert_matrix<0>(p.cv.cd_out, 1024, 1024, p.cv.cd_outT, base, bi, nb);
        convert_experts(p.cv.wgu, p.cv.wdn, p.cv.wguT, p.cv.wdnT, 0, NEXP, bi, nb);
        ph_mod(p);
        ph_l1_wlr(p.l1);
    }
    xcd_barrier(bar);
    ph_normmod(p.ctx, p.x, p.norm_mix, p.mvec, 0, NTOK, p.Ub);
    xcd_barrier(bar);
    ph_gemm_bf16out(p.Ub, 0, NTOK, p.ab_inT, AB_IN, 3328, p.ZB, AB_IN);
    xcd_barrier(bar);
    ph_l0_prep(p.l0);
    xcd_barrier(bar);
    ph_l0_local(p.l0);
    xcd_barrier(bar);
    ph_l0_prop(p.l0);
    xcd_barrier(bar);
    ph_l0_out(p.l0);
    xcd_barrier(bar);
    ph_gemm_resid(p.Ub, 0, NTOK, p.ab_outT, p.ctx, p.x, p.mvec + 2048, p.H);
    xcd_barrier(bar);
    ph_norm_router(p, 0, 0, NTOK);
    xcd_barrier(bar);
    ph_assign(p, 0, 0, NTOK);
    xcd_barrier(bar);
    ph_moe_gu(p.Ub, p.meta, p.list, p.wguT, p.bgu, p.ZB);
    xcd_barrier(bar);
    ph_moe_dn(p.ZB, p.meta, p.wdnT, p.bdn, (bf16_t*)p.P, p.slot_w);
    xcd_barrier(bar);
    ph_combine<false>(p, 0, 0, NTOK);
    xcd_barrier(bar);
    ph_gemm_bf16out(p.Ub, 0, NTOK, p.cd_inT, CD_IN, 4608, p.ZB, CD_IN);
    xcd_barrier(bar);
    ph_l1_rwprep(p.l1);
    xcd_barrier(bar);
    {
        const int nrw = (int)gridDim.x >> 1;
        if ((int)blockIdx.x < nrw) ph_l1_rwkv2(p.l1, blockIdx.x, nrw);
        else {
            const int bi = (int)blockIdx.x - nrw, nb = (int)gridDim.x - nrw;
            ph_l1_local(p.l1, bi, nb);
            sub_barrier(p.bar, 0, (unsigned)nb);
            ph_l1_prop(p.l1, bi, nb);
            sub_barrier(p.bar, 64, (unsigned)nb);
            ph_l1_out(p.l1, bi, nb);
            convert_experts(p.cv.wgu, p.cv.wdn, p.cv.wguT, p.cv.wdnT, NEXP, 2 * NEXP, bi, nb);
        }
    }
    xcd_barrier(bar);
    ph_l1_rwmerge(p.l1);
    xcd_barrier(bar);
    ph_gemm_resid(p.Ub, NCTX, NLAT, p.cd_outT, p.H, p.H + (size_t)NCTX * DM, p.mvec + 5 * 6144 + 2048, p.H);
    xcd_barrier(bar);
    ph_norm_router(p, 1, NCTX, NTOK);
    xcd_barrier(bar);
    ph_assign(p, 1, NCTX, NTOK);
    xcd_barrier(bar);
    ph_moe_gu(p.Ub, p.meta + 128, p.list + LIST_INTS, p.wguT + (size_t)NEXP * 2048 * 1024, p.bgu + NEXP * 2048, p.ZB);
    xcd_barrier(bar);
    ph_moe_dn(p.ZB, p.meta + 128, p.wdnT + (size_t)NEXP * 1024 * 1024, p.bdn + NEXP * 1024, (bf16_t*)p.P, p.slot_w);
    xcd_barrier(bar);
    ph_combine<true>(p, 1, NCTX, NTOK);
}

extern "C" void kernel_launch(void* const* d_in, const int* in_sizes, int n_in, void* d_out, int out_size, void* d_ws, size_t ws_size,
                              hipStream_t stream) {
    const size_t NT1024 = (size_t)NTOK * 1024, NT512 = (size_t)NTOK * 512;
    char* wp = (char*)d_ws;
    auto carve = [&](size_t bytes) { char* q = wp; wp += (bytes + 255) & ~(size_t)255; return q; };
    const size_t CTL_BYTES = (size_t)XCD_BAR_WORDS * 4 + 256 * 4 + (size_t)2 * LIST_INTS * 4;
    char* ctl = carve(CTL_BYTES);
    unsigned* bar = (unsigned*)ctl;
    int* meta = (int*)(ctl + (size_t)XCD_BAR_WORDS * 4);
    int* list = (int*)(ctl + (size_t)XCD_BAR_WORDS * 4 + 256 * 4);
    FwdParams p{};
    p.x = (const float*)d_in[0]; p.c = (const float*)d_in[1]; p.ctx = (const float*)d_in[2]; p.c_ctx = (const float*)d_in[3];
    p.mod_w = (const float*)d_in[4]; p.mod_b = (const float*)d_in[5]; p.norm_mix = (const float*)d_in[6]; p.norm_ffn = (const float*)d_in[7];
    p.norm_final = (const float*)d_in[8];
    p.router_w = (const float*)d_in[30]; p.router_b = (const float*)d_in[31]; p.bgu = (const float*)d_in[33]; p.bdn = (const float*)d_in[35];
    p.out = (float*)d_out;
    p.bar = bar; p.meta = meta; p.list = list;
    p.mvec = (float*)carve((size_t)2 * 5 * 6144 * 4);
    p.ab_inT = (bf16_t*)carve((size_t)3328 * 1024 * 2);
    p.ab_outT = (bf16_t*)carve((size_t)1024 * 1024 * 2);
    p.cd_inT = (bf16_t*)carve((size_t)4608 * 1024 * 2);
    p.cd_outT = (bf16_t*)carve((size_t)1024 * 1024 * 2);
    p.wguT = (bf16_t*)carve((size_t)2 * NEXP * 2048 * 1024 * 2);
    p.wdnT = (bf16_t*)carve((size_t)2 * NEXP * 1024 * 1024 * 2);
    p.H = (float*)carve(NT1024 * 4);
    p.Ub = (bf16_t*)carve(NT1024 * 2);
    p.ZB = (bf16_t*)carve((size_t)NTOK * CD_IN * 2);
    const size_t P_BYTES = (size_t)805306368;
    p.P = (float*)carve(P_BYTES);
    float* O = (float*)carve(NT512 * 4 * 4);
    p.Y = O;
    p.top_e = (int*)carve((size_t)NTOK * 4 * 4);
    p.top_w = (float*)carve((size_t)NTOK * 4 * 4);
    p.slot_of = (int*)carve((size_t)NTOK * 4 * 4);
    bf16_t* WLR = (bf16_t*)carve((size_t)196608 * 2);
    p.slot_w = (float*)carve((size_t)LIST_INTS * 4);
    if ((size_t)(wp - (char*)d_ws) > ws_size) return;

    p.cv.ab_in = (const float*)d_in[9]; p.cv.ab_out = (const float*)d_in[10]; p.cv.cd_in = (const float*)d_in[16]; p.cv.cd_out = (const float*)d_in[17];
    p.cv.wgu = (const float*)d_in[32]; p.cv.wdn = (const float*)d_in[34];
    p.cv.ab_inT = p.ab_inT; p.cv.ab_outT = p.ab_outT; p.cv.cd_inT = p.cd_inT; p.cv.cd_outT = p.cd_outT; p.cv.wguT = p.wguT; p.cv.wdnT = p.wdnT;
    {
        char* pp = (char*)p.P;
        auto sub = [&](size_t bytes) { char* q = pp; pp += (bytes + 255) & ~(size_t)255; return q; };
        L0Args& a = p.l0;
        a.z = p.ZB; a.ml_conv = (const float*)d_in[13]; a.gate_b = (const float*)d_in[14]; a.ret_decay = (const float*)d_in[11];
        a.ret_norm = (const float*)d_in[12]; a.ml_norm = (const float*)d_in[15];
        a.RQ = (bf16_t*)sub((size_t)NTOK * 256 * 2); a.RK = (bf16_t*)sub((size_t)NTOK * 256 * 2);
        a.MQ = (bf16_t*)sub((size_t)NTOK * 256 * 2); a.MK = (bf16_t*)sub((size_t)NTOK * 256 * 2);
        a.LIF = (float*)sub((size_t)NTOK * 16 * 4);
        a.ST = (bf16_t*)sub((size_t)16 * NCHUNK * REC * 2);
        a.CM = (float*)sub((size_t)8 * NCHUNK * 2 * 4);
        a.MI = (float*)sub((size_t)8 * NCHUNK * 4);
        a.MG = p.Ub;
        if ((size_t)(pp - (char*)p.P) > P_BYTES) return;
    }
    {
        char* pp = (char*)p.P;
        auto sub = [&](size_t bytes) { char* q = pp; pp += (bytes + 255) & ~(size_t)255; return q; };
        L1Args& a = p.l1;
        a.z = p.ZB; a.hgrn_lb = (const float*)d_in[18]; a.hg_norm = (const float*)d_in[19];
        a.HST = (bf16_t*)sub((size_t)8 * NCHUNK * HREC * 2);
        a.HDEC = (float*)sub((size_t)8 * NCHUNK * 128 * 4);
        a.MG = p.Ub;
        a.shift = (const float*)d_in[20]; a.w0 = (const float*)d_in[21]; a.w2 = (const float*)d_in[22]; a.a0 = (const float*)d_in[23];
        a.a2 = (const float*)d_in[24]; a.g2 = (const float*)d_in[25]; a.kk_scale = (const float*)d_in[26]; a.k_a = (const float*)d_in[27];
        a.r_k = (const float*)d_in[28]; a.rw_norm = (const float*)d_in[29];
        a.PKK = (bf16_t*)sub(NT512 * 2); a.PV = (bf16_t*)sub(NT512 * 2);
        a.PG = (float*)sub(NT512 * 4);
        a.PW = (float*)sub(NT512 * 2 * 4);
        a.PAB = (bf16_t*)sub(NT512 * 2 * 2); a.PKE = (bf16_t*)sub(NT512 * 2 * 2); a.PWR = (bf16_t*)sub(NT512 * 2 * 2);
        a.PSC = (float*)sub((size_t)2 * NTOK * 16 * 4);
        a.PBON = (float*)sub((size_t)NTOK * 8 * 4);
        a.RWO = O; a.WLR = WLR;
        if ((size_t)(pp - (char*)p.P) > P_BYTES) return;
    }
    static int grid = 0;
    if (grid == 0) {
        int dev = 0, cus = 0;
        if (hipGetDevice(&dev) != hipSuccess || hipDeviceGetAttribute(&cus, hipDeviceAttributeMultiprocessorCount, dev) != hipSuccess) { grid = -1; return; }
        if (hipFuncSetAttribute((const void*)k_fwd, hipFuncAttributeMaxDynamicSharedMemorySize, LDS_BYTES) != hipSuccess) { grid = -1; return; }
        int per_cu = 0;
        if (hipOccupancyMaxActiveBlocksPerMultiprocessor(&per_cu, (const void*)k_fwd, NTHR, LDS_BYTES) != hipSuccess || per_cu < 1) { (void)hipGetLastError(); }
        grid = cus > 0 ? cus : 256;
    }
    if (grid < 0) return;
    (void)hipMemsetAsync(ctl, 0, CTL_BYTES, stream);
    k_fwd<<<grid, NTHR, LDS_BYTES, stream>>>(p);
}
```

```cpp
#include <hip/hip_runtime.h>
#include <stdint.h>
#include <stddef.h>

#define DM 1024
#define NB 4
#define TL 8192
#define TC 256
#define NCTX (NB * TC)
#define NLAT (NB * TL)
#define NTOK (NCTX + NLAT)
#define AB_IN 3088
#define CD_IN 4480
#define NEXP 32
#define EPSF 1e-6f

typedef unsigned short bf16_t;
typedef unsigned u32x2 __attribute__((ext_vector_type(2)));
typedef unsigned u32x4 __attribute__((ext_vector_type(4)));
__device__ __forceinline__ unsigned cvt_pk_bf16(float lo, float hi) { unsigned r; asm volatile("v_cvt_pk_bf16_f32 %0, %1, %2" : "=v"(r) : "v"(lo), "v"(hi)); return r; }
typedef __bf16 bf16x2_t __attribute__((ext_vector_type(2)));
typedef float f32x2_t __attribute__((ext_vector_type(2)));
__device__ __forceinline__ unsigned cvt_pk_bf16_nat(float lo, float hi) { const f32x2_t v = {lo, hi}; return __builtin_bit_cast(unsigned, __builtin_convertvector(v, bf16x2_t)); }
__device__ __forceinline__ void st_bf16x8(bf16_t* p, float a, float b, float c, float d, float e, float f, float g, float h) { u32x4 w; w.x = cvt_pk_bf16_nat(a, b); w.y = cvt_pk_bf16_nat(c, d); w.z = cvt_pk_bf16_nat(e, f); w.w = cvt_pk_bf16_nat(g, h); *(u32x4*)p = w; }
__device__ __forceinline__ void st_bf16x4(bf16_t* p, float a, float b, float c, float d) { u32x2 w; w.x = cvt_pk_bf16(a, b); w.y = cvt_pk_bf16(c, d); *(u32x2*)p = w; }
__device__ __forceinline__ float sigmoidf_(float x) { return 1.0f / (1.0f + expf(-x)); }
__device__ __forceinline__ float siluf_(float x) { return x / (1.0f + expf(-x)); }
__device__ __forceinline__ float logsigmoidf_(float x) { return fminf(x, 0.0f) - log1pf(expf(-fabsf(x))); }
__device__ __forceinline__ float softplusf_(float x) { return fmaxf(x, 0.0f) + log1pf(expf(-fabsf(x))); }

__device__ __forceinline__ float fexp_(float x) { return __expf(x); }
__device__ __forceinline__ float frcp_(float x) { return __builtin_amdgcn_rcpf(x); }
__device__ __forceinline__ float fsigmoid_(float x) { return frcp_(1.0f + __expf(-x)); }
__device__ __forceinline__ float flog_(float x) { return __logf(x); }
__device__ __forceinline__ float wave_sum(float v) {
#pragma unroll
    for (int o = 32; o > 0; o >>= 1) v += __shfl_xor(v, o);
    return v;
}
__device__ __forceinline__ float block_sum(float v, float* red) {
    v = wave_sum(v);
    const int w = threadIdx.x >> 6, nw = blockDim.x >> 6;
    __syncthreads();
    if ((threadIdx.x & 63) == 0) red[w] = v;
    __syncthreads();
    float s = 0.f;
    for (int i = 0; i < nw; ++i) s += red[i];
    return s;
}

struct RowInfo { int t, len, mrow; };
__device__ __forceinline__ RowInfo row_info(int r) {
    RowInfo ri;
    if (r < NCTX) { ri.t = r % TC; ri.len = TC; ri.mrow = 4; }
    else { const int rr = r - NCTX; ri.t = rr % TL; ri.len = TL; ri.mrow = rr / TL; }
    return ri;
}

typedef short bf16x8 __attribute__((ext_vector_type(8)));
typedef float f32x4 __attribute__((ext_vector_type(4)));
#define NTHR 512
__device__ __forceinline__ int tid_fresh() { int t = threadIdx.x; asm volatile("" : "+v"(t)); return t; }
#define LDS_BYTES 147456
#define LDS_TAB 131072
extern __shared__ __attribute__((aligned(16))) char g_shm[];

__device__ __forceinline__ float bf16_to_f32(bf16_t v) { return __uint_as_float(((unsigned)v) << 16); }
__device__ __forceinline__ float ldz(const bf16_t* p) { return bf16_to_f32(*p); }
__device__ __forceinline__ f32x4 ldz4(const bf16_t* p) { const u32x2 w = *(const u32x2*)p; f32x4 r; r[0] = __uint_as_float(w.x << 16); r[1] = __uint_as_float(w.x & 0xffff0000u); r[2] = __uint_as_float(w.y << 16); r[3] = __uint_as_float(w.y & 0xffff0000u); return r; }

template <int MODE>
__device__ __forceinline__ int src_col(int sn) {
    if (MODE == 2) { const int rho = sn & 31, nn = rho >> 4, ii = rho & 15; sn = (sn & ~31) + 8 * (ii >> 2) + 4 * nn + (ii & 3); }
    if (MODE == 1) {
        const int u = sn >> 8, within = sn & 255, bj = within >> 7, q = within & 127, rho = q & 31, nn = rho >> 4, ii = rho & 15;
        sn = (bj ? 1024 : 0) + u * 128 + (q & ~31) + 8 * (ii >> 2) + 4 * nn + (ii & 3);
    }
    return sn;
}
template <int MODE>
__device__ __forceinline__ void convert_tile(const float* __restrict__ W, int N, bf16_t* __restrict__ Wt, int n0, int k0) {
    float (*tile)[129] = (float (*)[129])g_shm;
    const int tid = tid_fresh();
    const int kr = tid >> 5, n4 = (tid & 31) * 4;
    const int sn = src_col<MODE>(n0 + n4);
    f32x4 v[4];
#pragma unroll
    for (int i = 0; i < 4; ++i) {
        v[i] = (f32x4){0.f, 0.f, 0.f, 0.f};
        if (sn < N) v[i] = *(const f32x4*)(W + (size_t)(k0 + kr + 16 * i) * N + sn);
    }
    __syncthreads();
#pragma unroll
    for (int i = 0; i < 4; ++i) { float* t = &tile[kr + 16 * i][n4]; t[0] = v[i][0]; t[1] = v[i][1]; t[2] = v[i][2]; t[3] = v[i][3]; }
    __syncthreads();
    const int n = tid >> 2, k16 = (tid & 3) * 16;
    u32x4 o0, o1;
    o0.x = cvt_pk_bf16(tile[k16 + 0][n], tile[k16 + 1][n]); o0.y = cvt_pk_bf16(tile[k16 + 2][n], tile[k16 + 3][n]);
    o0.z = cvt_pk_bf16(tile[k16 + 4][n], tile[k16 + 5][n]); o0.w = cvt_pk_bf16(tile[k16 + 6][n], tile[k16 + 7][n]);
    o1.x = cvt_pk_bf16(tile[k16 + 8][n], tile[k16 + 9][n]); o1.y = cvt_pk_bf16(tile[k16 + 10][n], tile[k16 + 11][n]);
    o1.z = cvt_pk_bf16(tile[k16 + 12][n], tile[k16 + 13][n]); o1.w = cvt_pk_bf16(tile[k16 + 14][n], tile[k16 + 15][n]);
    bf16_t* dst = Wt + (size_t)(n0 + n) * 1024 + k0 + k16;
    *(u32x4*)dst = o0; *(u32x4*)(dst + 8) = o1;
}
template <int MODE>
__device__ __forceinline__ int convert_matrix(const float* W, int N, int Npad, bf16_t* Wt, int base, int bi, int G) {
    const int ntiles = (Npad >> 7) * 16;
    for (int it = base + ((bi - base % G) + G) % G; it < base + ntiles; it += G) {
        const int l = it - base;
        convert_tile<MODE>(W, N, Wt, (l >> 4) * 128, (l & 15) * 64);
    }
    return base + ntiles;
}
__device__ __forceinline__ void lds_barrier() { asm volatile("s_waitcnt lgkmcnt(0)" ::: "memory"); __builtin_amdgcn_s_barrier(); asm volatile("" ::: "memory"); }
__device__ __forceinline__ void convert_experts(const float* __restrict__ wgu, const float* __restrict__ wdn, bf16_t* __restrict__ wguT, bf16_t* __restrict__ wdnT, int le0, int le1, int bi, int G) {
    float (*tile)[129] = (float (*)[129])g_shm;
    const int tid = tid_fresh();
    const int kr = tid >> 5, n4 = (tid & 31) * 4;
    const int n = tid >> 2, k16 = (tid & 3) * 16;
    const int total = (le1 - le0) * 384;
    f32x4 v[4];
    auto issue = [&](int item) {
        const int e = le0 + item / 384, t = item % 384;
        const bool gu = t < 256; const int l = gu ? t : t - 256;
        const int n0 = (l >> 4) * 128, k0 = (l & 15) * 64, N = gu ? 2048 : 1024;
        const float* W = gu ? wgu + (size_t)e * 1024 * 2048 : wdn + (size_t)e * 1024 * 1024;
        const int sn = gu ? src_col<1>(n0 + n4) : src_col<2>(n0 + n4);
#pragma unroll
        for (int i = 0; i < 4; ++i) v[i] = *(const f32x4*)(W + (size_t)(k0 + kr + 16 * i) * N + sn);
    };
    __syncthreads();
    int item = bi;
    if (item < total) issue(item);
    for (; item < total; item += G) {
        lds_barrier();
#pragma unroll
        for (int i = 0; i < 4; ++i) { float* t = &tile[kr + 16 * i][n4]; t[0] = v[i][0]; t[1] = v[i][1]; t[2] = v[i][2]; t[3] = v[i][3]; }
        const int e = le0 + item / 384, t = item % 384;
        const bool gu = t < 256; const int l = gu ? t : t - 256;
        bf16_t* dst = (gu ? wguT + (size_t)e * 2048 * 1024 : wdnT + (size_t)e * 1024 * 1024) + (size_t)((l >> 4) * 128 + n) * 1024 + (l & 15) * 64 + k16;
        if (item + G < total) issue(item + G);
        lds_barrier();
        u32x4 o0, o1;
        o0.x = cvt_pk_bf16(tile[k16 + 0][n], tile[k16 + 1][n]); o0.y = cvt_pk_bf16(tile[k16 + 2][n], tile[k16 + 3][n]);
        o0.z = cvt_pk_bf16(tile[k16 + 4][n], tile[k16 + 5][n]); o0.w = cvt_pk_bf16(tile[k16 + 6][n], tile[k16 + 7][n]);
        o1.x = cvt_pk_bf16(tile[k16 + 8][n], tile[k16 + 9][n]); o1.y = cvt_pk_bf16(tile[k16 + 10][n], tile[k16 + 11][n]);
        o1.z = cvt_pk_bf16(tile[k16 + 12][n], tile[k16 + 13][n]); o1.w = cvt_pk_bf16(tile[k16 + 14][n], tile[k16 + 15][n]);
        *(u32x4*)dst = o0; *(u32x4*)(dst + 8) = o1;
    }
    __syncthreads();
}

__device__ __forceinline__ int lds_byte(int r, int c) { const int st = (r >> 4) * 2 + (c >> 5), rr = r & 15, cc = c & 31, ob = rr * 64 + cc * 2; return st * 1024 + (ob ^ (((ob >> 9) & 1) << 5)); }
__device__ __forceinline__ void stage_rc(int b, int& R, int& C) { const int st = b / 1024, sb = b % 1024, swz = sb ^ (((sb >> 9) & 1) << 5); R = (st >> 1) * 16 + swz / 64; C = (st & 1) * 32 + (swz % 64) / 2; }

#define G_HT (128 * 64)
#define G_SA(b, h) (shm + ((b) * 2 + (h)) * G_HT)
#define G_SB(b, h) (shm + (4 + (b) * 2 + (h)) * G_HT)
#define G_GLDS(src, dst) __builtin_amdgcn_global_load_lds((const unsigned*)(src), (unsigned*)(dst), 16, 0, 0)
#define G_STAGE_A(P, h, kt) do { G_GLDS(Ab + (size_t)(unsigned)((h ? a10 : a00) + (unsigned)(kt) * 128u), (char*)(P) + tb); G_GLDS(Ab + (size_t)(unsigned)((h ? a11 : a01) + (unsigned)(kt) * 128u), (char*)(P) + tb + 8192); } while (0)
#define G_STAGE_B(P, h, kt) do { G_GLDS(Bb + (size_t)(unsigned)(bofs + (unsigned)((h) * (128 * 2048)) + (unsigned)(kt) * 128u), (char*)(P) + tb); G_GLDS(Bb + (size_t)(unsigned)(bofs + (unsigned)((h) * (128 * 2048) + 64 * 2048) + (unsigned)(kt) * 128u), (char*)(P) + tb + 8192); } while (0)
#define G_LDA(dst, b, h) for (int m = 0; m < 4; ++m) for (int k = 0; k < 2; ++k) dst[m][k] = *reinterpret_cast<const bf16x8*>((char*)G_SA(b, h) + lds_byte(wr * 64 + m * 16 + fr, k * 32 + fq * 8))
#define G_LDB(dst, b, h) for (int n = 0; n < 2; ++n) for (int k = 0; k < 2; ++k) dst[n][k] = *reinterpret_cast<const bf16x8*>((char*)G_SB(b, h) + lds_byte(wc * 32 + n * 16 + fr, k * 32 + fq * 8))
#define G_MMA(ai, bj, At_, Bt_) do { __builtin_amdgcn_s_setprio(1); \
    for (int m = 0; m < 4; ++m) for (int n = 0; n < 2; ++n) for (int k = 0; k < 2; ++k) \
        acc[ai][bj][m][n] = __builtin_amdgcn_mfma_f32_16x16x32_bf16(Bt_[n][k], At_[m][k], acc[ai][bj][m][n], 0, 0, 0); \
    __builtin_amdgcn_s_setprio(0); } while (0)
#define G_WAIT_V(n) asm volatile("s_waitcnt vmcnt(" #n ")" ::: "memory")
#define G_WAIT_L(n) asm volatile("s_waitcnt lgkmcnt(" #n ")" ::: "memory")
#define G_BAR __builtin_amdgcn_s_barrier()
#define G_SCHED __builtin_amdgcn_sched_barrier(0)

#define G_STAGE_AX(P, X0, X1, kt) do { G_GLDS(Ab + (size_t)(unsigned)((X0) + (unsigned)(kt) * 128u), (char*)(P) + tb); G_GLDS(Ab + (size_t)(unsigned)((X1) + (unsigned)(kt) * 128u), (char*)(P) + tb + 8192); } while (0)
#define G_STAGE_BX(P, XB, h, kt) do { G_GLDS(Bb + (size_t)(unsigned)((XB) + (unsigned)((h) * (128 * 2048)) + (unsigned)(kt) * 128u), (char*)(P) + tb); G_GLDS(Bb + (size_t)(unsigned)((XB) + (unsigned)((h) * (128 * 2048) + 64 * 2048) + (unsigned)(kt) * 128u), (char*)(P) + tb + 8192); } while (0)
template <class Sched>
__device__ __forceinline__ void gemm_stream(const bf16_t* __restrict__ A, const bf16_t* __restrict__ Bt, const Sched& S) {
    typename Sched::U cur, nxt;
    if (!S.get(0, cur)) return;
    bf16_t* shm = (bf16_t*)g_shm;
    const int tid = tid_fresh();
    const int tb = tid * 16;
    int R0, C0; stage_rc(tb, R0, C0);
    const char* Ab = (const char*)A; const char* Bb = (const char*)Bt;
    unsigned a00, a01, a10, a11, bofs;
    S.addrs(cur, R0, C0, a00, a01, a10, a11, bofs);
    const int wid = tid >> 6, lane = tid & 63, wr = wid >> 2, wc = wid & 3, fr = lane & 15, fq = lane >> 4;
    bf16x8 At[4][2], B0[2][2], B1[2][2];
    constexpr int nt = 16;
    G_STAGE_BX(G_SB(0, 0), bofs, 0, 0); G_STAGE_AX(G_SA(0, 0), a00, a01, 0);
    G_STAGE_BX(G_SB(0, 1), bofs, 1, 0); G_STAGE_AX(G_SA(0, 1), a10, a11, 0);
    if (wr == 1) G_BAR;
    G_WAIT_V(4); G_BAR;
    G_STAGE_BX(G_SB(1, 0), bofs, 0, 1); G_STAGE_AX(G_SA(1, 0), a00, a01, 1); G_STAGE_BX(G_SB(1, 1), bofs, 1, 1);
    G_WAIT_V(6); G_BAR;
    bool more = true;
    for (int ui = 0; more; ++ui) {
        more = S.get(ui + 1, nxt);
        unsigned n00 = a00, n01 = a01, n10 = a10, n11 = a11, nb = bofs;
        if (more) S.addrs(nxt, R0, C0, n00, n01, n10, n11, nb);
        f32x4 acc[2][2][4][2] = {};
        for (int t = 0; t < nt; t += 2) {
            const bool last = (t == nt - 2);
            const unsigned s00 = last ? n00 : a00, s01 = last ? n01 : a01, s10 = last ? n10 : a10, s11 = last ? n11 : a11, sb = last ? nb : bofs;
            const int k2 = last ? 0 : t + 2, k3 = last ? 1 : t + 3;
            G_LDB(B0, 0, 0); G_SCHED; G_LDA(At, 0, 0); G_STAGE_AX(G_SA(1, 1), a10, a11, t + 1);
            G_WAIT_L(8); G_BAR; G_WAIT_L(0); G_MMA(0, 0, At, B0); G_BAR; G_SCHED;
            G_LDB(B1, 0, 1); G_STAGE_BX(G_SB(0, 0), sb, 0, k2);
            G_BAR; G_WAIT_L(0); G_MMA(0, 1, At, B1); G_BAR;
            G_LDA(At, 0, 1); G_STAGE_AX(G_SA(0, 0), s00, s01, k2);
            G_BAR; G_WAIT_L(0); G_MMA(1, 0, At, B0); G_BAR; G_SCHED;
            G_STAGE_BX(G_SB(0, 1), sb, 1, k2);
            G_WAIT_V(6); G_BAR; G_MMA(1, 1, At, B1); G_BAR;
            G_LDB(B0, 1, 0); G_SCHED; G_LDA(At, 1, 0); G_STAGE_AX(G_SA(0, 1), s10, s11, k2);
            G_WAIT_L(8); G_BAR; G_WAIT_L(0); G_MMA(0, 0, At, B0); G_BAR; G_SCHED;
            G_LDB(B1, 1, 1); G_STAGE_BX(G_SB(1, 0), sb, 0, k3);
            G_BAR; G_WAIT_L(0); G_MMA(0, 1, At, B1); G_BAR;
            G_LDA(At, 1, 1); G_STAGE_AX(G_SA(1, 0), s00, s01, k3);
            G_BAR; G_WAIT_L(0); G_MMA(1, 0, At, B0); G_BAR; G_SCHED;
            G_STAGE_BX(G_SB(1, 1), sb, 1, k3);
            G_WAIT_V(6); G_BAR; G_MMA(1, 1, At, B1); G_BAR;
        }
        S.epi(cur, acc, wr, wc, fr, fq);
        cur = nxt; a00 = n00; a01 = n01; a10 = n10; a11 = n11; bofs = nb;
    }
    G_WAIT_V(0);
    if (wr == 0) G_BAR;
}

__device__ __forceinline__ bool dense_unit(int i, int nM, int nN, int& pm, int& pn) {
    const int G = gridDim.x, c = blockIdx.x;
    const int v = (G % 8 == 0) ? ((c % 8) * (G / 8) + c / 8) : c;
    const long L = (long)i * G + v;
    const int nwg = nM * nN;
    if (L >= nwg) return false;
    const int wgid = (int)L;
    const int nig = 16 * nN, gid = wgid / nig, fm = gid * 16, gsz = (nM - fm) < 16 ? (nM - fm) : 16;
    pm = fm + ((wgid % nig) % gsz); pn = (wgid % nig) / gsz;
    return true;
}
struct UDense { int pm, pn; };
template <class Derived> struct DenseBase {
    typedef UDense U;
    int nM, nN, row_base;
    __device__ __forceinline__ bool get(int i, U& u) const { return dense_unit(i, nM, nN, u.pm, u.pn); }
    __device__ __forceinline__ void addrs(const U& u, int R0, int C0, unsigned& a00, unsigned& a01, unsigned& a10, unsigned& a11, unsigned& bofs) const {
        const unsigned r = (unsigned)(row_base + u.pm * 256 + R0);
        a00 = (r * 1024u + C0) * 2u; a01 = a00 + 64u * 2048u; a10 = a00 + 128u * 2048u; a11 = a00 + 192u * 2048u;
        bofs = ((unsigned)(u.pn * 256 + R0) * 1024u + C0) * 2u;
    }
};
struct SchedBf16 : DenseBase<SchedBf16> {
    bf16_t* C; int ldc, N;
    __device__ __forceinline__ void epi(const UDense& u, const f32x4 (&acc)[2][2][4][2], int wr, int wc, int fr, int fq) const {
        const int row0 = row_base + u.pm * 256, col0 = u.pn * 256;
#pragma unroll
        for (int ai = 0; ai < 2; ++ai)
#pragma unroll
            for (int m = 0; m < 4; ++m) {
                bf16_t* rowp = C + (size_t)(row0 + ai * 128 + wr * 64 + m * 16 + fr) * ldc;
#pragma unroll
                for (int bj = 0; bj < 2; ++bj) {
                    const int c = col0 + bj * 128 + wc * 32 + fq * 8;
                    const f32x4 x = acc[ai][bj][m][0], y = acc[ai][bj][m][1];
                    if (c < N) st_bf16x8(rowp + c, x[0], x[1], x[2], x[3], y[0], y[1], y[2], y[3]);
                }
            }
    }
};
struct SchedResid : DenseBase<SchedResid> {
    const float* src_ctx; const float* src_lat; const float* gate; float* H;
    __device__ __forceinline__ void epi(const UDense& u, const f32x4 (&acc)[2][2][4][2], int wr, int wc, int fr, int fq) const {
        const int row0 = row_base + u.pm * 256, col0 = u.pn * 256;
#pragma unroll
        for (int ai = 0; ai < 2; ++ai)
#pragma unroll
            for (int m = 0; m < 4; ++m) {
                const int r = row0 + ai * 128 + wr * 64 + m * 16 + fr;
                const float* sp = r < NCTX ? src_ctx + (size_t)r * DM : src_lat + (size_t)(r - NCTX) * DM;
                const float* gp = gate + (size_t)(r < NCTX ? 4 : (r - NCTX) / TL) * 6144;
                float* hp = H + (size_t)r * DM;
#pragma unroll
                for (int bj = 0; bj < 2; ++bj)
#pragma unroll
                    for (int n = 0; n < 2; ++n) {
                        const int c = col0 + bj * 128 + wc * 32 + n * 16 + fq * 4;
                        const f32x4 x = *(const f32x4*)(sp + c), g = *(const f32x4*)(gp + c);
                        *(f32x4*)(hp + c) = x + g * acc[ai][bj][m][n];
                    }
            }
    }
};
__device__ __forceinline__ void ph_gemm_bf16out(const bf16_t* A, int row_base, int M, const bf16_t* Bt, int N, int Npad, bf16_t* C, int ldc) {
    SchedBf16 S; S.nM = M / 256; S.nN = Npad / 256; S.row_base = row_base; S.C = C; S.ldc = ldc; S.N = N;
    gemm_stream(A, Bt, S);
}
__device__ __forceinline__ void ph_gemm_resid(const bf16_t* A, int row_base, int M, const bf16_t* Bt, const float* src_ctx, const float* src_lat, const float* gate, float* H) {
    SchedResid S; S.nM = M / 256; S.nN = 4; S.row_base = row_base; S.src_ctx = src_ctx; S.src_lat = src_lat; S.gate = gate; S.H = H;
    gemm_stream(A, Bt, S);
}

struct UMoe { int e, pm, pn, off; };
__device__ __forceinline__ void moe_table(const int* __restrict__ meta, int nN) {
    int* TAB = (int*)(g_shm + LDS_TAB);
    __syncthreads();
    if (threadIdx.x == 0) {
        int us = 0;
        for (int x = 0; x < NEXP; ++x) { const int nrt = (meta[x] + 255) >> 8; TAB[x] = us; TAB[32 + x] = nrt; TAB[64 + x] = meta[64 + x]; us += nrt * nN; }
        TAB[96] = us;
    }
    __syncthreads();
}
__device__ __forceinline__ bool moe_unit(int i, int nN, UMoe& u) {
    const int* TAB = (const int*)(g_shm + LDS_TAB);
    const int G = gridDim.x, c = blockIdx.x;
    const int v = (G % 8 == 0) ? ((c % 8) * (G / 8) + c / 8) : c;
    const int L = i * G + v;
    if (L >= TAB[96]) return false;
    int x = 0;
#pragma unroll
    for (int st = 16; st > 0; st >>= 1) if (TAB[x + st] <= L) x += st;
    const int wgid = L - TAB[x], nrt = TAB[32 + x];
    const int nig = 8 * nN, gid = wgid / nig, fm = gid * 8, gsz = (nrt - fm) < 8 ? (nrt - fm) : 8;
    u.e = x; u.off = TAB[64 + x]; u.pm = fm + ((wgid % nig) % gsz); u.pn = (wgid % nig) / gsz;
    return true;
}
struct SchedGU {
    typedef UMoe U;
    const int* meta; const int* list; const float* bgu; bf16_t* act;
    __device__ __forceinline__ bool get(int i, U& u) const { return moe_unit(i, 8, u); }
    __device__ __forceinline__ void addrs(const U& u, int R0, int C0, unsigned& a00, unsigned& a01, unsigned& a10, unsigned& a11, unsigned& bofs) const {
        const int* lp = list + u.off + u.pm * 256 + R0;
        a00 = ((unsigned)lp[0] * 1024u + C0) * 2u; a01 = ((unsigned)lp[64] * 1024u + C0) * 2u; a10 = ((unsigned)lp[128] * 1024u + C0) * 2u; a11 = ((unsigned)lp[192] * 1024u + C0) * 2u;
        bofs = ((unsigned)(u.e * 2048 + u.pn * 256 + R0) * 1024u + C0) * 2u;
    }
    __device__ __forceinline__ void epi(const U& u, const f32x4 (&acc)[2][2][4][2], int wr, int wc, int fr, int fq) const {
        const int s0 = u.off + u.pm * 256;
        const float* bg_ = bgu + (size_t)u.e * 2048;
        const int ch = u.pn * 128 + wc * 32 + fq * 8;
        const f32x4 bg0 = *(const f32x4*)(bg_ + ch), bg1 = *(const f32x4*)(bg_ + ch + 4), bl0 = *(const f32x4*)(bg_ + 1024 + ch), bl1 = *(const f32x4*)(bg_ + 1024 + ch + 4);
#pragma unroll
        for (int ai = 0; ai < 2; ++ai)
#pragma unroll
            for (int m = 0; m < 4; ++m) {
                const int slot = s0 + ai * 128 + wr * 64 + m * 16 + fr;
                float o[8];
#pragma unroll
                for (int n = 0; n < 2; ++n)
#pragma unroll
                    for (int j = 0; j < 4; ++j) {
                        float g = acc[ai][0][m][n][j] + (n ? bg1[j] : bg0[j]), l = acc[ai][1][m][n][j] + (n ? bl1[j] : bl0[j]);
                        g = fminf(g, 7.0f); l = fminf(fmaxf(l, -7.0f), 7.0f);
                        o[n * 4 + j] = g * frcp_(1.0f + __expf(-1.702f * g)) * (l + 1.0f);
                    }
                st_bf16x8(act + (size_t)slot * 1024 + ch, o[0], o[1], o[2], o[3], o[4], o[5], o[6], o[7]);
            }
    }
};
struct SchedDN {
    typedef UMoe U;
    const int* meta; const float* bdn; bf16_t* ys; const float* slot_w;
    __device__ __forceinline__ bool get(int i, U& u) const { return moe_unit(i, 4, u); }
    __device__ __forceinline__ void addrs(const U& u, int R0, int C0, unsigned& a00, unsigned& a01, unsigned& a10, unsigned& a11, unsigned& bofs) const {
        const unsigned r = (unsigned)(u.off + u.pm * 256 + R0);
        a00 = (r * 1024u + C0) * 2u; a01 = a00 + 64u * 2048u; a10 = a00 + 128u * 2048u; a11 = a00 + 192u * 2048u;
        bofs = ((unsigned)(u.e * 1024 + u.pn * 256 + R0) * 1024u + C0) * 2u;
    }
    __device__ __forceinline__ void epi(const U& u, const f32x4 (&acc)[2][2][4][2], int wr, int wc, int fr, int fq) const {
        const int s0 = u.off + u.pm * 256, col0 = u.pn * 256;
        const float* bd_ = bdn + (size_t)u.e * 1024;
#pragma unroll
        for (int bj = 0; bj < 2; ++bj) {
            const int c = col0 + bj * 128 + wc * 32 + fq * 8;
            const f32x4 b0 = *(const f32x4*)(bd_ + c), b1 = *(const f32x4*)(bd_ + c + 4);
#pragma unroll
            for (int ai = 0; ai < 2; ++ai)
#pragma unroll
                for (int m = 0; m < 4; ++m) {
                    const int slot = s0 + ai * 128 + wr * 64 + m * 16 + fr;
                    const float w = slot_w[slot];
                    const f32x4 x = (acc[ai][bj][m][0] + b0) * w, y = (acc[ai][bj][m][1] + b1) * w;
                    st_bf16x8(ys + (size_t)slot * 1024 + c, x[0], x[1], x[2], x[3], y[0], y[1], y[2], y[3]);
                }
        }
    }
};
__device__ __forceinline__ void ph_moe_gu(const bf16_t* V, const int* meta, const int* list, const bf16_t* WguT, const float* bgu, bf16_t* act) {
    SchedGU S; S.meta = meta; S.list = list; S.bgu = bgu; S.act = act;
    moe_table(meta, 8);
    gemm_stream(V, WguT, S);
}
__device__ __forceinline__ void ph_moe_dn(const bf16_t* act, const int* meta, const bf16_t* WdnT, const float* bdn, bf16_t* ys, const float* slot_w) {
    SchedDN S; S.meta = meta; S.bdn = bdn; S.ys = ys; S.slot_w = slot_w;
    moe_table(meta, 4);
    gemm_stream(act, WdnT, S);
}

#define NCHUNK 528
#define REC 8320
#define LP 72
__device__ __forceinline__ size_t rec_off(int type, int dir, int h, int g) { return ((size_t)(((type * 2 + dir) * 4 + h) * NCHUNK + g)) * REC; }
__device__ __forceinline__ int chunk_g(int b, int dir, int s) {
    if (s < 4) return b * 4 + (dir ? 3 - s : s);
    const int s2 = s - 4; return 16 + b * 128 + (dir ? 127 - s2 : s2);
}
__device__ __forceinline__ float wave_incl_prefix(float v, int lane) {
#pragma unroll
    for (int o = 1; o < 64; o <<= 1) { const float t = __shfl_up(v, o); if (lane >= o) v += t; }
    return v;
}
__device__ __forceinline__ float wave_incl_suffix(float v, int lane) {
#pragma unroll
    for (int o = 1; o < 64; o <<= 1) { const float t = __shfl_down(v, o); if (lane + o < 64) v += t; }
    return v;
}
__device__ __forceinline__ float wave_prefix_max(float v, int lane) {
#pragma unroll
    for (int o = 1; o < 64; o <<= 1) { const float t = __shfl_up(v, o); if (lane >= o) v = fmaxf(v, t); }
    return v;
}
__device__ __forceinline__ float wave_suffix_max(float v, int lane) {
#pragma unroll
    for (int o = 1; o < 64; o <<= 1) { const float t = __shfl_down(v, o); if (lane + o < 64) v = fmaxf(v, t); }
    return v;
}
__device__ __forceinline__ float wave_max(float v) {
#pragma unroll
    for (int o = 32; o > 0; o >>= 1) v = fmaxf(v, __shfl_xor(v, o));
    return v;
}
__device__ __forceinline__ bf16x8 lds_frag(const bf16_t* base, int row, int kofs) { return *(const bf16x8*)(base + row * LP + kofs); }
__device__ __forceinline__ bf16_t f2bf(float x) { return (bf16_t)(cvt_pk_bf16(x, 0.f) & 0xffffu); }

struct L0Args {
    const bf16_t* z;
    const float* ml_conv; const float* gate_b; const float* ret_decay; const float* ret_norm; const float* ml_norm;
    bf16_t* RQ; bf16_t* RK; bf16_t* MQ; bf16_t* MK;
    float* LIF;
    bf16_t* ST;
    float* CM;
    float* MI;
    bf16_t* MG;
};

__device__ __forceinline__ void ph_l0_prep(const L0Args& a) {
    const int tfz = tid_fresh(); const int wid = tfz >> 6, lane = tfz & 63;
    for (int r = blockIdx.x * 8 + wid; r < NTOK; r += gridDim.x * 8) {
        const RowInfo ri = row_info(r);
        const bf16_t* zc = a.z + (size_t)r * AB_IN;
        {
            const int h = lane >> 4, hf = (lane >> 3) & 1, j0 = (lane & 7) * 4;
            const f32x4 q1 = ldz4(zc + h * 64 + j0), q2 = ldz4(zc + h * 64 + 32 + j0);
            const f32x4 k1 = ldz4(zc + 256 + h * 64 + j0), k2 = ldz4(zc + 256 + h * 64 + 32 + j0);
            f32x4 qo, ko;
            if (r >= NCTX) {
#pragma unroll
                for (int x = 0; x < 4; ++x) {
                    const int j = j0 + x;
                    const float pos = (j < 16) ? (float)(ri.t >> 6) : (float)(ri.t & 63);
                    const float inv = exp2f(-(float)(j & 15) * 0.83048202372184059f);
                    const float ang = pos * inv;
                    const float cs = __cosf(ang), sn = __sinf(ang);
                    qo[x] = hf ? (q1[x] * sn + q2[x] * cs) : (q1[x] * cs - q2[x] * sn);
                    ko[x] = hf ? (k1[x] * sn + k2[x] * cs) : (k1[x] * cs - k2[x] * sn);
                }
            } else { qo = hf ? q2 : q1; ko = hf ? k2 : k1; }
            const int d0 = h * 64 + hf * 32 + j0;
            st_bf16x4(a.RQ + (size_t)r * 256 + d0, qo[0], qo[1], qo[2], qo[3]);
            st_bf16x4(a.RK + (size_t)r * 256 + d0, ko[0] * 0.125f, ko[1] * 0.125f, ko[2] * 0.125f, ko[3] * 0.125f);
        }
#pragma unroll
        for (int rep = 0; rep < 2; ++rep) {
            const int ch = rep * 256 + lane * 4;
            f32x4 cv = ldz4(zc + 1536 + ch) * *(const f32x4*)(a.ml_conv + 512 + ch);
            if (ri.t > 0) cv += ldz4(zc + 1536 + ch - AB_IN) * *(const f32x4*)(a.ml_conv + ch);
            if (ri.t < ri.len - 1) cv += ldz4(zc + 1536 + ch + AB_IN) * *(const f32x4*)(a.ml_conv + 1024 + ch);
            float o[4];
#pragma unroll
            for (int x = 0; x < 4; ++x) o[x] = cv[x] * frcp_(1.0f + __expf(-cv[x])) * (rep == 0 ? 0.125f : 1.0f);
            st_bf16x4((rep == 0 ? a.MQ : a.MK) + (size_t)r * 256 + lane * 4, o[0], o[1], o[2], o[3]);
        }
        if (lane < 16) {
            const float val = ldz(zc + 3072 + lane) + a.gate_b[lane];
            const int d = lane >> 3, gi = (lane >> 2) & 1, h = lane & 3;
            a.LIF[(size_t)r * 16 + gi * 8 + d * 4 + h] = gi ? logsigmoidf_(val) : val;
        }
    }
}

__device__ __forceinline__ void ph_l0_local(const L0Args& a) {
    bf16_t* KT = (bf16_t*)g_shm;
    bf16_t* VT = (bf16_t*)(g_shm + 4 * 64 * LP * 2);
    float* SC = (float*)(g_shm + 4 * 64 * LP * 2 + 2 * 128 * LP * 2);
    const int tid = tid_fresh(), wid = tid >> 6, lane = tid & 63, fr = lane & 15, fq = lane >> 4;
    const int kd = tid & 63, jg = tid >> 6, dv = tid & 127, vg = tid >> 7;
    bf16_t pk[2][8], pv[2][16]; float pli = 0.f, plf = 0.f;
    auto prefetch = [&](int it) {
        const int g = it >> 2, h = it & 3, row0 = g * 64;
#pragma unroll
        for (int ty = 0; ty < 2; ++ty) {
            const bf16_t* src = (ty ? a.MK : a.RK) + (size_t)(row0 + jg * 8) * 256 + h * 64 + kd;
#pragma unroll
            for (int x = 0; x < 8; ++x) pk[ty][x] = src[(size_t)x * 256];
            const bf16_t* sv = a.z + (size_t)(row0 + vg * 16) * AB_IN + (ty ? 2048 : 512) + h * 128 + dv;
#pragma unroll
            for (int x = 0; x < 16; ++x) pv[ty][x] = sv[(size_t)x * AB_IN];
        }
        if (wid == 1 || wid == 2) { const int dir = wid - 1; pli = a.LIF[(size_t)(row0 + lane) * 16 + dir * 4 + h]; plf = a.LIF[(size_t)(row0 + lane) * 16 + 8 + dir * 4 + h]; }
    };
    if ((int)blockIdx.x < NCHUNK * 4) prefetch(blockIdx.x);
    for (int it = blockIdx.x; it < NCHUNK * 4; it += gridDim.x) {
        const int g = it >> 2, h = it & 3;
        __syncthreads();
        if (wid == 0) {
            const float l2f = log2f(1.0f - expf(a.ret_decay[h])), l2b = log2f(1.0f - expf(a.ret_decay[4 + h]));
            SC[lane] = exp2f((float)(63 - lane) * l2f);
            SC[64 + lane] = exp2f((float)lane * l2b);
        } else if (wid == 1 || wid == 2) {
            const int dir = wid - 1;
            const float bc = dir ? wave_incl_suffix(plf, lane) : wave_incl_prefix(plf, lane);
            const float btot = __shfl(bc, dir ? 0 : 63);
            const float lw = btot - bc + pli;
            const float mloc = wave_max(lw);
            SC[(2 + dir) * 64 + lane] = fexp_(lw - mloc);
            if (lane == 0) { float* cm = a.CM + ((size_t)(dir * 4 + h) * NCHUNK + g) * 2; cm[0] = btot; cm[1] = mloc; }
        }
        __syncthreads();
#pragma unroll
        for (int ty = 0; ty < 2; ++ty) {
#pragma unroll
            for (int dir = 0; dir < 2; ++dir) {
                const float* sc = SC + (ty * 2 + dir) * 64 + jg * 8;
                u32x4 o;
                o.x = cvt_pk_bf16(bf16_to_f32(pk[ty][0]) * sc[0], bf16_to_f32(pk[ty][1]) * sc[1]); o.y = cvt_pk_bf16(bf16_to_f32(pk[ty][2]) * sc[2], bf16_to_f32(pk[ty][3]) * sc[3]);
                o.z = cvt_pk_bf16(bf16_to_f32(pk[ty][4]) * sc[4], bf16_to_f32(pk[ty][5]) * sc[5]); o.w = cvt_pk_bf16(bf16_to_f32(pk[ty][6]) * sc[6], bf16_to_f32(pk[ty][7]) * sc[7]);
                *(u32x4*)(KT + (ty * 2 + dir) * 64 * LP + (((kd >> 2) & 3) * 16 + (kd >> 4) * 4 + (kd & 3)) * LP + jg * 8) = o;
            }
            u32x4 o0, o1;
            o0.x = (unsigned)pv[ty][0] | ((unsigned)pv[ty][1] << 16); o0.y = (unsigned)pv[ty][2] | ((unsigned)pv[ty][3] << 16);
            o0.z = (unsigned)pv[ty][4] | ((unsigned)pv[ty][5] << 16); o0.w = (unsigned)pv[ty][6] | ((unsigned)pv[ty][7] << 16);
            o1.x = (unsigned)pv[ty][8] | ((unsigned)pv[ty][9] << 16); o1.y = (unsigned)pv[ty][10] | ((unsigned)pv[ty][11] << 16);
            o1.z = (unsigned)pv[ty][12] | ((unsigned)pv[ty][13] << 16); o1.w = (unsigned)pv[ty][14] | ((unsigned)pv[ty][15] << 16);
            *(u32x4*)(VT + ty * 128 * LP + dv * LP + vg * 16) = o0;
            *(u32x4*)(VT + ty * 128 * LP + dv * LP + vg * 16 + 8) = o1;
        }
        if (it + (int)gridDim.x < NCHUNK * 4) prefetch(it + gridDim.x);
        __syncthreads();
#pragma unroll
        for (int ty = 0; ty < 2; ++ty) {
            const bf16x8 v0 = lds_frag(VT + ty * 128 * LP, wid * 16 + fr, fq * 8), v1 = lds_frag(VT + ty * 128 * LP, wid * 16 + fr, 32 + fq * 8);
#pragma unroll
            for (int dir = 0; dir < 2; ++dir) {
                const bf16_t* kt = KT + (ty * 2 + dir) * 64 * LP;
                bf16_t* st = a.ST + rec_off(ty, dir, h, g) + (size_t)(wid * 16 + fr) * 64 + fq * 16;
#pragma unroll
                for (int dp = 0; dp < 2; ++dp) {
                    f32x4 acc0 = {0.f, 0.f, 0.f, 0.f}, acc1 = {0.f, 0.f, 0.f, 0.f};
                    acc0 = __builtin_amdgcn_mfma_f32_16x16x32_bf16(lds_frag(kt, (2 * dp) * 16 + fr, fq * 8), v0, acc0, 0, 0, 0);
                    acc0 = __builtin_amdgcn_mfma_f32_16x16x32_bf16(lds_frag(kt, (2 * dp) * 16 + fr, 32 + fq * 8), v1, acc0, 0, 0, 0);
                    acc1 = __builtin_amdgcn_mfma_f32_16x16x32_bf16(lds_frag(kt, (2 * dp + 1) * 16 + fr, fq * 8), v0, acc1, 0, 0, 0);
                    acc1 = __builtin_amdgcn_mfma_f32_16x16x32_bf16(lds_frag(kt, (2 * dp + 1) * 16 + fr, 32 + fq * 8), v1, acc1, 0, 0, 0);
                    st_bf16x8(st + dp * 8, acc0[0], acc0[1], acc0[2], acc0[3], acc1[0], acc1[1], acc1[2], acc1[3]);
                }
            }
        }
        if (tid < 128) {
            const int dir = tid >> 6, d = tid & 63;
            const bf16_t* kt = KT + (2 + dir) * 64 * LP + (((d >> 2) & 3) * 16 + (d >> 4) * 4 + (d & 3)) * LP;
            float sum = 0.f;
#pragma unroll 16
            for (int j = 0; j < 64; ++j) sum += bf16_to_f32(kt[j]);
            ((float*)(a.ST + rec_off(1, dir, h, g) + 8192))[d] = sum;
        }
    }
}

__device__ __forceinline__ void ph_l0_prop(const L0Args& a) {
    for (int idx = blockIdx.x * NTHR + tid_fresh(); idx < 64 * 2064; idx += gridDim.x * NTHR) {
        const int seq = idx / 2064, e4 = idx % 2064;
        const int ty = seq >> 5, dir = (seq >> 4) & 1, h = (seq >> 2) & 3, b = seq & 3;
        if (ty == 0 && e4 >= 2048) continue;
        const bool isn = e4 >= 2048;
        f32x4 S = {0.f, 0.f, 0.f, 0.f};
        float m = 0.f;
        const float g64 = exp2f(64.0f * log2f(1.0f - expf(a.ret_decay[dir * 4 + h])));
        for (int s0 = 0; s0 < 132; s0 += 12) {
            f32x4 loc[12]; float bt[12], ml[12];
#pragma unroll
            for (int i = 0; i < 12; ++i) {
                const int g = chunk_g(b, dir, s0 + i);
                bf16_t* rp = a.ST + rec_off(ty, dir, h, g);
                if (isn) loc[i] = *(const f32x4*)((const float*)(rp + 8192) + (e4 - 2048) * 4); else loc[i] = ldz4(rp + (size_t)e4 * 4);
                if (ty == 1) { const float* cm = a.CM + ((size_t)(dir * 4 + h) * NCHUNK + g) * 2; bt[i] = cm[0]; ml[i] = cm[1]; } else { bt[i] = 0.f; ml[i] = 0.f; }
            }
#pragma unroll
            for (int i = 0; i < 12; ++i) {
                const int g = chunk_g(b, dir, s0 + i);
                float dec, wl;
                if (ty == 0) { dec = g64; wl = 1.0f; }
                else {
                    const float mn = fmaxf(bt[i] + m, ml[i]);
                    dec = expf(bt[i] + m - mn); wl = expf(ml[i] - mn);
                    if (e4 == 0) a.MI[(size_t)(dir * 4 + h) * NCHUNK + g] = m;
                    m = mn;
                }
                bf16_t* rp = a.ST + rec_off(ty, dir, h, g);
                if (isn) *(f32x4*)((float*)(rp + 8192) + (e4 - 2048) * 4) = S; else st_bf16x4(rp + (size_t)e4 * 4, S[0], S[1], S[2], S[3]);
                S = S * dec + loc[i] * wl;
            }
        }
    }
}

__device__ __forceinline__ void ph_l0_out(const L0Args& a) {
    bf16_t* Qs = (bf16_t*)g_shm;
    bf16_t* Ks = Qs + 64 * LP;
    bf16_t* ATT = Ks + 64 * LP;
    bf16_t* VT = ATT + 64 * LP;
    bf16_t* SF = VT + 128 * LP;
    bf16_t* SB = SF + 144 * LP;
    float* FV = (float*)(SB + 144 * LP);
    const int tid = tid_fresh(), wid = tid >> 6, lane = tid & 63, fr = lane & 15, fq = lane >> 4;
    u32x4 pq, pkk; bf16_t pv[16]; float pli = 0.f, plf = 0.f, pmi = 0.f;
    auto prefetch = [&](int it) {
        const int ty = it & 1, h = (it >> 1) & 3, g = it >> 3, row0 = g * 64;
        const int tp = tid_fresh();
        const int i = tp >> 3, c8 = tp & 7;
        const size_t go = (size_t)(row0 + i) * 256 + h * 64 + c8 * 8;
        pq = *(const u32x4*)((ty ? a.MQ : a.RQ) + go);
        pkk = *(const u32x4*)((ty ? a.MK : a.RK) + go);
        const int dv = tp & 127, vg = tp >> 7;
        const bf16_t* src = a.z + (size_t)(row0 + vg * 16) * AB_IN + (ty ? 2048 : 512) + h * 128 + dv;
#pragma unroll
        for (int x = 0; x < 16; ++x) pv[x] = src[(size_t)x * AB_IN];
        if (ty == 1 && tp < 128) {
            const int w2 = tp >> 6, l2 = tp & 63;
            pli = a.LIF[(size_t)(row0 + l2) * 16 + w2 * 4 + h]; plf = a.LIF[(size_t)(row0 + l2) * 16 + 8 + w2 * 4 + h];
            pmi = a.MI[(size_t)(w2 * 4 + h) * NCHUNK + g];
        }
    };
    if ((int)blockIdx.x < NCHUNK * 8) prefetch(blockIdx.x);
    for (int it = blockIdx.x; it < NCHUNK * 8; it += gridDim.x) {
        const int ty = it & 1, h = (it >> 1) & 3, g = it >> 3, row0 = g * 64;
        __syncthreads();
        {
            const int ts = tid_fresh();
            const int i = ts >> 3, c8 = ts & 7;
            *(u32x4*)(Qs + i * LP + c8 * 8) = pq;
            *(u32x4*)(Ks + i * LP + c8 * 8) = pkk;
            const int dv = ts & 127, vg = ts >> 7;
            u32x4 o0, o1;
            o0.x = (unsigned)pv[0] | ((unsigned)pv[1] << 16); o0.y = (unsigned)pv[2] | ((unsigned)pv[3] << 16); o0.z = (unsigned)pv[4] | ((unsigned)pv[5] << 16); o0.w = (unsigned)pv[6] | ((unsigned)pv[7] << 16);
            o1.x = (unsigned)pv[8] | ((unsigned)pv[9] << 16); o1.y = (unsigned)pv[10] | ((unsigned)pv[11] << 16); o1.z = (unsigned)pv[12] | ((unsigned)pv[13] << 16); o1.w = (unsigned)pv[14] | ((unsigned)pv[15] << 16);
            *(u32x4*)(VT + dv * LP + vg * 16) = o0;
            *(u32x4*)(VT + dv * LP + vg * 16 + 8) = o1;
            if (ts < 2 * 16 * 8) {
                const int dir = ts >> 7, rr = (ts >> 3) & 15, c = ts & 7;
                u32x4 o = {0u, 0u, 0u, 0u};
                if (ty == 1 && rr == 0) {
                    const float* np = (const float*)(a.ST + rec_off(1, dir, h, g) + 8192) + c * 8;
                    o.x = cvt_pk_bf16(np[0], np[1]); o.y = cvt_pk_bf16(np[2], np[3]); o.z = cvt_pk_bf16(np[4], np[5]); o.w = cvt_pk_bf16(np[6], np[7]);
                }
                *(u32x4*)((dir ? SB : SF) + (128 + rr) * LP + c * 8) = o;
            }
            if (ty == 1 && wid < 2) {
                const int dir = wid;
                const float bc = dir ? wave_incl_suffix(plf, lane) : wave_incl_prefix(plf, lane);
                const float aj = pli - bc;
                const float pm = dir ? wave_suffix_max(aj, lane) : wave_prefix_max(aj, lane);
                const float M = fmaxf(pmi, pm);
                float* fv = FV + dir * 256;
                fv[lane] = M; fv[64 + lane] = aj; fv[128 + lane] = fexp_(pmi - M); fv[192 + lane] = fexp_(-(bc + M));
            }
        }
        u32x4 ps[2][2];
        {
            const int tq = tid_fresh();
            const int sdv = tq >> 2, sd = (tq & 3) * 16;
#pragma unroll
            for (int dir = 0; dir < 2; ++dir) {
                const bf16_t* sp = a.ST + rec_off(ty, dir, h, g) + (size_t)sdv * 64 + sd;
                ps[dir][0] = *(const u32x4*)sp; ps[dir][1] = *(const u32x4*)(sp + 8);
            }
        }
        __syncthreads();
        const float l2f = (ty == 0) ? log2f(1.0f - expf(a.ret_decay[h])) : 0.f;
        const float l2b = (ty == 0) ? log2f(1.0f - expf(a.ret_decay[4 + h])) : 0.f;
        f32x4 otot[4];
#pragma unroll
        for (int x = 0; x < 4; ++x) otot[x] = (f32x4){0.f, 0.f, 0.f, 0.f};
        const int ndir = (ty == 0) ? 1 : 2;
        for (int pass = 0; pass < ndir; ++pass) {
            {
                const int itl = wid >> 1;
                const bf16x8 q0 = lds_frag(Qs, itl * 16 + fr, fq * 8), q1 = lds_frag(Qs, itl * 16 + fr, 32 + fq * 8);
                float rs = 0.f;
                const int i = itl * 16 + fr;
#pragma unroll
                for (int jj = 0; jj < 2; ++jj) {
                    const int jt = (wid & 1) * 2 + jj;
                    f32x4 acc = {0.f, 0.f, 0.f, 0.f};
                    acc = __builtin_amdgcn_mfma_f32_16x16x32_bf16(lds_frag(Ks, jt * 16 + fr, fq * 8), q0, acc, 0, 0, 0);
                    acc = __builtin_amdgcn_mfma_f32_16x16x32_bf16(lds_frag(Ks, jt * 16 + fr, 32 + fq * 8), q1, acc, 0, 0, 0);
                    float sv[4];
#pragma unroll
                    for (int r = 0; r < 4; ++r) {
                        const int j = jt * 16 + fq * 4 + r;
                        float dcy;
                        if (ty == 0) {
                            dcy = ((j <= i) ? exp2f((float)(i - j) * l2f) : 0.f) + ((j >= i) ? exp2f((float)(j - i) * l2b) : 0.f);
                        } else {
                            const float* fv = FV + pass * 256;
                            const bool ok = pass ? (j >= i) : (j <= i);
                            dcy = ok ? fexp_(fv[64 + j] - fv[i]) : 0.f;
                        }
                        sv[r] = acc[r] * dcy;
                        rs += sv[r];
                    }
                    u32x2 w; w.x = cvt_pk_bf16(sv[0], sv[1]); w.y = cvt_pk_bf16(sv[2], sv[3]);
                    *(u32x2*)(ATT + i * LP + jt * 16 + fq * 4) = w;
                }
                if (ty == 1) {
                    rs += __shfl_xor(rs, 16); rs += __shfl_xor(rs, 32);
                    if (fq == 0) FV[512 + (pass * 2 + (wid & 1)) * 64 + i] = rs;
                }
            }
            if (pass == 0) {
                const int tq = tid_fresh();
                const int sdv = tq >> 2, sd = (tq & 3) * 16;
#pragma unroll
                for (int dir = 0; dir < 2; ++dir) {
                    bf16_t* dst = (dir ? SB : SF) + sdv * LP + sd;
                    *(u32x4*)dst = ps[dir][0]; *(u32x4*)(dst + 8) = ps[dir][1];
                }
                if (it + (int)gridDim.x < NCHUNK * 8) prefetch(it + gridDim.x);
            }
            __syncthreads();
            {
                const bf16x8 v0 = lds_frag(VT, wid * 16 + fr, fq * 8), v1 = lds_frag(VT, wid * 16 + fr, 32 + fq * 8);
                const bf16_t* S1 = (ty == 0) ? SF : (pass ? SB : SF);
                const bf16x8 sf0 = lds_frag(S1, wid * 16 + fr, fq * 8), sf1 = lds_frag(S1, wid * 16 + fr, 32 + fq * 8);
                bf16x8 sb0 = sf0, sb1 = sf1;
                if (ty == 0) { sb0 = lds_frag(SB, wid * 16 + fr, fq * 8); sb1 = lds_frag(SB, wid * 16 + fr, 32 + fq * 8); }
                if (ty == 1 && wid == 0) {
                    const bf16x8 n0 = lds_frag(S1, 128 + fr, fq * 8), n1 = lds_frag(S1, 128 + fr, 32 + fq * 8);
#pragma unroll
                    for (int tt = 0; tt < 4; ++tt) {
                        f32x4 an = {0.f, 0.f, 0.f, 0.f};
                        an = __builtin_amdgcn_mfma_f32_16x16x32_bf16(n0, lds_frag(Qs, tt * 16 + fr, fq * 8), an, 0, 0, 0);
                        an = __builtin_amdgcn_mfma_f32_16x16x32_bf16(n1, lds_frag(Qs, tt * 16 + fr, 32 + fq * 8), an, 0, 0, 0);
                        if (fq == 0) FV[768 + pass * 64 + tt * 16 + fr] = an[0];
                    }
                }
                if (ty == 1) __syncthreads();
#pragma unroll
                for (int tt = 0; tt < 4; ++tt) {
                    const bf16x8 a0 = lds_frag(ATT, tt * 16 + fr, fq * 8), a1 = lds_frag(ATT, tt * 16 + fr, 32 + fq * 8);
                    const bf16x8 qq0 = lds_frag(Qs, tt * 16 + fr, fq * 8), qq1 = lds_frag(Qs, tt * 16 + fr, 32 + fq * 8);
                    f32x4 ao = {0.f, 0.f, 0.f, 0.f}, af = {0.f, 0.f, 0.f, 0.f}, ab = {0.f, 0.f, 0.f, 0.f};
                    ao = __builtin_amdgcn_mfma_f32_16x16x32_bf16(v0, a0, ao, 0, 0, 0);
                    ao = __builtin_amdgcn_mfma_f32_16x16x32_bf16(v1, a1, ao, 0, 0, 0);
                    af = __builtin_amdgcn_mfma_f32_16x16x32_bf16(sf0, qq0, af, 0, 0, 0);
                    af = __builtin_amdgcn_mfma_f32_16x16x32_bf16(sf1, qq1, af, 0, 0, 0);
                    const int i = tt * 16 + fr;
                    if (ty == 0) {
                        ab = __builtin_amdgcn_mfma_f32_16x16x32_bf16(sb0, qq0, ab, 0, 0, 0);
                        ab = __builtin_amdgcn_mfma_f32_16x16x32_bf16(sb1, qq1, ab, 0, 0, 0);
                        const float wf = exp2f((float)(i + 1) * l2f), wb = exp2f((float)(64 - i) * l2b);
                        otot[tt] += ao + af * wf + ab * wb;
                    } else {
                        const float* fv = FV + pass * 256;
                        const float wint = fv[128 + i], eden = fv[192 + i];
                        const float den = wint * FV[768 + pass * 64 + i] + FV[512 + (pass * 2) * 64 + i] + FV[512 + (pass * 2 + 1) * 64 + i];
                        const float inv = frcp_(fmaxf(fabsf(den), eden));
                        otot[tt] += (ao + af * wint) * inv;
                    }
                }
            }
            if (ty == 1) __syncthreads();
        }
        {
            float* ssw = FV + 896;
#pragma unroll
            for (int tt = 0; tt < 4; ++tt) {
                float ss = otot[tt][0] * otot[tt][0] + otot[tt][1] * otot[tt][1] + otot[tt][2] * otot[tt][2] + otot[tt][3] * otot[tt][3];
                ss += __shfl_xor(ss, 16); ss += __shfl_xor(ss, 32);
                if (fq == 0) ssw[wid * 64 + tt * 16 + fr] = ss;
            }
            __syncthreads();
            const float* nw = (ty ? a.ml_norm : a.ret_norm) + h * 128 + wid * 16 + fq * 4;
            const f32x4 nv = *(const f32x4*)nw;
#pragma unroll
            for (int tt = 0; tt < 4; ++tt) {
                const int i = tt * 16 + fr;
                float tot = 0.f;
#pragma unroll
                for (int w = 0; w < 8; ++w) tot += ssw[w * 64 + i];
                const float rsn = rsqrtf(tot * (1.0f / 128.0f) + EPSF);
                const f32x4 gz = ldz4(a.z + (size_t)(row0 + i) * AB_IN + (ty ? 2560 : 1024) + h * 128 + wid * 16 + fq * 4);
                float o[4];
#pragma unroll
                for (int r = 0; r < 4; ++r) {
                    const float gate = ty ? fsigmoid_(gz[r]) : gz[r] * fsigmoid_(gz[r]);
                    o[r] = otot[tt][r] * rsn * nv[r] * gate;
                }
                st_bf16x4(a.MG + (size_t)(row0 + i) * DM + ty * 512 + h * 128 + wid * 16 + fq * 4, o[0], o[1], o[2], o[3]);
            }
        }
    }
}


#define LP2 136
#define HREC 16384
struct L1Args {
    const bf16_t* z;
    const float* hgrn_lb; const float* hg_norm;
    bf16_t* HST;
    float* HDEC;
    bf16_t* MG;
    const float* shift; const float* w0; const float* w2; const float* a0; const float* a2; const float* g2;
    const float* kk_scale; const float* k_a; const float* r_k; const float* rw_norm;
    bf16_t* PKK; bf16_t* PV;
    float* PG;
    float* PW;
    bf16_t* PAB; bf16_t* PKE; bf16_t* PWR;
    float* PSC;
    float* PBON;
    float* RWO;
    bf16_t* WLR;
};
__device__ __forceinline__ size_t hrec_off(int dir, int h, int g) { return ((size_t)((dir * 4 + h) * NCHUNK + g)) * HREC; }
__device__ __forceinline__ bf16x8 lds_frag2(const bf16_t* base, int row, int kofs) { return *(const bf16x8*)(base + row * LP2 + kofs); }

__device__ __forceinline__ void ph_l1_local(const L1Args& a, int bi, int nb) {
    bf16_t* KD = (bf16_t*)g_shm;
    bf16_t* VT = KD + 2 * 128 * LP;
    bf16_t* RAW = VT + 128 * LP;
    const int tid = tid_fresh(), wid = tid >> 6, lane = tid & 63, fr = lane & 15, fq = lane >> 4;
    u32x4 praw[4]; bf16_t pv[16];
    auto prefetch = [&](int it) {
        const int g = it >> 2, h = it & 3, row0 = g * 64;
        const int tp = tid_fresh();
#pragma unroll
        for (int c = 0; c < 4; ++c) {
            const int idx = tp + NTHR * c, dir = idx >> 10, j = (idx >> 4) & 63, c8 = idx & 15;
            praw[c] = *(const u32x4*)(a.z + (size_t)(row0 + j) * CD_IN + 512 + dir * 512 + h * 128 + c8 * 8);
        }
        const int dv = tp & 127, vg = tp >> 7;
        const bf16_t* src = a.z + (size_t)(row0 + vg * 16) * CD_IN + 1536 + h * 128 + dv;
#pragma unroll
        for (int x = 0; x < 16; ++x) pv[x] = src[(size_t)x * CD_IN];
    };
    if (bi < NCHUNK * 4) prefetch(bi);
    for (int it = bi; it < NCHUNK * 4; it += nb) {
        const int g = it >> 2, h = it & 3;
        __syncthreads();
        {
            const int ts = tid_fresh();
#pragma unroll
            for (int c = 0; c < 4; ++c) {
                const int idx = ts + NTHR * c, dir = idx >> 10, j = (idx >> 4) & 63, c8 = idx & 15;
                *(u32x4*)(RAW + (dir * 64 + j) * 128 + c8 * 8) = praw[c];
            }
            const int dv = ts & 127, vg = ts >> 7;
            u32x4 o0, o1;
            o0.x = (unsigned)pv[0] | ((unsigned)pv[1] << 16); o0.y = (unsigned)pv[2] | ((unsigned)pv[3] << 16); o0.z = (unsigned)pv[4] | ((unsigned)pv[5] << 16); o0.w = (unsigned)pv[6] | ((unsigned)pv[7] << 16);
            o1.x = (unsigned)pv[8] | ((unsigned)pv[9] << 16); o1.y = (unsigned)pv[10] | ((unsigned)pv[11] << 16); o1.z = (unsigned)pv[12] | ((unsigned)pv[13] << 16); o1.w = (unsigned)pv[14] | ((unsigned)pv[15] << 16);
            *(u32x4*)(VT + dv * LP + vg * 16) = o0;
            *(u32x4*)(VT + dv * LP + vg * 16 + 8) = o1;
        }
        if (it + nb < NCHUNK * 4) prefetch(it + nb);
        __syncthreads();
        if (tid < 256) {
            const int dir = tid >> 7, d = tid & 127;
            const float p0 = a.hgrn_lb[h * 128 + d], p1 = a.hgrn_lb[512 + h * 128 + d];
            const float lb = 1.0f / (1.0f + expf(p0 - p1));
            const bf16_t* raw = RAW + dir * 64 * 128 + d;
            float E = 0.f;
            bf16_t* kd = KD + (dir * 128 + (((d >> 2) & 7) * 16 + (d >> 5) * 4 + (d & 3))) * LP;
#pragma unroll 8
            for (int s2 = 0; s2 < 64; ++s2) {
                const int j = dir ? s2 : 63 - s2;
                const float f = lb + (1.0f - lb) * fsigmoid_(bf16_to_f32(raw[j * 128]));
                kd[j] = f2bf((1.0f - f) * fexp_(E));
                E += flog_(f);
            }
            a.HDEC[((size_t)(dir * 4 + h) * NCHUNK + g) * 128 + d] = expf(E);
        }
        __syncthreads();
        const bf16x8 v0 = lds_frag(VT, wid * 16 + fr, fq * 8), v1 = lds_frag(VT, wid * 16 + fr, 32 + fq * 8);
#pragma unroll
        for (int dir = 0; dir < 2; ++dir) {
            bf16_t* st = a.HST + hrec_off(dir, h, g) + (size_t)(wid * 16 + fr) * 128 + fq * 32;
#pragma unroll
            for (int dp = 0; dp < 4; ++dp) {
                f32x4 acc0 = {0.f, 0.f, 0.f, 0.f}, acc1 = {0.f, 0.f, 0.f, 0.f};
                acc0 = __builtin_amdgcn_mfma_f32_16x16x32_bf16(lds_frag(KD + dir * 128 * LP, (2 * dp) * 16 + fr, fq * 8), v0, acc0, 0, 0, 0);
                acc0 = __builtin_amdgcn_mfma_f32_16x16x32_bf16(lds_frag(KD + dir * 128 * LP, (2 * dp) * 16 + fr, 32 + fq * 8), v1, acc0, 0, 0, 0);
                acc1 = __builtin_amdgcn_mfma_f32_16x16x32_bf16(lds_frag(KD + dir * 128 * LP, (2 * dp + 1) * 16 + fr, fq * 8), v0, acc1, 0, 0, 0);
                acc1 = __builtin_amdgcn_mfma_f32_16x16x32_bf16(lds_frag(KD + dir * 128 * LP, (2 * dp + 1) * 16 + fr, 32 + fq * 8), v1, acc1, 0, 0, 0);
                st_bf16x8(st + dp * 8, acc0[0], acc0[1], acc0[2], acc0[3], acc1[0], acc1[1], acc1[2], acc1[3]);
            }
        }
    }
}
__device__ __forceinline__ void ph_l1_prop(const L1Args& a, int bi, int nb) {
    for (int idx = bi * NTHR + tid_fresh(); idx < 32 * (HREC / 4); idx += nb * NTHR) {
        const int seq = idx / (HREC / 4), e4 = idx % (HREC / 4);
        const int dir = seq >> 4, h = (seq >> 2) & 3, b = seq & 3;
        const int d4 = (e4 & 31) * 4;
        f32x4 S = {0.f, 0.f, 0.f, 0.f};
        for (int s0 = 0; s0 < 132; s0 += 12) {
            f32x4 loc[12], dec[12];
#pragma unroll
            for (int i = 0; i < 12; ++i) {
                const int g = chunk_g(b, dir, s0 + i);
                loc[i] = ldz4(a.HST + hrec_off(dir, h, g) + (size_t)e4 * 4);
                dec[i] = *(const f32x4*)(a.HDEC + ((size_t)(dir * 4 + h) * NCHUNK + g) * 128 + d4);
            }
#pragma unroll
            for (int i = 0; i < 12; ++i) {
                const int g = chunk_g(b, dir, s0 + i);
                st_bf16x4(a.HST + hrec_off(dir, h, g) + (size_t)e4 * 4, S[0], S[1], S[2], S[3]);
                S = S * dec[i] + loc[i];
            }
        }
    }
}
__device__ __forceinline__ void ph_l1_out(const L1Args& a, int bi, int nb) {
    bf16_t* QA = (bf16_t*)g_shm;
    bf16_t* R2 = QA + 2 * 64 * LP2;
    bf16_t* ATT = R2 + 2 * 128 * LP2;
    bf16_t* VT = ATT + 64 * LP;
    float* ssw = (float*)(VT + 128 * LP);
    bf16_t* RAWF = R2 + 128 * LP2;
    bf16_t* RAWQ = ATT;
    const int tid = tid_fresh(), wid = tid >> 6, lane = tid & 63, fr = lane & 15, fq = lane >> 4;
    u32x4 praw[6]; bf16_t pv[16];
    auto prefetch = [&](int it) {
        const int g = it >> 2, h = it & 3, row0 = g * 64;
        const int tp = tid_fresh();
#pragma unroll
        for (int c = 0; c < 6; ++c) {
            const int idx = tp + NTHR * c, arr = idx >> 10, j = (idx >> 4) & 63, c8 = idx & 15;
            praw[c] = *(const u32x4*)(a.z + (size_t)(row0 + j) * CD_IN + (arr < 2 ? 512 + arr * 512 : 0) + h * 128 + c8 * 8);
        }
        const int dv = tp & 127, vg = tp >> 7;
        const bf16_t* src = a.z + (size_t)(row0 + vg * 16) * CD_IN + 1536 + h * 128 + dv;
#pragma unroll
        for (int x = 0; x < 16; ++x) pv[x] = src[(size_t)x * CD_IN];
    };
    if (bi < NCHUNK * 4) prefetch(bi);
    for (int it = bi; it < NCHUNK * 4; it += nb) {
        const int g = it >> 2, h = it & 3, row0 = g * 64;
        __syncthreads();
        {
            const int ts = tid_fresh();
#pragma unroll
            for (int c = 0; c < 6; ++c) {
                const int idx = ts + NTHR * c, arr = idx >> 10, j = (idx >> 4) & 63, c8 = idx & 15;
                bf16_t* dst = (arr < 2 ? RAWF + (arr * 64 + j) * 128 : RAWQ + j * 128) + c8 * 8;
                *(u32x4*)dst = praw[c];
            }
        }
        u32x4 ps[2][4];
        {
            const int tq = tid_fresh();
#pragma unroll
            for (int dir = 0; dir < 2; ++dir) {
                const bf16_t* sp = a.HST + hrec_off(dir, h, g);
#pragma unroll
                for (int c = 0; c < 4; ++c) { const int e = (c * NTHR + tq) * 8; ps[dir][c] = *(const u32x4*)(sp + e); }
            }
        }
        __syncthreads();
        if (tid < 256) {
            const int dir = tid >> 7, d = tid & 127;
            const float p0 = a.hgrn_lb[h * 128 + d], p1 = a.hgrn_lb[512 + h * 128 + d];
            const float lb = 1.0f / (1.0f + expf(p0 - p1));
            const bf16_t* rf = RAWF + dir * 64 * 128 + d;
            const bf16_t* rq = RAWQ + d;
            float B = 0.f;
#pragma unroll 8
            for (int s2 = 0; s2 < 64; ++s2) {
                const int j = dir ? 63 - s2 : s2;
                const float f = lb + (1.0f - lb) * fsigmoid_(bf16_to_f32(rf[j * 128]));
                B += flog_(f);
                QA[(dir * 64 + j) * LP2 + d] = f2bf(bf16_to_f32(rq[j * 128]) * fexp_(B));
                R2[(dir * 64 + j) * LP2 + d] = f2bf((1.0f - f) * fexp_(fminf(-B, 80.0f)));
            }
        }
        __syncthreads();
        {
            const int ts = tid_fresh();
            const int dv = ts & 127, vg = ts >> 7;
            u32x4 o0, o1;
            o0.x = (unsigned)pv[0] | ((unsigned)pv[1] << 16); o0.y = (unsigned)pv[2] | ((unsigned)pv[3] << 16); o0.z = (unsigned)pv[4] | ((unsigned)pv[5] << 16); o0.w = (unsigned)pv[6] | ((unsigned)pv[7] << 16);
            o1.x = (unsigned)pv[8] | ((unsigned)pv[9] << 16); o1.y = (unsigned)pv[10] | ((unsigned)pv[11] << 16); o1.z = (unsigned)pv[12] | ((unsigned)pv[13] << 16); o1.w = (unsigned)pv[14] | ((unsigned)pv[15] << 16);
            *(u32x4*)(VT + dv * LP + vg * 16) = o0;
            *(u32x4*)(VT + dv * LP + vg * 16 + 8) = o1;
        }
        {
            const int itl = wid >> 1, i = itl * 16 + fr;
#pragma unroll
            for (int jj = 0; jj < 2; ++jj) {
                const int jt = (wid & 1) * 2 + jj;
                f32x4 af = {0.f, 0.f, 0.f, 0.f}, ab = {0.f, 0.f, 0.f, 0.f};
#pragma unroll
                for (int ks = 0; ks < 4; ++ks) {
                    af = __builtin_amdgcn_mfma_f32_16x16x32_bf16(lds_frag2(R2, jt * 16 + fr, ks * 32 + fq * 8), lds_frag2(QA, itl * 16 + fr, ks * 32 + fq * 8), af, 0, 0, 0);
                    ab = __builtin_amdgcn_mfma_f32_16x16x32_bf16(lds_frag2(R2 + 64 * LP2, jt * 16 + fr, ks * 32 + fq * 8), lds_frag2(QA + 64 * LP2, itl * 16 + fr, ks * 32 + fq * 8), ab, 0, 0, 0);
                }
                float sv[4];
#pragma unroll
                for (int r = 0; r < 4; ++r) {
                    const int j = jt * 16 + fq * 4 + r;
                    sv[r] = ((j <= i) ? af[r] : 0.f) + ((j >= i) ? ab[r] : 0.f);
                }
                u32x2 w; w.x = cvt_pk_bf16(sv[0], sv[1]); w.y = cvt_pk_bf16(sv[2], sv[3]);
                *(u32x2*)(ATT + i * LP + jt * 16 + fq * 4) = w;
            }
        }
        __syncthreads();
        {
            const int tq = tid_fresh();
#pragma unroll
            for (int dir = 0; dir < 2; ++dir) {
#pragma unroll
                for (int c = 0; c < 4; ++c) {
                    const int e = (c * NTHR + tq) * 8;
                    const int dv = e >> 7, d = e & 127;
                    *(u32x4*)(R2 + (dir * 128 + dv) * LP2 + d) = ps[dir][c];
                }
            }
            if (it + nb < NCHUNK * 4) prefetch(it + nb);
        }
        __syncthreads();
        f32x4 o4[4];
        {
            const bf16x8 v0 = lds_frag(VT, wid * 16 + fr, fq * 8), v1 = lds_frag(VT, wid * 16 + fr, 32 + fq * 8);
#pragma unroll
            for (int tt = 0; tt < 4; ++tt) {
                f32x4 acc = {0.f, 0.f, 0.f, 0.f};
                acc = __builtin_amdgcn_mfma_f32_16x16x32_bf16(v0, lds_frag(ATT, tt * 16 + fr, fq * 8), acc, 0, 0, 0);
                acc = __builtin_amdgcn_mfma_f32_16x16x32_bf16(v1, lds_frag(ATT, tt * 16 + fr, 32 + fq * 8), acc, 0, 0, 0);
#pragma unroll
                for (int dir = 0; dir < 2; ++dir)
#pragma unroll
                    for (int ks = 0; ks < 4; ++ks)
                        acc = __builtin_amdgcn_mfma_f32_16x16x32_bf16(lds_frag2(R2 + dir * 128 * LP2, wid * 16 + fr, ks * 32 + fq * 8),
                                                                      lds_frag2(QA + dir * 64 * LP2, tt * 16 + fr, ks * 32 + fq * 8), acc, 0, 0, 0);
                o4[tt] = acc;
            }
        }
#pragma unroll
        for (int tt = 0; tt < 4; ++tt) {
            float ss = o4[tt][0] * o4[tt][0] + o4[tt][1] * o4[tt][1] + o4[tt][2] * o4[tt][2] + o4[tt][3] * o4[tt][3];
            ss += __shfl_xor(ss, 16); ss += __shfl_xor(ss, 32);
            if (fq == 0) ssw[wid * 64 + tt * 16 + fr] = ss;
        }
        __syncthreads();
        const f32x4 nv = *(const f32x4*)(a.hg_norm + h * 128 + wid * 16 + fq * 4);
#pragma unroll
        for (int tt = 0; tt < 4; ++tt) {
            const int i = tt * 16 + fr;
            float tot = 0.f;
#pragma unroll
            for (int w = 0; w < 8; ++w) tot += ssw[w * 64 + i];
            const float rsn = rsqrtf(tot * (1.0f / 128.0f) + EPSF);
            const f32x4 gz = ldz4(a.z + (size_t)(row0 + i) * CD_IN + 2048 + h * 128 + wid * 16 + fq * 4);
            st_bf16x4(a.MG + (size_t)(row0 + i) * DM + h * 128 + wid * 16 + fq * 4,
                      o4[tt][0] * rsn * nv[0] * fsigmoid_(gz[0]), o4[tt][1] * rsn * nv[1] * fsigmoid_(gz[1]),
                      o4[tt][2] * rsn * nv[2] * fsigmoid_(gz[2]), o4[tt][3] * rsn * nv[3] * fsigmoid_(gz[3]));
        }
    }
}

__device__ __forceinline__ void ph_l1_wlr(const L1Args& a) {
    const int gt = blockIdx.x * NTHR + tid_fresh(), gs = gridDim.x * NTHR;
    for (int i = gt; i < 4 * 32768 + 65536; i += gs) {
        float v;
        if (i < 4 * 32768) { const int m = i >> 15, e = i & 32767, n = e >> 6, k = e & 63; v = (m < 2 ? a.w2 : a.a2)[((size_t)(m & 1) * 64 + k) * 512 + n]; }
        else { const int e = i - 4 * 32768, n = e >> 7, k = e & 127; v = a.g2[(size_t)k * 512 + n]; }
        a.WLR[i] = f2bf(v);
    }
}
#define FP 392
__device__ __forceinline__ void ph_l1_rwprep(const L1Args& a) {
    bf16_t* F = (bf16_t*)g_shm;
    float* SH = (float*)(F + 32 * FP);
    float* PT = SH + 3 * 1920;
    const int tid = tid_fresh(), wid = tid >> 6, lane = tid & 63, fr = lane & 15, fq = lane >> 4;
    const int tt = wid & 1, hg = wid >> 1;
    __syncthreads();
    for (int i = tid; i < 3 * 1920; i += NTHR) SH[i] = a.shift[i];
    for (int i = tid; i < 512; i += NTHR) { PT[i] = a.kk_scale[i]; PT[512 + i] = a.k_a[i]; PT[1024 + i] = a.r_k[i]; }
    for (int i = tid; i < 1024; i += NTHR) { PT[1536 + i] = a.w0[i]; PT[2560 + i] = a.a0[i]; }
    constexpr int NIT = NTOK / 32;
    const int G = gridDim.x, nfull = (NIT / G) * G, rem = NIT - nfull;
    const bool split = 2 * rem <= G;
    const int nmine = (int)blockIdx.x < nfull ? (nfull / G) : 0;
    const int extra = split ? ((int)blockIdx.x < 2 * rem ? 1 : 0) : ((int)blockIdx.x < rem ? 1 : 0);
    for (int q = 0; q < nmine + extra; ++q) {
        const bool tail = q >= nmine;
        const int it = !tail ? (int)blockIdx.x + q * G : nfull + (split ? ((int)blockIdx.x >> 1) : (int)blockIdx.x);
        const int i0 = (tail && split) ? ((int)blockIdx.x & 1) * 4 : 0, i1 = (tail && split) ? i0 + 4 : 8;
        const int row0 = it * 32;
        __syncthreads();
#pragma unroll 1
        for (int jb = 0; jb < 2; ++jb) {
            u32x2 zz[3][3];
#pragma unroll
            for (int j = 0; j < 3; ++j) {
                const int idx = tid + NTHR * (jb * 3 + j), tk = idx / 96, cg = idx - tk * 96;
                const int r = row0 + tk;
                const RowInfo ri = row_info(r);
                const bf16_t* zp = a.z + (size_t)r * CD_IN + 2560 + 1536 + cg * 4;
                zz[j][0] = *(const u32x2*)(zp - (ri.t > 0 ? CD_IN : 0));
                zz[j][1] = *(const u32x2*)zp;
                zz[j][2] = *(const u32x2*)(zp + (ri.t < ri.len - 1 ? CD_IN : 0));
            }
#pragma unroll
            for (int j = 0; j < 3; ++j) {
                const int idx = tid + NTHR * (jb * 3 + j), tk = idx / 96, cg = idx - tk * 96;
                const RowInfo ri = row_info(row0 + tk);
                const float mp = ri.t > 0 ? 1.0f : 0.0f, mn = ri.t < ri.len - 1 ? 1.0f : 0.0f;
                const int ch = 1536 + cg * 4;
                float o[4];
#pragma unroll
                for (int x = 0; x < 4; ++x) {
                    const unsigned wp_ = x < 2 ? zz[j][0].x : zz[j][0].y, wc_ = x < 2 ? zz[j][1].x : zz[j][1].y, wn_ = x < 2 ? zz[j][2].x : zz[j][2].y;
                    const float pv_ = __uint_as_float((x & 1) ? (wp_ & 0xffff0000u) : (wp_ << 16)), cv_ = __uint_as_float((x & 1) ? (wc_ & 0xffff0000u) : (wc_ << 16)),
                                nv_ = __uint_as_float((x & 1) ? (wn_ & 0xffff0000u) : (wn_ << 16));
                    const float cv = SH[ch + x] * pv_ * mp + SH[1920 + ch + x] * cv_ + SH[3840 + ch + x] * nv_ * mn;
                    const float sg = frcp_(1.0f + __expf(cg < 32 ? -2.0f * cv : -cv));
                    o[x] = (cg < 32) ? (2.0f * sg - 1.0f) : ((cg < 64) ? cv : sg);
                }
                st_bf16x4(F + tk * FP + cg * 4, o[0], o[1], o[2], o[3]);
            }
        }
        __syncthreads();
        const int r = row0 + tt * 16 + fr;
        const RowInfo ri = row_info(r);
        const float mp = ri.t > 0 ? 1.0f : 0.0f, mn = ri.t < ri.len - 1 ? 1.0f : 0.0f;
        const bf16_t* zc = a.z + (size_t)r * CD_IN + 2560;
        const bf16_t* zpv = zc - (ri.t > 0 ? CD_IN : 0);
        const bf16_t* znx = zc + (ri.t < ri.len - 1 ? CD_IN : 0);
        const bf16_t* fbp = F + (tt * 16 + fr) * FP + fq * 8;
        auto conv_from = [&](const u32x2 (&zr)[3], int ch) -> f32x4 {
            f32x4 o;
#pragma unroll
            for (int x = 0; x < 4; ++x) {
                const unsigned wp_ = x < 2 ? zr[0].x : zr[0].y, wc_ = x < 2 ? zr[1].x : zr[1].y, wn_ = x < 2 ? zr[2].x : zr[2].y;
                const float pv_ = __uint_as_float((x & 1) ? (wp_ & 0xffff0000u) : (wp_ << 16)), cv_ = __uint_as_float((x & 1) ? (wc_ & 0xffff0000u) : (wc_ << 16)),
                            nv_ = __uint_as_float((x & 1) ? (wn_ & 0xffff0000u) : (wn_ << 16));
                o[x] = SH[ch + x] * pv_ * mp + SH[1920 + ch + x] * cv_ + SH[3840 + ch + x] * nv_ * mn;
            }
            return o;
        };
        bf16x8 wa[12]; u32x2 zr[3][3];
        auto issue = [&](int idx) {
            const int h = hg + 4 * (idx >> 2), nt = idx & 3;
            const int n = h * 64 + (nt >> 1) * 32 + 8 * (fr >> 2) + 4 * (nt & 1) + (fr & 3), ch = h * 64 + (nt >> 1) * 32 + 8 * fq + 4 * (nt & 1);
#pragma unroll
            for (int m = 0; m < 4; ++m)
#pragma unroll
                for (int ks = 0; ks < 2; ++ks) wa[m * 2 + ks] = *(const bf16x8*)(a.WLR + (size_t)m * 32768 + n * 64 + ks * 32 + fq * 8);
#pragma unroll
            for (int ks = 0; ks < 4; ++ks) wa[8 + ks] = *(const bf16x8*)(a.WLR + 131072 + (size_t)n * 128 + ks * 32 + fq * 8);
#pragma unroll
            for (int arr = 0; arr < 3; ++arr) {
                zr[arr][0] = *(const u32x2*)(zpv + arr * 512 + ch); zr[arr][1] = *(const u32x2*)(zc + arr * 512 + ch); zr[arr][2] = *(const u32x2*)(znx + arr * 512 + ch);
            }
        };
        issue(i0);
        float rn = 0.f, br0 = 0.f, kr0 = 0.f, br1 = 0.f, kr1 = 0.f, bonus = 0.f;
        u32x2 sv_pv = {0u, 0u}, sv_kk = {0u, 0u}, sv_ab[2] = {{0u, 0u}, {0u, 0u}}, sv_ke[2] = {{0u, 0u}, {0u, 0u}}, sv_wr[2] = {{0u, 0u}, {0u, 0u}};
#pragma unroll 1
        for (int idx = i0; idx < i1; ++idx) {
            const int h = hg + 4 * (idx >> 2), nt = idx & 3;
            const bool odd = nt & 1;
            auto emit = [&](bf16_t* dst, u32x2& stash, float x0, float x1, float x2, float x3) {
                u32x2 w; w.x = cvt_pk_bf16(x0, x1); w.y = cvt_pk_bf16(x2, x3);
                if (odd) { u32x4 q; q.x = stash.x; q.y = stash.y; q.z = w.x; q.w = w.y; *(u32x4*)(dst - 4) = q; }
                else stash = w;
            };
            if (nt == 0) {
                u32x2 zk[4][3];
#pragma unroll
                for (int q = 0; q < 4; ++q) { const int ch = 512 + h * 64 + q * 16 + fq * 4; zk[q][0] = *(const u32x2*)(zpv + ch); zk[q][1] = *(const u32x2*)(zc + ch); zk[q][2] = *(const u32x2*)(znx + ch); }
                float ssk = 0.f;
#pragma unroll
                for (int q = 0; q < 4; ++q) {
                    const int chh = h * 64 + q * 16 + fq * 4;
                    const f32x4 kq4 = conv_from(zk[q], 512 + chh) * *(const f32x4*)(PT + chh);
                    ssk += kq4[0] * kq4[0] + kq4[1] * kq4[1] + kq4[2] * kq4[2] + kq4[3] * kq4[3];
                }
                ssk += __shfl_xor(ssk, 16); ssk += __shfl_xor(ssk, 32);
                rn = rsqrtf(ssk + EPSF);
                br0 = 0.f; kr0 = 0.f; br1 = 0.f; kr1 = 0.f; bonus = 0.f;
            }
            f32x4 acc[5];
#pragma unroll
            for (int m = 0; m < 5; ++m) acc[m] = (f32x4){0.f, 0.f, 0.f, 0.f};
#pragma unroll
            for (int m = 0; m < 4; ++m)
#pragma unroll
                for (int ks = 0; ks < 2; ++ks) acc[m] = __builtin_amdgcn_mfma_f32_16x16x32_bf16(wa[m * 2 + ks], *(const bf16x8*)(fbp + (m * 2 + ks) * 32), acc[m], 0, 0, 0);
#pragma unroll
            for (int ks = 0; ks < 4; ++ks) acc[4] = __builtin_amdgcn_mfma_f32_16x16x32_bf16(wa[8 + ks], *(const bf16x8*)(fbp + (8 + ks) * 32), acc[4], 0, 0, 0);
            const int ch = h * 64 + (nt >> 1) * 32 + 8 * fq + 4 * (nt & 1);
            const f32x4 rv = conv_from(zr[0], ch), kv = conv_from(zr[1], 512 + ch), vv = conv_from(zr[2], 1024 + ch);
            if (idx + 1 < i1) issue(idx + 1);
            const f32x4 kn = kv * *(const f32x4*)(PT + ch) * rn;
            const size_t o = (size_t)r * 512 + ch;
            emit(a.PV + o, sv_pv, vv[0], vv[1], vv[2], vv[3]);
            *(f32x4*)(a.PG + o) = acc[4];
            emit(a.PKK + o, sv_kk, kn[0], kn[1], kn[2], kn[3]);
            const f32x4 kav = *(const f32x4*)(PT + 512 + ch), rkv = *(const f32x4*)(PT + 1024 + ch);
#pragma unroll
            for (int d = 0; d < 2; ++d) {
                const size_t od = (size_t)d * NTOK * 512 + o;
                const f32x4 w0v = *(const f32x4*)(PT + 1536 + d * 512 + ch), a0v = *(const f32x4*)(PT + 2560 + d * 512 + ch);
                f32x4 wv; float ab[4], ke[4], wr[4];
                float brs = 0.f, krs = 0.f;
#pragma unroll
                for (int x = 0; x < 4; ++x) {
                    const float pw = acc[d][x] + w0v[x], pa = acc[2 + d][x] + a0v[x];
                    const float sp_ = fmaxf(-pw, 0.0f) + flog_(1.0f + fexp_(-fabsf(pw)));
                    const float w = fexp_(-fexp_(-sp_ - 0.5f));
                    const float av = fsigmoid_(pa);
                    wv[x] = w;
                    ke[x] = kv[x] * (1.0f + (av - 1.0f) * kav[x]);
                    ab[x] = kn[x] * av;
                    wr[x] = w * rv[x];
                    brs += ab[x] * rv[x]; krs += ke[x] * rv[x]; bonus += rv[x] * ke[x] * rkv[x];
                }
                if (d == 0) { br0 += brs; kr0 += krs; } else { br1 += brs; kr1 += krs; }
                *(f32x4*)(a.PW + od) = wv;
                emit(a.PAB + od, sv_ab[d], ab[0], ab[1], ab[2], ab[3]);
                emit(a.PKE + od, sv_ke[d], ke[0], ke[1], ke[2], ke[3]);
                emit(a.PWR + od, sv_wr[d], wr[0], wr[1], wr[2], wr[3]);
            }
            if (nt == 3) {
#pragma unroll
                for (int o2 = 16; o2 < 64; o2 <<= 1) { br0 += __shfl_xor(br0, o2); kr0 += __shfl_xor(kr0, o2); br1 += __shfl_xor(br1, o2); kr1 += __shfl_xor(kr1, o2); bonus += __shfl_xor(bonus, o2); }
                if (fq == 0) {
                    float* sc0 = a.PSC + ((size_t)r) * 16 + h * 2; sc0[0] = br0; sc0[1] = kr0;
                    float* sc1 = a.PSC + ((size_t)NTOK + r) * 16 + h * 2; sc1[0] = br1; sc1[1] = kr1;
                    a.PBON[(size_t)r * 8 + h] = bonus;
                }
            }
        }
    }
}

#define RW_NB 32
template <int CTRL> __device__ __forceinline__ float dppf(float v) { return __int_as_float(__builtin_amdgcn_update_dpp(0, __float_as_int(v), CTRL, 0xF, 0xF, true)); }
__device__ __forceinline__ int rw_row(int b, int dir, int s) {
    if (s < TC) return b * TC + (dir ? (TC - 1 - s) : s);
    const int s2 = s - TC; return NCTX + b * TL + (dir ? (TL - 1 - s2) : s2);
}
#define RW2_STR 400
__device__ __forceinline__ void ph_l1_rwkv2(const L1Args& a, int bi, int nblk) {
    float* OUT = (float*)g_shm;
    float* BUF = OUT + 2 * RW_NB * 32;
    const int tid = tid_fresh(), wid = tid >> 6, lane = tid & 63;
    constexpr int NBT = (TC + TL) / RW_NB;
    constexpr int NPC = 53;
    typedef float f32x2 __attribute__((ext_vector_type(2)));
    for (int u = bi; u < 128; u += nblk) {
        const int seq = u >> 1, half = u & 1;
        const int dir = seq & 1, h = (seq >> 1) & 7, b = seq >> 4;
        const size_t dof = (size_t)dir * NTOK * 512;
        const int lt = tid - 256, lw = lt >> 6, ll = lt & 63;
        const int sgn = dir ? -1 : 1;
        const char* gb0 = (const char*)a.PKK;
        const int p32 = lt & 31, qa = p32 >> 3, ca = p32 & 7, s0 = lt >> 5;
        const bf16_t* arrA = qa == 0 ? a.PKK : (qa == 1 ? a.PAB + dof : (qa == 2 ? a.PKE + dof : a.PWR + dof));
        const unsigned offA = (unsigned)(size_t)((const char*)(arrA + h * 64 + ca * 8) - gb0) + (unsigned)(sgn * s0) * 1024u;
        const int dA = s0 * RW2_STR + (qa == 0 ? 0 : 64 + qa * 64) + ca * 8;
        unsigned offX = 0u, offD = 0u; int dX = 0;
        if (lw < 2) { const int c = lt & 15, s1 = lt >> 4;
            offX = (unsigned)(size_t)((const char*)(a.PW + dof + h * 64 + c * 4) - gb0) + (unsigned)(sgn * s1) * 2048u; dX = s1 * RW2_STR + 64 + c * 4; }
        else if (lw == 2) { const int c = ll & 3, s3 = ll >> 2;
            offX = (unsigned)(size_t)((const char*)(a.PV + h * 64 + half * 32 + c * 8) - gb0) + (unsigned)(sgn * s3) * 1024u; dX = s3 * RW2_STR + 320 + c * 16;
            offD = (unsigned)(size_t)((const char*)(a.PSC + (size_t)dir * NTOK * 16 + h * 2) - gb0) + (unsigned)(sgn * ll) * 64u; }
        const unsigned offF = (unsigned)((dof + (size_t)h * 64 + half * 32 + (ll & 7) * 4) * 4) + (unsigned)(sgn * (ll >> 3)) * 2048u;
        u32x4 raw[8];
        auto issue = [&](int bt) {
            const unsigned rowb = (unsigned)rw_row(b, dir, bt * RW_NB);
            const unsigned oA = offA + rowb * 1024u, stA = (unsigned)(sgn * 8) * 1024u;
#pragma unroll
            for (int j = 0; j < 4; ++j) raw[j] = *(const u32x4*)(gb0 + (size_t)(oA + (unsigned)j * stA));
            if (lw < 2) {
                const unsigned oX = offX + rowb * 2048u, stX = (unsigned)(sgn * 8) * 2048u;
#pragma unroll
                for (int j = 0; j < 4; ++j) raw[4 + j] = *(const u32x4*)(gb0 + (size_t)(oX + (unsigned)j * stX));
            } else if (lw == 2) {
                const unsigned oX = offX + rowb * 1024u, stX = (unsigned)(sgn * 16) * 1024u;
#pragma unroll
                for (int j = 0; j < 2; ++j) raw[4 + j] = *(const u32x4*)(gb0 + (size_t)(oX + (unsigned)j * stX));
                if (ll < 32) { const u32x2 t2 = *(const u32x2*)(gb0 + (size_t)(offD + rowb * 64u)); raw[6].x = t2.x; raw[6].y = t2.y; }
            }
        };
        auto cvt8 = [&](const u32x4 w, f32x4& l4, f32x4& h4) {
            l4[0] = __uint_as_float(w.x << 16); l4[1] = __uint_as_float(w.x & 0xffff0000u); l4[2] = __uint_as_float(w.y << 16); l4[3] = __uint_as_float(w.y & 0xffff0000u);
            h4[0] = __uint_as_float(w.z << 16); h4[1] = __uint_as_float(w.z & 0xffff0000u); h4[2] = __uint_as_float(w.w << 16); h4[3] = __uint_as_float(w.w & 0xffff0000u);
        };
        auto commit = [&](int bt) {
            float* bb = BUF + (bt & 1) * RW_NB * RW2_STR;
#pragma unroll
            for (int j = 0; j < 4; ++j) {
                f32x4 l4, h4; cvt8(raw[j], l4, h4);
                float* d = bb + dA + 8 * j * RW2_STR;
                *(f32x4*)d = l4; *(f32x4*)(d + 4) = h4;
            }
            if (lw < 2) {
#pragma unroll
                for (int j = 0; j < 4; ++j) *(u32x4*)(bb + dX + 8 * j * RW2_STR) = raw[4 + j];
            } else if (lw == 2) {
#pragma unroll
                for (int j = 0; j < 2; ++j) {
                    f32x4 l4, h4; cvt8(raw[4 + j], l4, h4);
                    float* d = bb + dX + 16 * j * RW2_STR;
                    *(f32x4*)d = (f32x4){l4[0], l4[1], l4[1], l4[0]}; *(f32x4*)(d + 4) = (f32x4){l4[2], l4[3], l4[3], l4[2]};
                    *(f32x4*)(d + 8) = (f32x4){h4[0], h4[1], h4[1], h4[0]}; *(f32x4*)(d + 12) = (f32x4){h4[2], h4[3], h4[3], h4[2]};
                }
                if (ll < 32) { u32x2 t2; t2.x = raw[6].x; t2.y = raw[6].y; *(u32x2*)(bb + ll * RW2_STR + 384) = t2; }
            }
        };
        auto flush = [&](int bt) {
            if (lw == 3) {
                const unsigned rowb = (unsigned)rw_row(b, dir, bt * RW_NB);
                const unsigned oF = offF + rowb * 2048u, stF = (unsigned)(sgn * 8) * 2048u;
#pragma unroll
                for (int r = 0; r < 4; ++r) {
                    const f32x4 v4 = *(const f32x4*)(OUT + (bt & 1) * RW_NB * 32 + (ll + 64 * r) * 4);
                    *(f32x4*)((char*)a.RWO + (size_t)(oF + (unsigned)r * stF)) = v4;
                }
            }
        };
        __syncthreads();
        if (wid >= 4) { issue(0); commit(0); issue(1); }
        f32x2 S0 = {0.f, 0.f}, S1 = {0.f, 0.f}, S2 = {0.f, 0.f}, S3 = {0.f, 0.f};
        const int dr = lane >> 4, l16 = lane & 15, rp = (wid & 3) * 4 + dr, hi8 = l16 >> 3;
        const int vo = 320 + rp * 4 + hi8 * 2, oo = rp * 2 + hi8;
        for (int bt = 0; bt < NBT; ++bt) {
            asm volatile("s_waitcnt lgkmcnt(0)" ::: "memory");
            __builtin_amdgcn_s_barrier();
            asm volatile("" ::: "memory");
            if (wid >= 4) {
                if (bt + 1 < NBT) commit(bt + 1);
                if (bt + 2 < NBT) issue(bt + 2);
                if (bt > 0) flush(bt - 1);
            } else {
                const float* base = BUF + (bt & 1) * RW_NB * RW2_STR;
                float* outp = OUT + (bt & 1) * RW_NB * 32 + oo;
                const float* bs = base;
                f32x4 kk4 = *(const f32x4*)(bs + l16 * 4), w4 = *(const f32x4*)(bs + 64 + l16 * 4), ab4 = *(const f32x4*)(bs + 128 + l16 * 4),
                      ke4 = *(const f32x4*)(bs + 192 + l16 * 4), wr4 = *(const f32x4*)(bs + 256 + l16 * 4);
                f32x2 v2 = *(const f32x2*)(bs + vo), sc2 = *(const f32x2*)(bs + 384);
#pragma unroll
                for (int si = 0; si < RW_NB; ++si) {
                    const float* bn = base + (si + 1 < RW_NB ? si + 1 : si) * RW2_STR;
                    const f32x4 nkk4 = *(const f32x4*)(bn + l16 * 4), nw4 = *(const f32x4*)(bn + 64 + l16 * 4), nab4 = *(const f32x4*)(bn + 128 + l16 * 4),
                                nke4 = *(const f32x4*)(bn + 192 + l16 * 4), nwr4 = *(const f32x4*)(bn + 256 + l16 * 4);
                    const f32x2 nv2 = *(const f32x2*)(bn + vo), nsc2 = *(const f32x2*)(bn + 384);
                    float o;
                    asm volatile(
                        "v_pk_mul_f32 v[236:237], %[S0], %[kkl] op_sel_hi:[1,0]\n\t"
                        "v_pk_mul_f32 v[238:239], %[S0], %[wrl] op_sel_hi:[1,0]\n\t"
                        "v_pk_fma_f32 v[236:237], %[S1], %[kkl], v[236:237] op_sel:[0,1,0]\n\t"
                        "v_pk_fma_f32 v[238:239], %[S1], %[wrl], v[238:239] op_sel:[0,1,0]\n\t"
                        "v_pk_fma_f32 v[236:237], %[S2], %[kkh], v[236:237] op_sel_hi:[1,0,1]\n\t"
                        "v_pk_fma_f32 v[238:239], %[S2], %[wrh], v[238:239] op_sel_hi:[1,0,1]\n\t"
                        "v_pk_fma_f32 v[236:237], %[S3], %[kkh], v[236:237] op_sel:[0,1,0]\n\t"
                        "v_pk_fma_f32 v[238:239], %[S3], %[wrh], v[238:239] op_sel:[0,1,0]\n\t"
                        "v_pk_mul_f32 v[244:245], %[S0], %[wl] op_sel_hi:[1,0]\n\t"
                        "v_add_f32_dpp v240, v237, v236 row_ror:8 row_mask:0xf bank_mask:0xf bound_ctrl:1\n\t"
                        "v_add_f32_dpp v242, v239, v238 row_ror:8 row_mask:0xf bank_mask:0xf bound_ctrl:1\n\t"
                        "v_pk_mul_f32 v[246:247], %[S1], %[wl] op_sel:[0,1]\n\t"
                        "v_add_f32_dpp v240, v240, v240 quad_perm:[1,0,3,2] row_mask:0xf bank_mask:0xf bound_ctrl:1\n\t"
                        "v_add_f32_dpp v242, v242, v242 quad_perm:[1,0,3,2] row_mask:0xf bank_mask:0xf bound_ctrl:1\n\t"
                        "v_pk_mul_f32 v[248:249], %[S2], %[wh] op_sel_hi:[1,0]\n\t"
                        "v_add_f32_dpp v240, v240, v240 quad_perm:[2,3,0,1] row_mask:0xf bank_mask:0xf bound_ctrl:1\n\t"
                        "v_add_f32_dpp v242, v242, v242 quad_perm:[2,3,0,1] row_mask:0xf bank_mask:0xf bound_ctrl:1\n\t"
                        "v_pk_mul_f32 v[250:251], %[S3], %[wh] op_sel:[0,1]\n\t"
                        "v_add_f32_dpp v240, v240, v240 row_half_mirror row_mask:0xf bank_mask:0xf bound_ctrl:1\n\t"
                        "v_add_f32_dpp v242, v242, v242 row_half_mirror row_mask:0xf bank_mask:0xf bound_ctrl:1\n\t"
                        "v_pk_fma_f32 v[244:245], %[v2], %[kel], v[244:245] op_sel_hi:[1,0,1]\n\t"
                        "v_mov_b32_dpp v241, v240 row_ror:8 row_mask:0xf bank_mask:0xf bound_ctrl:1\n\t"
                        "v_pk_fma_f32 v[246:247], %[v2], %[kel], v[246:247] op_sel:[0,1,0]\n\t"
                        "v_pk_fma_f32 v[248:249], %[v2], %[keh], v[248:249] op_sel_hi:[1,0,1]\n\t"
                        "v_pk_fma_f32 %[S0], v[240:241], %[abl], v[244:245] op_sel_hi:[1,0,1] neg_lo:[1,0,0] neg_hi:[1,0,0]\n\t"
                        "v_pk_fma_f32 v[250:251], %[v2], %[keh], v[250:251] op_sel:[0,1,0]\n\t"
                        "v_pk_fma_f32 %[S1], v[240:241], %[abl], v[246:247] op_sel:[0,1,0] neg_lo:[1,0,0] neg_hi:[1,0,0]\n\t"
                        "v_fma_f32 v243, -v240, %[br], v242\n\t"
                        "v_pk_fma_f32 %[S2], v[240:241], %[abh], v[248:249] op_sel_hi:[1,0,1] neg_lo:[1,0,0] neg_hi:[1,0,0]\n\t"
                        "v_fma_f32 %[o], %[vx], %[kr], v243\n\t"
                        "v_pk_fma_f32 %[S3], v[240:241], %[abh], v[250:251] op_sel:[0,1,0] neg_lo:[1,0,0] neg_hi:[1,0,0]"
                        : [S0] "+v"(S0), [S1] "+v"(S1), [S2] "+v"(S2), [S3] "+v"(S3), [o] "=&v"(o)
                        : [kkl] "v"(__builtin_shufflevector(kk4, kk4, 0, 1)), [kkh] "v"(__builtin_shufflevector(kk4, kk4, 2, 3)),
                          [wrl] "v"(__builtin_shufflevector(wr4, wr4, 0, 1)), [wrh] "v"(__builtin_shufflevector(wr4, wr4, 2, 3)),
                          [wl] "v"(__builtin_shufflevector(w4, w4, 0, 1)), [wh] "v"(__builtin_shufflevector(w4, w4, 2, 3)),
                          [abl] "v"(__builtin_shufflevector(ab4, ab4, 0, 1)), [abh] "v"(__builtin_shufflevector(ab4, ab4, 2, 3)),
                          [kel] "v"(__builtin_shufflevector(ke4, ke4, 0, 1)), [keh] "v"(__builtin_shufflevector(ke4, ke4, 2, 3)),
                          [v2] "v"(v2), [vx] "v"(v2.x), [br] "v"(sc2.x), [kr] "v"(sc2.y)
                        : "v236", "v237", "v238", "v239", "v240", "v241", "v242", "v243", "v244", "v245", "v246", "v247", "v248", "v249", "v250", "v251");
                    outp[si * 32] = o;
                    kk4 = nkk4; w4 = nw4; ab4 = nab4; ke4 = nke4; wr4 = nwr4; v2 = nv2; sc2 = nsc2;
                }
            }
        }
        __syncthreads();
        if (wid >= 4) flush(NBT - 1);
    }
}
__device__ __forceinline__ void ph_l1_rwmerge(const L1Args& a) {
    const int tid = tid_fresh(), h = tid >> 6;
    for (int r = NCTX + blockIdx.x; r < NTOK; r += gridDim.x) {
        const size_t o = (size_t)r * 512 + tid;
        const float v = a.RWO[o] + a.RWO[(size_t)NTOK * 512 + o];
        const float ss = wave_sum(v * v);
        const float nv = v * rsqrtf(ss * (1.0f / 64.0f) + EPSF) * a.rw_norm[tid];
        const float outv = (nv + a.PBON[(size_t)r * 8 + h] * bf16_to_f32(a.PV[o])) * a.PG[o];
        a.MG[(size_t)r * DM + 512 + tid] = f2bf(outv);
    }
}

struct ConvArgs { const float* ab_in; const float* ab_out; const float* cd_in; const float* cd_out; const float* wgu; const float* wdn;
                  bf16_t* ab_inT; bf16_t* ab_outT; bf16_t* cd_inT; bf16_t* cd_outT; bf16_t* wguT; bf16_t* wdnT; };


#define XB_TMO      128
#define XB_XCNT(j)  (256  + 64 * (j))
#define XB_XSUB(j)  (1280 + 64 * (j))
#define XB_XGEN(j)  (2304 + 64 * (j))
#define XB_TOP      3328
#define XB_TOPGEN   3392
#define XCD_BAR_WORDS 3456
#define XB_SPIN_CAP (1u << 18)
#define LAS __attribute__((address_space(3)))

__device__ __forceinline__ unsigned xb_ld(unsigned* p)              { return __hip_atomic_load(p, __ATOMIC_RELAXED, __HIP_MEMORY_SCOPE_AGENT); }
__device__ __forceinline__ unsigned xb_add(unsigned* p, unsigned v) { return __hip_atomic_fetch_add(p, v, __ATOMIC_RELAXED, __HIP_MEMORY_SCOPE_AGENT); }
__device__ __forceinline__ unsigned xb_xcc_id() { return (unsigned)__builtin_amdgcn_s_getreg((3 << 11) | 20) & 0xFu; }
#define XB_SPIN(cond, bar) do { unsigned _sp = 0; while (cond) { __builtin_amdgcn_s_sleep(1); \
    if ((++_sp & 255u) == 0u) { if (xb_ld(&(bar)[XB_TMO])) break; if (_sp > XB_SPIN_CAP) { atomicAdd(&(bar)[XB_TMO], 1u); break; } } } } while (0)

struct XcdBarrier {
    unsigned* bar; unsigned x;
    volatile LAS unsigned* st;
};

__device__ __forceinline__ XcdBarrier xcd_barrier_post(unsigned* bar, volatile LAS unsigned* st) {
    XcdBarrier b; b.bar = bar; b.x = xb_xcc_id(); b.st = st;
    if (threadIdx.x == 0) (void)xb_add(&bar[XB_XCNT(b.x)], 1u);
    return b;
}
__device__ __forceinline__ void xcd_barrier_complete(unsigned* bar, unsigned x, unsigned& nloc, unsigned& nx) {
    const unsigned G = gridDim.x * gridDim.y * gridDim.z;
    unsigned sum, cnt, mine, sp = 0u;
    for (;;) {
        sum = 0u; cnt = 0u; mine = 0u;
#pragma unroll
        for (unsigned j = 0; j < 16; ++j) { const unsigned c = xb_ld(&bar[XB_XCNT(j)]); sum += c; cnt += (c > 0u) ? 1u : 0u; mine = (j == x) ? c : mine; }
        if (sum == G) break;
        __builtin_amdgcn_s_sleep(1);
        if ((++sp & 255u) == 0u) { if (xb_ld(&bar[XB_TMO])) break; if (sp > XB_SPIN_CAP) { atomicAdd(&bar[XB_TMO], 1u); break; } }
    }
    nloc = mine > 0u ? mine : 1u; nx = cnt > 0u ? cnt : 1u;
}

__device__ __forceinline__ void xcd_barrier(const XcdBarrier& b) {
    asm volatile("s_waitcnt vmcnt(0)" ::: "memory");
    __syncthreads();
    if (threadIdx.x == 0) {
        unsigned* bar = b.bar;
        __builtin_amdgcn_s_waitcnt(0);
        unsigned nloc = b.st[0], nx = b.st[1];
        if (nloc == 0u) { xcd_barrier_complete(bar, b.x, nloc, nx); b.st[0] = nloc; b.st[1] = nx; }
        const unsigned old = xb_add(&bar[XB_XSUB(b.x)], 1u);
        const unsigned gen = old / nloc;
        if (old + 1u == (gen + 1u) * nloc) {
            __builtin_amdgcn_fence(__ATOMIC_RELEASE, "agent");
            asm volatile("s_waitcnt vmcnt(0)" ::: "memory");
            const unsigned og = xb_add(&bar[XB_TOP], 1u);
            const unsigned tg = og / nx;
            if (og + 1u == (tg + 1u) * nx) xb_add(&bar[XB_TOPGEN], 1u);
            else XB_SPIN(xb_ld(&bar[XB_TOPGEN]) == tg, bar);
            __builtin_amdgcn_fence(__ATOMIC_ACQUIRE, "agent");
            xb_add(&bar[XB_XGEN(b.x)], 1u);
            asm volatile("s_waitcnt vmcnt(0)" ::: "memory");
        } else {
            XB_SPIN(xb_ld(&bar[XB_XGEN(b.x)]) == gen, bar);
            __builtin_amdgcn_fence(__ATOMIC_ACQUIRE, "agent");
            asm volatile("s_waitcnt vmcnt(0)" ::: "memory");
        }
    }
    __syncthreads();
}


__device__ __forceinline__ void sub_barrier(unsigned* bar, int word, unsigned n) {
    asm volatile("s_waitcnt vmcnt(0)" ::: "memory");
    __syncthreads();
    if (threadIdx.x == 0) {
        __builtin_amdgcn_s_waitcnt(0);
        __builtin_amdgcn_fence(__ATOMIC_RELEASE, "agent");
        asm volatile("s_waitcnt vmcnt(0)" ::: "memory");
        (void)xb_add(&bar[word], 1u);
        XB_SPIN(xb_ld(&bar[word]) < n, bar);
        __builtin_amdgcn_fence(__ATOMIC_ACQUIRE, "agent");
        asm volatile("s_waitcnt vmcnt(0)" ::: "memory");
    }
    __syncthreads();
}

struct FwdParams {
    const float* x; const float* c; const float* ctx; const float* c_ctx; const float* mod_w; const float* mod_b;
    const float* norm_mix; const float* norm_ffn; const float* norm_final;
    const float* router_w; const float* router_b; const float* bgu; const float* bdn;
    float* out;
    unsigned* bar; int* meta;
    float* mvec; float* H; bf16_t* Ub; bf16_t* ZB; float* P; float* Y;
    int* top_e; float* top_w; int* slot_of; int* list;
    float* slot_w;
    bf16_t* ab_inT; bf16_t* ab_outT; bf16_t* cd_inT; bf16_t* cd_outT; bf16_t* wguT; bf16_t* wdnT;
    ConvArgs cv; L0Args l0; L1Args l1;
};
#define LIST_INTS (NTOK * 4 + NEXP * 256)

__device__ __forceinline__ void ph_mod(const FwdParams& p) {
    float* sc = (float*)g_shm;
    float* part = sc + 5 * 1024;
    const int tid = tid_fresh();
    __syncthreads();
    for (int i = tid; i < 5 * 1024; i += NTHR) { const int b = i >> 10, k = i & 1023; sc[i] = siluf_(b < 4 ? p.c[b * 1024 + k] : p.c_ctx[k]); }
    __syncthreads();
    for (int cg = blockIdx.x; cg < 256; cg += gridDim.x) {
        const int colidx0 = cg * 48, layer = colidx0 / 6144, col0 = colidx0 % 6144;
        if (tid < 384) {
            const int cl = tid % 48, kp = tid / 48;
            const float* W = p.mod_w + (size_t)layer * 1024 * 6144 + col0 + cl;
            float a0 = 0.f, a1 = 0.f, a2 = 0.f, a3 = 0.f, a4 = 0.f;
#pragma unroll 8
            for (int k = kp * 128; k < kp * 128 + 128; ++k) {
                const float w = W[(size_t)k * 6144];
                a0 += sc[k] * w; a1 += sc[1024 + k] * w; a2 += sc[2048 + k] * w; a3 += sc[3072 + k] * w; a4 += sc[4096 + k] * w;
            }
            float* pp = part + (kp * 48 + cl) * 5;
            pp[0] = a0; pp[1] = a1; pp[2] = a2; pp[3] = a3; pp[4] = a4;
        }
        __syncthreads();
        if (tid < 240) {
            const int cl = tid / 5, rr = tid % 5;
            float sum = p.mod_b[layer * 6144 + col0 + cl];
#pragma unroll
            for (int kp = 0; kp < 8; ++kp) sum += part[(kp * 48 + cl) * 5 + rr];
            p.mvec[((size_t)layer * 5 + rr) * 6144 + col0 + cl] = sum;
        }
        __syncthreads();
    }
}
__device__ __forceinline__ const float* row_src(const float* src_ctx, const float* src_lat, int r) { return r < NCTX ? src_ctx + (size_t)r * DM : src_lat + (size_t)(r - NCTX) * DM; }
__device__ __forceinline__ int row_mrow(int r) { return r < NCTX ? 4 : (r - NCTX) / TL; }
__device__ __forceinline__ void ph_normmod(const float* src_ctx, const float* src_lat, const float* gain, const float* mvl, int row0, int row1, bf16_t* out) {
    const int tfz = tid_fresh(); const int wid = tfz >> 6, lane = tfz & 63;
    const int stride = gridDim.x * 8;
    int r = row0 + blockIdx.x * 8 + wid;
    float4 x[4], xn[4];
    if (r < row1) { const float4* src = (const float4*)row_src(src_ctx, src_lat, r);
#pragma unroll
        for (int i = 0; i < 4; ++i) x[i] = src[lane + 64 * i]; }
    for (; r < row1; r += stride) {
        const int rn = r + stride;
        if (rn < row1) { const float4* src = (const float4*)row_src(src_ctx, src_lat, rn);
#pragma unroll
            for (int i = 0; i < 4; ++i) xn[i] = src[lane + 64 * i]; }
        const float* mv = mvl + (size_t)row_mrow(r) * 6144;
        float ss = 0.f;
#pragma unroll
        for (int i = 0; i < 4; ++i) ss += x[i].x * x[i].x + x[i].y * x[i].y + x[i].z * x[i].z + x[i].w * x[i].w;
        const float rs = rsqrtf(wave_sum(ss) * (1.0f / DM) + EPSF);
#pragma unroll
        for (int i = 0; i < 4; ++i) {
            const int c4 = lane + 64 * i;
            const float4 g = ((const float4*)gain)[c4], sh = ((const float4*)mv)[c4], sc = ((const float4*)(mv + 1024))[c4];
            st_bf16x4(out + (size_t)r * DM + c4 * 4, x[i].x * rs * g.x * (1.0f + sc.x) + sh.x, x[i].y * rs * g.y * (1.0f + sc.y) + sh.y,
                      x[i].z * rs * g.z * (1.0f + sc.z) + sh.z, x[i].w * rs * g.w * (1.0f + sc.w) + sh.w);
        }
#pragma unroll
        for (int i = 0; i < 4; ++i) x[i] = xn[i];
    }
}
__device__ __forceinline__ void ph_norm_router(const FwdParams& p, int layer, int row0, int row1) {
    float* RW = (float*)g_shm;
    float* lgs = RW + 1024 * 32;
    int* hist = (int*)(lgs + 8 * 32);
    const int tid = tid_fresh(), wid = tid >> 6, lane = tid & 63;
    const float* mvl = p.mvec + (size_t)layer * 5 * 6144;
    const float* gain = p.norm_ffn + layer * DM;
    const float* rw = p.router_w + (size_t)layer * 1024 * 32;
    const float* rb = p.router_b + layer * 32;
    int* meta = p.meta + layer * 128;
    __syncthreads();
    if (tid < 32) hist[tid] = 0;
    for (int i = tid; i < 1024 * 8; i += NTHR) {
        const int k = i >> 3, c8 = i & 7;
        const int i2 = k >> 5, kq = (k >> 2) & 7, c = k & 3;
        *(float4*)(RW + (32 * i2 + 8 * c + kq) * 32 + c8 * 4) = *(const float4*)(rw + k * 32 + c8 * 4);
    }
    __syncthreads();
    const int e4 = lane & 7, kq = lane >> 3;
    const int stride = gridDim.x * 8;
    int r = row0 + blockIdx.x * 8 + wid;
    float4 hn[4];
    if (r < row1) {
#pragma unroll
        for (int i = 0; i < 4; ++i) hn[i] = ((const float4*)(p.H + (size_t)r * DM))[lane + 64 * i]; }
    for (; r < row1; r += stride) {
        const float* mv = mvl + (size_t)row_mrow(r) * 6144;
        float4 hh[4]; float ss = 0.f;
#pragma unroll
        for (int i = 0; i < 4; ++i) {
            hh[i] = hn[i];
            ss += hh[i].x * hh[i].x + hh[i].y * hh[i].y + hh[i].z * hh[i].z + hh[i].w * hh[i].w;
        }
        if (r + stride < row1) {
#pragma unroll
            for (int i = 0; i < 4; ++i) hn[i] = ((const float4*)(p.H + (size_t)(r + stride) * DM))[lane + 64 * i]; }
        const float rs = rsqrtf(wave_sum(ss) * (1.0f / DM) + EPSF);
#pragma unroll
        for (int i = 0; i < 4; ++i) {
            const int c4 = lane + 64 * i;
            const float4 g = ((const float4*)gain)[c4], sh = ((const float4*)(mv + 3072))[c4], sc = ((const float4*)(mv + 4096))[c4];
            hh[i].x = hh[i].x * rs * g.x * (1.0f + sc.x) + sh.x; hh[i].y = hh[i].y * rs * g.y * (1.0f + sc.y) + sh.y;
            hh[i].z = hh[i].z * rs * g.z * (1.0f + sc.z) + sh.z; hh[i].w = hh[i].w * rs * g.w * (1.0f + sc.w) + sh.w;
            st_bf16x4(p.Ub + (size_t)r * DM + c4 * 4, hh[i].x, hh[i].y, hh[i].z, hh[i].w);
        }
        float l0 = 0.f, l1 = 0.f, l2 = 0.f, l3 = 0.f;
#pragma unroll
        for (int i2 = 0; i2 < 32; ++i2) {
            const int srcl = kq + 8 * (i2 & 7);
            const float4 hv = hh[i2 >> 3];
            const float x0 = __shfl(hv.x, srcl), x1 = __shfl(hv.y, srcl), x2 = __shfl(hv.z, srcl), x3 = __shfl(hv.w, srcl);
            const float* wp = RW + (32 * i2 + kq) * 32 + e4 * 4;
            const float4 w0 = *(const float4*)wp, w1 = *(const float4*)(wp + 8 * 32), w2 = *(const float4*)(wp + 16 * 32), w3 = *(const float4*)(wp + 24 * 32);
            l0 += x0 * w0.x + x1 * w1.x + x2 * w2.x + x3 * w3.x;
            l1 += x0 * w0.y + x1 * w1.y + x2 * w2.y + x3 * w3.y;
            l2 += x0 * w0.z + x1 * w1.z + x2 * w2.z + x3 * w3.z;
            l3 += x0 * w0.w + x1 * w1.w + x2 * w2.w + x3 * w3.w;
        }
#pragma unroll
        for (int o = 8; o < 64; o <<= 1) { l0 += __shfl_xor(l0, o); l1 += __shfl_xor(l1, o); l2 += __shfl_xor(l2, o); l3 += __shfl_xor(l3, o); }
        if (lane < 8) { float* lg = lgs + wid * 32 + e4 * 4; lg[0] = l0 + rb[e4 * 4]; lg[1] = l1 + rb[e4 * 4 + 1]; lg[2] = l2 + rb[e4 * 4 + 2]; lg[3] = l3 + rb[e4 * 4 + 3]; }
        float val = (lane < 32) ? lgs[wid * 32 + lane] : -INFINITY;
        float tv[4]; int ti[4];
#pragma unroll
        for (int k = 0; k < 4; ++k) {
            float bv = val; int bi = lane;
#pragma unroll
            for (int o = 1; o < 64; o <<= 1) {
                const float ov = __shfl_xor(bv, o); const int oi = __shfl_xor(bi, o);
                if (ov > bv || (ov == bv && oi < bi)) { bv = ov; bi = oi; }
            }
            tv[k] = bv; ti[k] = bi;
            if (lane == bi) val = -INFINITY;
        }
        const float w0 = 1.0f, w1 = expf(tv[1] - tv[0]), w2 = expf(tv[2] - tv[0]), w3 = expf(tv[3] - tv[0]);
        const float inv = 1.0f / (w0 + w1 + w2 + w3);
        if (lane == 0) {
            *(int4*)(p.top_e + (size_t)r * 4) = make_int4(ti[0], ti[1], ti[2], ti[3]);
            *(float4*)(p.top_w + (size_t)r * 4) = make_float4(w0 * inv, w1 * inv, w2 * inv, w3 * inv);
            atomicAdd(&hist[ti[0]], 1); atomicAdd(&hist[ti[1]], 1); atomicAdd(&hist[ti[2]], 1); atomicAdd(&hist[ti[3]], 1);
        }
    }
    __syncthreads();
    if (tid < 32 && hist[tid] != 0) atomicAdd(&meta[tid], hist[tid]);
}
__device__ __forceinline__ void ph_assign(const FwdParams& p, int layer, int row0, int row1) {
    int* hist = (int*)g_shm; int* base = hist + 32; int* lcur = base + 32;
    const int tid = tid_fresh();
    int* meta = p.meta + layer * 128;
    int* list = p.list + (size_t)layer * LIST_INTS;
    __syncthreads();
    if (tid < 32) { hist[tid] = 0; lcur[tid] = 0; }
    __syncthreads();
    const int npairs = (row1 - row0) * 4;
    for (int i = blockIdx.x * NTHR + tid; i < npairs; i += gridDim.x * NTHR) atomicAdd(&hist[p.top_e[(size_t)row0 * 4 + i]], 1);
    __syncthreads();
    if (tid < 32) {
        int off = 0;
        for (int e = 0; e < tid; ++e) off += (meta[e] + 255) & ~255;
        if (blockIdx.x == 0) meta[64 + tid] = off;
        base[tid] = off + (hist[tid] ? atomicAdd(&meta[32 + tid], hist[tid]) : 0);
    }
    __syncthreads();
    for (int i = blockIdx.x * NTHR + tid; i < npairs; i += gridDim.x * NTHR) {
        const int e = p.top_e[(size_t)row0 * 4 + i];
        const int slot = base[e] + atomicAdd(&lcur[e], 1);
        list[slot] = row0 + (i >> 2);
        p.slot_of[(size_t)row0 * 4 + i] = slot;
        p.slot_w[slot] = p.top_w[(size_t)row0 * 4 + i];
    }
}
template <bool FINAL>
__device__ __forceinline__ void ph_combine(const FwdParams& p, int layer, int row0, int row1) {
    const int tfz = tid_fresh(); const int wid = tfz >> 6, lane = tfz & 63;
    const float* mvl = p.mvec + (size_t)layer * 5 * 6144;
    const bf16_t* YS = (const bf16_t*)p.P;
    const int stride = gridDim.x * 8;
    int r = row0 + blockIdx.x * 8 + wid;
    int4 sl_n = make_int4(0, 0, 0, 0);
    u32x2 ya[4][4], yn[4][4]; float4 ha[4], hnx[4];
    auto load_rows = [&](int rr, const int4& sl, u32x2 (&y)[4][4], float4 (&h)[4]) {
#pragma unroll
        for (int i = 0; i < 4; ++i) {
            const int c4 = lane + 64 * i;
            y[0][i] = *(const u32x2*)(YS + (size_t)sl.x * DM + c4 * 4); y[1][i] = *(const u32x2*)(YS + (size_t)sl.y * DM + c4 * 4);
            y[2][i] = *(const u32x2*)(YS + (size_t)sl.z * DM + c4 * 4); y[3][i] = *(const u32x2*)(YS + (size_t)sl.w * DM + c4 * 4);
            h[i] = ((const float4*)(p.H + (size_t)rr * DM))[c4];
        }
    };
    if (r < row1) {
        const int4 sl0 = *(const int4*)(p.slot_of + (size_t)r * 4);
        load_rows(r, sl0, ya, ha);
        if (r + stride < row1) sl_n = *(const int4*)(p.slot_of + (size_t)(r + stride) * 4);
    }
    for (; r < row1; r += stride) {
        const int rn = r + stride;
        if (rn < row1) {
            load_rows(rn, sl_n, yn, hnx);
            if (rn + stride < row1) sl_n = *(const int4*)(p.slot_of + (size_t)(rn + stride) * 4);
        }
        const float* mv = mvl + (size_t)row_mrow(r) * 6144;
        float4 hh[4]; float ss = 0.f;
#pragma unroll
        for (int i = 0; i < 4; ++i) {
            const int c4 = lane + 64 * i;
            float ys4[4];
#pragma unroll
            for (int x = 0; x < 4; ++x) {
                float acc = 0.f;
#pragma unroll
                for (int k = 0; k < 4; ++k) { const unsigned w = x < 2 ? ya[k][i].x : ya[k][i].y; acc += __uint_as_float((x & 1) ? (w & 0xffff0000u) : (w << 16)); }
                ys4[x] = acc;
            }
            const float4 gt = ((const float4*)(mv + 5120))[c4];
            float4 h = ha[i];
            h.x += gt.x * ys4[0]; h.y += gt.y * ys4[1]; h.z += gt.z * ys4[2]; h.w += gt.w * ys4[3];
            hh[i] = h;
            if (!FINAL) ((float4*)(p.H + (size_t)r * DM))[c4] = h;
            ss += h.x * h.x + h.y * h.y + h.z * h.z + h.w * h.w;
        }
        const float rs = rsqrtf(wave_sum(ss) * (1.0f / DM) + EPSF);
        if (FINAL) {
#pragma unroll
            for (int i = 0; i < 4; ++i) {
                const int c4 = lane + 64 * i;
                const float4 g = ((const float4*)p.norm_final)[c4];
                ((float4*)(p.out + (size_t)(r - NCTX) * DM))[c4] = make_float4(hh[i].x * rs * g.x, hh[i].y * rs * g.y, hh[i].z * rs * g.z, hh[i].w * rs * g.w);
            }
        } else {
            const float* mv1 = p.mvec + (size_t)(layer + 1) * 5 * 6144 + (size_t)row_mrow(r) * 6144;
            const float* gain = p.norm_mix + (layer + 1) * DM;
#pragma unroll
            for (int i = 0; i < 4; ++i) {
                const int c4 = lane + 64 * i;
                const float4 g = ((const float4*)gain)[c4], sh = ((const float4*)mv1)[c4], sc = ((const float4*)(mv1 + 1024))[c4];
                st_bf16x4(p.Ub + (size_t)r * DM + c4 * 4, hh[i].x * rs * g.x * (1.0f + sc.x) + sh.x, hh[i].y * rs * g.y * (1.0f + sc.y) + sh.y,
                          hh[i].z * rs * g.z * (1.0f + sc.z) + sh.z, hh[i].w * rs * g.w * (1.0f + sc.w) + sh.w);
            }
        }
#pragma unroll
        for (int k = 0; k < 4; ++k)
#pragma unroll
            for (int i = 0; i < 4; ++i) ya[k][i] = yn[k][i];
#pragma unroll
        for (int i = 0; i < 4; ++i) ha[i] = hnx[i];
    }
}

__global__ void __launch_bounds__(NTHR, 2) k_fwd(FwdParams p) {
    volatile LAS unsigned* xbw = (volatile LAS unsigned*)(g_shm + LDS_BYTES - 16);
    if (threadIdx.x == 0) { xbw[0] = 0u; xbw[1] = 0u; xbw[2] = 0u; xbw[3] = 0u; }
    __syncthreads();
    XcdBarrier bar = xcd_barrier_post(p.bar, xbw);
    {
        int base = 0;
        const int bi = blockIdx.x, nb = gridDim.x;
        base = convert_matrix<2>(p.cv.ab_in, AB_IN, 3328, p.cv.ab_inT, base, bi, nb);
        base = convert_matrix<0>(p.cv.ab_out, 1024, 1024, p.cv.ab_outT, base, bi, nb);
        base = convert_matrix<2>(p.cv.cd_in, CD_IN, 4608, p.cv.cd_inT, base, bi, nb);
        base = convert_matrix<0>(p.cv.cd_out, 1024, 1024, p.cv.cd_outT, base, bi, nb);
        convert_experts(p.cv.wgu, p.cv.wdn, p.cv.wguT, p.cv.wdnT, 0, NEXP, bi, nb);
        ph_mod(p);
        ph_l1_wlr(p.l1);
    }
    xcd_barrier(bar);
    ph_normmod(p.ctx, p.x, p.norm_mix, p.mvec, 0, NTOK, p.Ub);
    xcd_barrier(bar);
    ph_gemm_bf16out(p.Ub, 0, NTOK, p.ab_inT, AB_IN, 3328, p.ZB, AB_IN);
    xcd_barrier(bar);
    ph_l0_prep(p.l0);
    xcd_barrier(bar);
    ph_l0_local(p.l0);
    xcd_barrier(bar);
    ph_l0_prop(p.l0);
    xcd_barrier(bar);
    ph_l0_out(p.l0);
    xcd_barrier(bar);
    ph_gemm_resid(p.Ub, 0, NTOK, p.ab_outT, p.ctx, p.x, p.mvec + 2048, p.H);
    xcd_barrier(bar);
    ph_norm_router(p, 0, 0, NTOK);
    xcd_barrier(bar);
    ph_assign(p, 0, 0, NTOK);
    xcd_barrier(bar);
    ph_moe_gu(p.Ub, p.meta, p.list, p.wguT, p.bgu, p.ZB);
    xcd_barrier(bar);
    ph_moe_dn(p.ZB, p.meta, p.wdnT, p.bdn, (bf16_t*)p.P, p.slot_w);
    xcd_barrier(bar);
    ph_combine<false>(p, 0, 0, NTOK);
    xcd_barrier(bar);
    ph_gemm_bf16out(p.Ub, 0, NTOK, p.cd_inT, CD_IN, 4608, p.ZB, CD_IN);
    xcd_barrier(bar);
    ph_l1_rwprep(p.l1);
    xcd_barrier(bar);
    {
        const int nrw = (int)gridDim.x >> 1;
        if ((int)blockIdx.x < nrw) ph_l1_rwkv2(p.l1, blockIdx.x, nrw);
        else {
            const int bi = (int)blockIdx.x - nrw, nb = (int)gridDim.x - nrw;
            ph_l1_local(p.l1, bi, nb);
            sub_barrier(p.bar, 0, (unsigned)nb);
            ph_l1_prop(p.l1, bi, nb);
            sub_barrier(p.bar, 64, (unsigned)nb);
            ph_l1_out(p.l1, bi, nb);
            convert_experts(p.cv.wgu, p.cv.wdn, p.cv.wguT, p.cv.wdnT, NEXP, 2 * NEXP, bi, nb);
        }
    }
    xcd_barrier(bar);
    ph_l1_rwmerge(p.l1);
    xcd_barrier(bar);
    ph_gemm_resid(p.Ub, NCTX, NLAT, p.cd_outT, p.H, p.H + (size_t)NCTX * DM, p.mvec + 5 * 6144 + 2048, p.H);
    xcd_barrier(bar);
    ph_norm_router(p, 1, NCTX, NTOK);
    xcd_barrier(bar);
    ph_assign(p, 1, NCTX, NTOK);
    xcd_barrier(bar);
    ph_moe_gu(p.Ub, p.meta + 128, p.list + LIST_INTS, p.wguT + (size_t)NEXP * 2048 * 1024, p.bgu + NEXP * 2048, p.ZB);
    xcd_barrier(bar);
    ph_moe_dn(p.ZB, p.meta + 128, p.wdnT + (size_t)NEXP * 1024 * 1024, p.bdn + NEXP * 1024, (bf16_t*)p.P, p.slot_w);
    xcd_barrier(bar);
    ph_combine<true>(p, 1, NCTX, NTOK);
}

extern "C" void kernel_launch(void* const* d_in, const int* in_sizes, int n_in, void* d_out, int out_size, void* d_ws, size_t ws_size,
                              hipStream_t stream) {
    const size_t NT1024 = (size_t)NTOK * 1024, NT512 = (size_t)NTOK * 512;
    char* wp = (char*)d_ws;
    auto carve = [&](size_t bytes) { char* q = wp; wp += (bytes + 255) & ~(size_t)255; return q; };
    const size_t CTL_BYTES = (size_t)XCD_BAR_WORDS * 4 + 256 * 4 + (size_t)2 * LIST_INTS * 4;
    char* ctl = carve(CTL_BYTES);
    unsigned* bar = (unsigned*)ctl;
    int* meta = (int*)(ctl + (size_t)XCD_BAR_WORDS * 4);
    int* list = (int*)(ctl + (size_t)XCD_BAR_WORDS * 4 + 256 * 4);
    FwdParams p{};
    p.x = (const float*)d_in[0]; p.c = (const float*)d_in[1]; p.ctx = (const float*)d_in[2]; p.c_ctx = (const float*)d_in[3];
    p.mod_w = (const float*)d_in[4]; p.mod_b = (const float*)d_in[5]; p.norm_mix = (const float*)d_in[6]; p.norm_ffn = (const float*)d_in[7];
    p.norm_final = (const float*)d_in[8];
    p.router_w = (const float*)d_in[30]; p.router_b = (const float*)d_in[31]; p.bgu = (const float*)d_in[33]; p.bdn = (const float*)d_in[35];
    p.out = (float*)d_out;
    p.bar = bar; p.meta = meta; p.list = list;
    p.mvec = (float*)carve((size_t)2 * 5 * 6144 * 4);
    p.ab_inT = (bf16_t*)carve((size_t)3328 * 1024 * 2);
    p.ab_outT = (bf16_t*)carve((size_t)1024 * 1024 * 2);
    p.cd_inT = (bf16_t*)carve((size_t)4608 * 1024 * 2);
    p.cd_outT = (bf16_t*)carve((size_t)1024 * 1024 * 2);
    p.wguT = (bf16_t*)carve((size_t)2 * NEXP * 2048 * 1024 * 2);
    p.wdnT = (bf16_t*)carve((size_t)2 * NEXP * 1024 * 1024 * 2);
    p.H = (float*)carve(NT1024 * 4);
    p.Ub = (bf16_t*)carve(NT1024 * 2);
    p.ZB = (bf16_t*)carve((size_t)NTOK * CD_IN * 2);
    const size_t P_BYTES = (size_t)805306368;
    p.P = (float*)carve(P_BYTES);
    float* O = (float*)carve(NT512 * 4 * 4);
    p.Y = O;
    p.top_e = (int*)carve((size_t)NTOK * 4 * 4);
    p.top_w = (float*)carve((size_t)NTOK * 4 * 4);
    p.slot_of = (int*)carve((size_t)NTOK * 4 * 4);
    bf16_t* WLR = (bf16_t*)carve((size_t)196608 * 2);
    p.slot_w = (float*)carve((size_t)LIST_INTS * 4);
    if ((size_t)(wp - (char*)d_ws) > ws_size) return;

    p.cv.ab_in = (const float*)d_in[9]; p.cv.ab_out = (const float*)d_in[10]; p.cv.cd_in = (const float*)d_in[16]; p.cv.cd_out = (const float*)d_in[17];
    p.cv.wgu = (const float*)d_in[32]; p.cv.wdn = (const float*)d_in[34];
    p.cv.ab_inT = p.ab_inT; p.cv.ab_outT = p.ab_outT; p.cv.cd_inT = p.cd_inT; p.cv.cd_outT = p.cd_outT; p.cv.wguT = p.wguT; p.cv.wdnT = p.wdnT;
    {
        char* pp = (char*)p.P;
        auto sub = [&](size_t bytes) { char* q = pp; pp += (bytes + 255) & ~(size_t)255; return q; };
        L0Args& a = p.l0;
        a.z = p.ZB; a.ml_conv = (const float*)d_in[13]; a.gate_b = (const float*)d_in[14]; a.ret_decay = (const float*)d_in[11];
        a.ret_norm = (const float*)d_in[12]; a.ml_norm = (const float*)d_in[15];
        a.RQ = (bf16_t*)sub((size_t)NTOK * 256 * 2); a.RK = (bf16_t*)sub((size_t)NTOK * 256 * 2);
        a.MQ = (bf16_t*)sub((size_t)NTOK * 256 * 2); a.MK = (bf16_t*)sub((size_t)NTOK * 256 * 2);
        a.LIF = (float*)sub((size_t)NTOK * 16 * 4);
        a.ST = (bf16_t*)sub((size_t)16 * NCHUNK * REC * 2);
        a.CM = (float*)sub((size_t)8 * NCHUNK * 2 * 4);
        a.MI = (float*)sub((size_t)8 * NCHUNK * 4);
        a.MG = p.Ub;
        if ((size_t)(pp - (char*)p.P) > P_BYTES) return;
    }
    {
        char* pp = (char*)p.P;
        auto sub = [&](size_t bytes) { char* q = pp; pp += (bytes + 255) & ~(size_t)255; return q; };
        L1Args& a = p.l1;
        a.z = p.ZB; a.hgrn_lb = (const float*)d_in[18]; a.hg_norm = (const float*)d_in[19];
        a.HST = (bf16_t*)sub((size_t)8 * NCHUNK * HREC * 2);
        a.HDEC = (float*)sub((size_t)8 * NCHUNK * 128 * 4);
        a.MG = p.Ub;
        a.shift = (const float*)d_in[20]; a.w0 = (const float*)d_in[21]; a.w2 = (const float*)d_in[22]; a.a0 = (const float*)d_in[23];
        a.a2 = (const float*)d_in[24]; a.g2 = (const float*)d_in[25]; a.kk_scale = (const float*)d_in[26]; a.k_a = (const float*)d_in[27];
        a.r_k = (const float*)d_in[28]; a.rw_norm = (const float*)d_in[29];
        a.PKK = (bf16_t*)sub(NT512 * 2); a.PV = (bf16_t*)sub(NT512 * 2);
        a.PG = (float*)sub(NT512 * 4);
        a.PW = (float*)sub(NT512 * 2 * 4);
        a.PAB = (bf16_t*)sub(NT512 * 2 * 2); a.PKE = (bf16_t*)sub(NT512 * 2 * 2); a.PWR = (bf16_t*)sub(NT512 * 2 * 2);
        a.PSC = (float*)sub((size_t)2 * NTOK * 16 * 4);
        a.PBON = (float*)sub((size_t)NTOK * 8 * 4);
        a.RWO = O; a.WLR = WLR;
        if ((size_t)(pp - (char*)p.P) > P_BYTES) return;
    }
    static int grid = 0;
    if (grid == 0) {
        int dev = 0, cus = 0;
        if (hipGetDevice(&dev) != hipSuccess || hipDeviceGetAttribute(&cus, hipDeviceAttributeMultiprocessorCount, dev) != hipSuccess) { grid = -1; return; }
        if (hipFuncSetAttribute((const void*)k_fwd, hipFuncAttributeMaxDynamicSharedMemorySize, LDS_BYTES) != hipSuccess) { grid = -1; return; }
        int per_cu = 0;
        if (hipOccupancyMaxActiveBlocksPerMultiprocessor(&per_cu, (const void*)k_fwd, NTHR, LDS_BYTES) != hipSuccess || per_cu < 1) { (void)hipGetLastError(); }
        grid = cus > 0 ? cus : 256;
    }
    if (grid < 0) return;
    (void)hipMemsetAsync(ctl, 0, CTL_BYTES, stream);
    k_fwd<<<grid, NTHR, LDS_BYTES, stream>>>(p);
}
```

```cpp
#include <hip/hip_runtime.h>
#include <stdint.h>
#include <stddef.h>

#define DM 1024
#define NB 4
#define TL 8192
#define TC 256
#define NCTX (NB * TC)
#define NLAT (NB * TL)
#define NTOK (NCTX + NLAT)
#define AB_IN 3088
#define CD_IN 4480
#define NEXP 32
#define EPSF 1e-6f

typedef unsigned short bf16_t;
typedef unsigned u32x2 __attribute__((ext_vector_type(2)));
typedef unsigned u32x4 __attribute__((ext_vector_type(4)));
__device__ __forceinline__ unsigned cvt_pk_bf16(float lo, float hi) { unsigned r; asm volatile("v_cvt_pk_bf16_f32 %0, %1, %2" : "=v"(r) : "v"(lo), "v"(hi)); return r; }
typedef __bf16 bf16x2_t __attribute__((ext_vector_type(2)));
typedef float f32x2_t __attribute__((ext_vector_type(2)));
__device__ __forceinline__ unsigned cvt_pk_bf16_nat(float lo, float hi) { const f32x2_t v = {lo, hi}; return __builtin_bit_cast(unsigned, __builtin_convertvector(v, bf16x2_t)); }
__device__ __forceinline__ void st_bf16x8(bf16_t* p, float a, float b, float c, float d, float e, float f, float g, float h) { u32x4 w; w.x = cvt_pk_bf16_nat(a, b); w.y = cvt_pk_bf16_nat(c, d); w.z = cvt_pk_bf16_nat(e, f); w.w = cvt_pk_bf16_nat(g, h); *(u32x4*)p = w; }
__device__ __forceinline__ void st_bf16x4(bf16_t* p, float a, float b, float c, float d) { u32x2 w; w.x = cvt_pk_bf16(a, b); w.y = cvt_pk_bf16(c, d); *(u32x2*)p = w; }
__device__ __forceinline__ float sigmoidf_(float x) { return 1.0f / (1.0f + expf(-x)); }
__device__ __forceinline__ float siluf_(float x) { return x / (1.0f + expf(-x)); }
__device__ __forceinline__ float logsigmoidf_(float x) { return fminf(x, 0.0f) - log1pf(expf(-fabsf(x))); }
__device__ __forceinline__ float softplusf_(float x) { return fmaxf(x, 0.0f) + log1pf(expf(-fabsf(x))); }

__device__ __forceinline__ float fexp_(float x) { return __expf(x); }
__device__ __forceinline__ float frcp_(float x) { return __builtin_amdgcn_rcpf(x); }
__device__ __forceinline__ float fsigmoid_(float x) { return frcp_(1.0f + __expf(-x)); }
__device__ __forceinline__ float flog_(float x) { return __logf(x); }
__device__ __forceinline__ float wave_sum(float v) {
#pragma unroll
    for (int o = 32; o > 0; o >>= 1) v += __shfl_xor(v, o);
    return v;
}
__device__ __forceinline__ float block_sum(float v, float* red) {
    v = wave_sum(v);
    const int w = threadIdx.x >> 6, nw = blockDim.x >> 6;
    __syncthreads();
    if ((threadIdx.x & 63) == 0) red[w] = v;
    __syncthreads();
    float s = 0.f;
    for (int i = 0; i < nw; ++i) s += red[i];
    return s;
}

struct RowInfo { int t, len, mrow; };
__device__ __forceinline__ RowInfo row_info(int r) {
    RowInfo ri;
    if (r < NCTX) { ri.t = r % TC; ri.len = TC; ri.mrow = 4; }
    else { const int rr = r - NCTX; ri.t = rr % TL; ri.len = TL; ri.mrow = rr / TL; }
    return ri;
}

typedef short bf16x8 __attribute__((ext_vector_type(8)));
typedef float f32x4 __attribute__((ext_vector_type(4)));
#define NTHR 512
__device__ __forceinline__ int tid_fresh() { int t = threadIdx.x; asm volatile("" : "+v"(t)); return t; }
#define LDS_BYTES 147456
#define LDS_TAB 131072
extern __shared__ __attribute__((aligned(16))) char g_shm[];

__device__ __forceinline__ float bf16_to_f32(bf16_t v) { return __uint_as_float(((unsigned)v) << 16); }
__device__ __forceinline__ float ldz(const bf16_t* p) { return bf16_to_f32(*p); }
__device__ __forceinline__ f32x4 ldz4(const bf16_t* p) { const u32x2 w = *(const u32x2*)p; f32x4 r; r[0] = __uint_as_float(w.x << 16); r[1] = __uint_as_float(w.x & 0xffff0000u); r[2] = __uint_as_float(w.y << 16); r[3] = __uint_as_float(w.y & 0xffff0000u); return r; }

template <int MODE>
__device__ __forceinline__ int src_col(int sn) {
    if (MODE == 2) { const int rho = sn & 31, nn = rho >> 4, ii = rho & 15; sn = (sn & ~31) + 8 * (ii >> 2) + 4 * nn + (ii & 3); }
    if (MODE == 1) {
        const int u = sn >> 8, within = sn & 255, bj = within >> 7, q = within & 127, rho = q & 31, nn = rho >> 4, ii = rho & 15;
        sn = (bj ? 1024 : 0) + u * 128 + (q & ~31) + 8 * (ii >> 2) + 4 * nn + (ii & 3);
    }
    return sn;
}
template <int MODE>
__device__ __forceinline__ void convert_tile(const float* __restrict__ W, int N, bf16_t* __restrict__ Wt, int n0, int k0) {
    float (*tile)[129] = (float (*)[129])g_shm;
    const int tid = tid_fresh();
    const int kr = tid >> 5, n4 = (tid & 31) * 4;
    const int sn = src_col<MODE>(n0 + n4);
    f32x4 v[4];
#pragma unroll
    for (int i = 0; i < 4; ++i) {
        v[i] = (f32x4){0.f, 0.f, 0.f, 0.f};
        if (sn < N) v[i] = *(const f32x4*)(W + (size_t)(k0 + kr + 16 * i) * N + sn);
    }
    __syncthreads();
#pragma unroll
    for (int i = 0; i < 4; ++i) { float* t = &tile[kr + 16 * i][n4]; t[0] = v[i][0]; t[1] = v[i][1]; t[2] = v[i][2]; t[3] = v[i][3]; }
    __syncthreads();
    const int n = tid >> 2, k16 = (tid & 3) * 16;
    u32x4 o0, o1;
    o0.x = cvt_pk_bf16(tile[k16 + 0][n], tile[k16 + 1][n]); o0.y = cvt_pk_bf16(tile[k16 + 2][n], tile[k16 + 3][n]);
    o0.z = cvt_pk_bf16(tile[k16 + 4][n], tile[k16 + 5][n]); o0.w = cvt_pk_bf16(tile[k16 + 6][n], tile[k16 + 7][n]);
    o1.x = cvt_pk_bf16(tile[k16 + 8][n], tile[k16 + 9][n]); o1.y = cvt_pk_bf16(tile[k16 + 10][n], tile[k16 + 11][n]);
    o1.z = cvt_pk_bf16(tile[k16 + 12][n], tile[k16 + 13][n]); o1.w = cvt_pk_bf16(tile[k16 + 14][n], tile[k16 + 15][n]);
    bf16_t* dst = Wt + (size_t)(n0 + n) * 1024 + k0 + k16;
    *(u32x4*)dst = o0; *(u32x4*)(dst + 8) = o1;
}
template <int MODE>
__device__ __forceinline__ int convert_matrix(const float* W, int N, int Npad, bf16_t* Wt, int base, int bi, int G) {
    const int ntiles = (Npad >> 7) * 16;
    for (int it = base + ((bi - base % G) + G) % G; it < base + ntiles; it += G) {
        const int l = it - base;
        convert_tile<MODE>(W, N, Wt, (l >> 4) * 128, (l & 15) * 64);
    }
    return base + ntiles;
}
__device__ __forceinline__ void lds_barrier() { asm volatile("s_waitcnt lgkmcnt(0)" ::: "memory"); __builtin_amdgcn_s_barrier(); asm volatile("" ::: "memory"); }
__device__ __forceinline__ void convert_experts(const float* __restrict__ wgu, const float* __restrict__ wdn, bf16_t* __restrict__ wguT, bf16_t* __restrict__ wdnT, int le0, int le1, int bi, int G) {
    float (*tile)[129] = (float (*)[129])g_shm;
    const int tid = tid_fresh();
    const int kr = tid >> 5, n4 = (tid & 31) * 4;
    const int n = tid >> 2, k16 = (tid & 3) * 16;
    const int total = (le1 - le0) * 384;
    f32x4 v[4];
    auto issue = [&](int item) {
        const int e = le0 + item / 384, t = item % 384;
        const bool gu = t < 256; const int l = gu ? t : t - 256;
        const int n0 = (l >> 4) * 128, k0 = (l & 15) * 64, N = gu ? 2048 : 1024;
        const float* W = gu ? wgu + (size_t)e * 1024 * 2048 : wdn + (size_t)e * 1024 * 1024;
        const int sn = gu ? src_col<1>(n0 + n4) : src_col<2>(n0 + n4);
#pragma unroll
        for (int i = 0; i < 4; ++i) v[i] = *(const f32x4*)(W + (size_t)(k0 + kr + 16 * i) * N + sn);
    };
    __syncthreads();
    int item = bi;
    if (item < total) issue(item);
    for (; item < total; item += G) {
        lds_barrier();
#pragma unroll
        for (int i = 0; i < 4; ++i) { float* t = &tile[kr + 16 * i][n4]; t[0] = v[i][0]; t[1] = v[i][1]; t[2] = v[i][2]; t[3] = v[i][3]; }
        const int e = le0 + item / 384, t = item % 384;
        const bool gu = t < 256; const int l = gu ? t : t - 256;
        bf16_t* dst = (gu ? wguT + (size_t)e * 2048 * 1024 : wdnT + (size_t)e * 1024 * 1024) + (size_t)((l >> 4) * 128 + n) * 1024 + (l & 15) * 64 + k16;
        if (item + G < total) issue(item + G);
        lds_barrier();
        u32x4 o0, o1;
        o0.x = cvt_pk_bf16(tile[k16 + 0][n], tile[k16 + 1][n]); o0.y = cvt_pk_bf16(tile[k16 + 2][n], tile[k16 + 3][n]);
        o0.z = cvt_pk_bf16(tile[k16 + 4][n], tile[k16 + 5][n]); o0.w = cvt_pk_bf16(tile[k16 + 6][n], tile[k16 + 7][n]);
        o1.x = cvt_pk_bf16(tile[k16 + 8][n], tile[k16 + 9][n]); o1.y = cvt_pk_bf16(tile[k16 + 10][n], tile[k16 + 11][n]);
        o1.z = cvt_pk_bf16(tile[k16 + 12][n], tile[k16 + 13][n]); o1.w = cvt_pk_bf16(tile[k16 + 14][n], tile[k16 + 15][n]);
        *(u32x4*)dst = o0; *(u32x4*)(dst + 8) = o1;
    }
    __syncthreads();
}

__device__ __forceinline__ int lds_byte(int r, int c) { const int st = (r >> 4) * 2 + (c >> 5), rr = r & 15, cc = c & 31, ob = rr * 64 + cc * 2; return st * 1024 + (ob ^ (((ob >> 9) & 1) << 5)); }
__device__ __forceinline__ void stage_rc(int b, int& R, int& C) { const int st = b / 1024, sb = b % 1024, swz = sb ^ (((sb >> 9) & 1) << 5); R = (st >> 1) * 16 + swz / 64; C = (st & 1) * 32 + (swz % 64) / 2; }

#define G_HT (128 * 64)
#define G_SA(b, h) (shm + ((b) * 2 + (h)) * G_HT)
#define G_SB(b, h) (shm + (4 + (b) * 2 + (h)) * G_HT)
#define G_GLDS(src, dst) __builtin_amdgcn_global_load_lds((const unsigned*)(src), (unsigned*)(dst), 16, 0, 0)
#define G_STAGE_A(P, h, kt) do { G_GLDS(Ab + (size_t)(unsigned)((h ? a10 : a00) + (unsigned)(kt) * 128u), (char*)(P) + tb); G_GLDS(Ab + (size_t)(unsigned)((h ? a11 : a01) + (unsigned)(kt) * 128u), (char*)(P) + tb + 8192); } while (0)
#define G_STAGE_B(P, h, kt) do { G_GLDS(Bb + (size_t)(unsigned)(bofs + (unsigned)((h) * (128 * 2048)) + (unsigned)(kt) * 128u), (char*)(P) + tb); G_GLDS(Bb + (size_t)(unsigned)(bofs + (unsigned)((h) * (128 * 2048) + 64 * 2048) + (unsigned)(kt) * 128u), (char*)(P) + tb + 8192); } while (0)
#define G_LDA(dst, b, h) for (int m = 0; m < 4; ++m) for (int k = 0; k < 2; ++k) dst[m][k] = *reinterpret_cast<const bf16x8*>((char*)G_SA(b, h) + lds_byte(wr * 64 + m * 16 + fr, k * 32 + fq * 8))
#define G_LDB(dst, b, h) for (int n = 0; n < 2; ++n) for (int k = 0; k < 2; ++k) dst[n][k] = *reinterpret_cast<const bf16x8*>((char*)G_SB(b, h) + lds_byte(wc * 32 + n * 16 + fr, k * 32 + fq * 8))
#define G_MMA(ai, bj, At_, Bt_) do { __builtin_amdgcn_s_setprio(1); \
    for (int m = 0; m < 4; ++m) for (int n = 0; n < 2; ++n) for (int k = 0; k < 2; ++k) \
        acc[ai][bj][m][n] = __builtin_amdgcn_mfma_f32_16x16x32_bf16(Bt_[n][k], At_[m][k], acc[ai][bj][m][n], 0, 0, 0); \
    __builtin_amdgcn_s_setprio(0); } while (0)
#define G_WAIT_V(n) asm volatile("s_waitcnt vmcnt(" #n ")" ::: "memory")
#define G_WAIT_L(n) asm volatile("s_waitcnt lgkmcnt(" #n ")" ::: "memory")
#define G_BAR __builtin_amdgcn_s_barrier()
#define G_SCHED __builtin_amdgcn_sched_barrier(0)

#define G_STAGE_AX(P, X0, X1, kt) do { G_GLDS(Ab + (size_t)(unsigned)((X0) + (unsigned)(kt) * 128u), (char*)(P) + tb); G_GLDS(Ab + (size_t)(unsigned)((X1) + (unsigned)(kt) * 128u), (char*)(P) + tb + 8192); } while (0)
#define G_STAGE_BX(P, XB, h, kt) do { G_GLDS(Bb + (size_t)(unsigned)((XB) + (unsigned)((h) * (128 * 2048)) + (unsigned)(kt) * 128u), (char*)(P) + tb); G_GLDS(Bb + (size_t)(unsigned)((XB) + (unsigned)((h) * (128 * 2048) + 64 * 2048) + (unsigned)(kt) * 128u), (char*)(P) + tb + 8192); } while (0)
template <class Sched>
__device__ __forceinline__ void gemm_stream(const bf16_t* __restrict__ A, const bf16_t* __restrict__ Bt, const Sched& S) {
    typename Sched::U cur, nxt;
    if (!S.get(0, cur)) return;
    bf16_t* shm = (bf16_t*)g_shm;
    const int tid = tid_fresh();
    const int tb = tid * 16;
    int R0, C0; stage_rc(tb, R0, C0);
    const char* Ab = (const char*)A; const char* Bb = (const char*)Bt;
    unsigned a00, a01, a10, a11, bofs;
    S.addrs(cur, R0, C0, a00, a01, a10, a11, bofs);
    const int wid = tid >> 6, lane = tid & 63, wr = wid >> 2, wc = wid & 3, fr = lane & 15, fq = lane >> 4;
    bf16x8 At[4][2], B0[2][2], B1[2][2];
    constexpr int nt = 16;
    G_STAGE_BX(G_SB(0, 0), bofs, 0, 0); G_STAGE_AX(G_SA(0, 0), a00, a01, 0);
    G_STAGE_BX(G_SB(0, 1), bofs, 1, 0); G_STAGE_AX(G_SA(0, 1), a10, a11, 0);
    if (wr == 1) G_BAR;
    G_WAIT_V(4); G_BAR;
    G_STAGE_BX(G_SB(1, 0), bofs, 0, 1); G_STAGE_AX(G_SA(1, 0), a00, a01, 1); G_STAGE_BX(G_SB(1, 1), bofs, 1, 1);
    G_WAIT_V(6); G_BAR;
    bool more = true;
    for (int ui = 0; more; ++ui) {
        more = S.get(ui + 1, nxt);
        unsigned n00 = a00, n01 = a01, n10 = a10, n11 = a11, nb = bofs;
        if (more) S.addrs(nxt, R0, C0, n00, n01, n10, n11, nb);
        f32x4 acc[2][2][4][2] = {};
        for (int t = 0; t < nt; t += 2) {
            const bool last = (t == nt - 2);
            const unsigned s00 = last ? n00 : a00, s01 = last ? n01 : a01, s10 = last ? n10 : a10, s11 = last ? n11 : a11, sb = last ? nb : bofs;
            const int k2 = last ? 0 : t + 2, k3 = last ? 1 : t + 3;
            G_LDB(B0, 0, 0); G_SCHED; G_LDA(At, 0, 0); G_STAGE_AX(G_SA(1, 1), a10, a11, t + 1);
            G_WAIT_L(8); G_BAR; G_WAIT_L(0); G_MMA(0, 0, At, B0); G_BAR; G_SCHED;
            G_LDB(B1, 0, 1); G_STAGE_BX(G_SB(0, 0), sb, 0, k2);
            G_BAR; G_WAIT_L(0); G_MMA(0, 1, At, B1); G_BAR;
            G_LDA(At, 0, 1); G_STAGE_AX(G_SA(0, 0), s00, s01, k2);
            G_BAR; G_WAIT_L(0); G_MMA(1, 0, At, B0); G_BAR; G_SCHED;
            G_STAGE_BX(G_SB(0, 1), sb, 1, k2);
            G_WAIT_V(6); G_BAR; G_MMA(1, 1, At, B1); G_BAR;
            G_LDB(B0, 1, 0); G_SCHED; G_LDA(At, 1, 0); G_STAGE_AX(G_SA(0, 1), s10, s11, k2);
            G_WAIT_L(8); G_BAR; G_WAIT_L(0); G_MMA(0, 0, At, B0); G_BAR; G_SCHED;
            G_LDB(B1, 1, 1); G_STAGE_BX(G_SB(1, 0), sb, 0, k3);
            G_BAR; G_WAIT_L(0); G_MMA(0, 1, At, B1); G_BAR;
            G_LDA(At, 1, 1); G_STAGE_AX(G_SA(1, 0), s00, s01, k3);
            G_BAR; G_WAIT_L(0); G_MMA(1, 0, At, B0); G_BAR; G_SCHED;
            G_STAGE_BX(G_SB(1, 1), sb, 1, k3);
            G_WAIT_V(6); G_BAR; G_MMA(1, 1, At, B1); G_BAR;
        }
        S.epi(cur, acc, wr, wc, fr, fq);
        cur = nxt; a00 = n00; a01 = n01; a10 = n10; a11 = n11; bofs = nb;
    }
    G_WAIT_V(0);
    if (wr == 0) G_BAR;
}

__device__ __forceinline__ bool dense_unit(int i, int nM, int nN, int& pm, int& pn) {
    const int G = gridDim.x, c = blockIdx.x;
    const int v = (G % 8 == 0) ? ((c % 8) * (G / 8) + c / 8) : c;
    const long L = (long)i * G + v;
    const int nwg = nM * nN;
    if (L >= nwg) return false;
    const int wgid = (int)L;
    const int nig = 16 * nN, gid = wgid / nig, fm = gid * 16, gsz = (nM - fm) < 16 ? (nM - fm) : 16;
    pm = fm + ((wgid % nig) % gsz); pn = (wgid % nig) / gsz;
    return true;
}
struct UDense { int pm, pn; };
template <class Derived> struct DenseBase {
    typedef UDense U;
    int nM, nN, row_base;
    __device__ __forceinline__ bool get(int i, U& u) const { return dense_unit(i, nM, nN, u.pm, u.pn); }
    __device__ __forceinline__ void addrs(const U& u, int R0, int C0, unsigned& a00, unsigned& a01, unsigned& a10, unsigned& a11, unsigned& bofs) const {
        const unsigned r = (unsigned)(row_base + u.pm * 256 + R0);
        a00 = (r * 1024u + C0) * 2u; a01 = a00 + 64u * 2048u; a10 = a00 + 128u * 2048u; a11 = a00 + 192u * 2048u;
        bofs = ((unsigned)(u.pn * 256 + R0) * 1024u + C0) * 2u;
    }
};
struct SchedBf16 : DenseBase<SchedBf16> {
    bf16_t* C; int ldc, N;
    __device__ __forceinline__ void epi(const UDense& u, const f32x4 (&acc)[2][2][4][2], int wr, int wc, int fr, int fq) const {
        const int row0 = row_base + u.pm * 256, col0 = u.pn * 256;
#pragma unroll
        for (int ai = 0; ai < 2; ++ai)
#pragma unroll
            for (int m = 0; m < 4; ++m) {
                bf16_t* rowp = C + (size_t)(row0 + ai * 128 + wr * 64 + m * 16 + fr) * ldc;
#pragma unroll
                for (int bj = 0; bj < 2; ++bj) {
                    const int c = col0 + bj * 128 + wc * 32 + fq * 8;
                    const f32x4 x = acc[ai][bj][m][0], y = acc[ai][bj][m][1];
                    if (c < N) st_bf16x8(rowp + c, x[0], x[1], x[2], x[3], y[0], y[1], y[2], y[3]);
                }
            }
    }
};
struct SchedResid : DenseBase<SchedResid> {
    const float* src_ctx; const float* src_lat; const float* gate; float* H;
    __device__ __forceinline__ void epi(const UDense& u, const f32x4 (&acc)[2][2][4][2], int wr, int wc, int fr, int fq) const {
        const int row0 = row_base + u.pm * 256, col0 = u.pn * 256;
#pragma unroll
        for (int ai = 0; ai < 2; ++ai)
#pragma unroll
            for (int m = 0; m < 4; ++m) {
                const int r = row0 + ai * 128 + wr * 64 + m * 16 + fr;
                const float* sp = r < NCTX ? src_ctx + (size_t)r * DM : src_lat + (size_t)(r - NCTX) * DM;
                const float* gp = gate + (size_t)(r < NCTX ? 4 : (r - NCTX) / TL) * 6144;
                float* hp = H + (size_t)r * DM;
#pragma unroll
                for (int bj = 0; bj < 2; ++bj)
#pragma unroll
                    for (int n = 0; n < 2; ++n) {
                        const int c = col0 + bj * 128 + wc * 32 + n * 16 + fq * 4;
                        const f32x4 x = *(const f32x4*)(sp + c), g = *(const f32x4*)(gp + c);
                        *(f32x4*)(hp + c) = x + g * acc[ai][bj][m][n];
                    }
            }
    }
};
__device__ __forceinline__ void ph_gemm_bf16out(const bf16_t* A, int row_base, int M, const bf16_t* Bt, int N, int Npad, bf16_t* C, int ldc) {
    SchedBf16 S; S.nM = M / 256; S.nN = Npad / 256; S.row_base = row_base; S.C = C; S.ldc = ldc; S.N = N;
    gemm_stream(A, Bt, S);
}
__device__ __forceinline__ void ph_gemm_resid(const bf16_t* A, int row_base, int M, const bf16_t* Bt, const float* src_ctx, const float* src_lat, const float* gate, float* H) {
    SchedResid S; S.nM = M / 256; S.nN = 4; S.row_base = row_base; S.src_ctx = src_ctx; S.src_lat = src_lat; S.gate = gate; S.H = H;
    gemm_stream(A, Bt, S);
}

struct UMoe { int e, pm, pn, off; };
__device__ __forceinline__ void moe_table(const int* __restrict__ meta, int nN) {
    int* TAB = (int*)(g_shm + LDS_TAB);
    __syncthreads();
    if (threadIdx.x == 0) {
        int us = 0;
        for (int x = 0; x < NEXP; ++x) { const int nrt = (meta[x] + 255) >> 8; TAB[x] = us; TAB[32 + x] = nrt; TAB[64 + x] = meta[64 + x]; us += nrt * nN; }
        TAB[96] = us;
    }
    __syncthreads();
}
__device__ __forceinline__ bool moe_unit(int i, int nN, UMoe& u) {
    const int* TAB = (const int*)(g_shm + LDS_TAB);
    const int G = gridDim.x, c = blockIdx.x;
    const int v = (G % 8 == 0) ? ((c % 8) * (G / 8) + c / 8) : c;
    const int L = i * G + v;
    if (L >= TAB[96]) return false;
    int x = 0;
#pragma unroll
    for (int st = 16; st > 0; st >>= 1) if (TAB[x + st] <= L) x += st;
    const int wgid = L - TAB[x], nrt = TAB[32 + x];
    const int nig = 8 * nN, gid = wgid / nig, fm = gid * 8, gsz = (nrt - fm) < 8 ? (nrt - fm) : 8;
    u.e = x; u.off = TAB[64 + x]; u.pm = fm + ((wgid % nig) % gsz); u.pn = (wgid % nig) / gsz;
    return true;
}
struct SchedGU {
    typedef UMoe U;
    const int* meta; const int* list; const float* bgu; bf16_t* act;
    __device__ __forceinline__ bool get(int i, U& u) const { return moe_unit(i, 8, u); }
    __device__ __forceinline__ void addrs(const U& u, int R0, int C0, unsigned& a00, unsigned& a01, unsigned& a10, unsigned& a11, unsigned& bofs) const {
        const int* lp = list + u.off + u.pm * 256 + R0;
        a00 = ((unsigned)lp[0] * 1024u + C0) * 2u; a01 = ((unsigned)lp[64] * 1024u + C0) * 2u; a10 = ((unsigned)lp[128] * 1024u + C0) * 2u; a11 = ((unsigned)lp[192] * 1024u + C0) * 2u;
        bofs = ((unsigned)(u.e * 2048 + u.pn * 256 + R0) * 1024u + C0) * 2u;
    }
    __device__ __forceinline__ void epi(const U& u, const f32x4 (&acc)[2][2][4][2], int wr, int wc, int fr, int fq) const {
        const int s0 = u.off + u.pm * 256;
        const float* bg_ = bgu + (size_t)u.e * 2048;
        const int ch = u.pn * 128 + wc * 32 + fq * 8;
        const f32x4 bg0 = *(const f32x4*)(bg_ + ch), bg1 = *(const f32x4*)(bg_ + ch + 4), bl0 = *(const f32x4*)(bg_ + 1024 + ch), bl1 = *(const f32x4*)(bg_ + 1024 + ch + 4);
#pragma unroll
        for (int ai = 0; ai < 2; ++ai)
#pragma unroll
            for (int m = 0; m < 4; ++m) {
                const int slot = s0 + ai * 128 + wr * 64 + m * 16 + fr;
                float o[8];
#pragma unroll
                for (int n = 0; n < 2; ++n)
#pragma unroll
                    for (int j = 0; j < 4; ++j) {
                        float g = acc[ai][0][m][n][j] + (n ? bg1[j] : bg0[j]), l = acc[ai][1][m][n][j] + (n ? bl1[j] : bl0[j]);
                        g = fminf(g, 7.0f); l = fminf(fmaxf(l, -7.0f), 7.0f);
                        o[n * 4 + j] = g * frcp_(1.0f + __expf(-1.702f * g)) * (l + 1.0f);
                    }
                st_bf16x8(act + (size_t)slot * 1024 + ch, o[0], o[1], o[2], o[3], o[4], o[5], o[6], o[7]);
            }
    }
};
struct SchedDN {
    typedef UMoe U;
    const int* meta; const float* bdn; bf16_t* ys; const float* slot_w;
    __device__ __forceinline__ bool get(int i, U& u) const { return moe_unit(i, 4, u); }
    __device__ __forceinline__ void addrs(const U& u, int R0, int C0, unsigned& a00, unsigned& a01, unsigned& a10, unsigned& a11, unsigned& bofs) const {
        const unsigned r = (unsigned)(u.off + u.pm * 256 + R0);
        a00 = (r * 1024u + C0) * 2u; a01 = a00 + 64u * 2048u; a10 = a00 + 128u * 2048u; a11 = a00 + 192u * 2048u;
        bofs = ((unsigned)(u.e * 1024 + u.pn * 256 + R0) * 1024u + C0) * 2u;
    }
    __device__ __forceinline__ void epi(const U& u, const f32x4 (&acc)[2][2][4][2], int wr, int wc, int fr, int fq) const {
        const int s0 = u.off + u.pm * 256, col0 = u.pn * 256;
        const float* bd_ = bdn + (size_t)u.e * 1024;
#pragma unroll
        for (int bj = 0; bj < 2; ++bj) {
            const int c = col0 + bj * 128 + wc * 32 + fq * 8;
            const f32x4 b0 = *(const f32x4*)(bd_ + c), b1 = *(const f32x4*)(bd_ + c + 4);
#pragma unroll
            for (int ai = 0; ai < 2; ++ai)
#pragma unroll
                for (int m = 0; m < 4; ++m) {
                    const int slot = s0 + ai * 128 + wr * 64 + m * 16 + fr;
                    const float w = slot_w[slot];
                    const f32x4 x = (acc[ai][bj][m][0] + b0) * w, y = (acc[ai][bj][m][1] + b1) * w;
                    st_bf16x8(ys + (size_t)slot * 1024 + c, x[0], x[1], x[2], x[3], y[0], y[1], y[2], y[3]);
                }
        }
    }
};
__device__ __forceinline__ void ph_moe_gu(const bf16_t* V, const int* meta, const int* list, const bf16_t* WguT, const float* bgu, bf16_t* act) {
    SchedGU S; S.meta = meta; S.list = list; S.bgu = bgu; S.act = act;
    moe_table(meta, 8);
    gemm_stream(V, WguT, S);
}
__device__ __forceinline__ void ph_moe_dn(const bf16_t* act, const int* meta, const bf16_t* WdnT, const float* bdn, bf16_t* ys, const float* slot_w) {
    SchedDN S; S.meta = meta; S.bdn = bdn; S.ys = ys; S.slot_w = slot_w;
    moe_table(meta, 4);
    gemm_stream(act, WdnT, S);
}

#define NCHUNK 528
#define REC 8320
#define LP 72
__device__ __forceinline__ size_t rec_off(int type, int dir, int h, int g) { return ((size_t)(((type * 2 + dir) * 4 + h) * NCHUNK + g)) * REC; }
__device__ __forceinline__ int chunk_g(int b, int dir, int s) {
    if (s < 4) return b * 4 + (dir ? 3 - s : s);
    const int s2 = s - 4; return 16 + b * 128 + (dir ? 127 - s2 : s2);
}
__device__ __forceinline__ float wave_incl_prefix(float v, int lane) {
#pragma unroll
    for (int o = 1; o < 64; o <<= 1) { const float t = __shfl_up(v, o); if (lane >= o) v += t; }
    return v;
}
__device__ __forceinline__ float wave_incl_suffix(float v, int lane) {
#pragma unroll
    for (int o = 1; o < 64; o <<= 1) { const float t = __shfl_down(v, o); if (lane + o < 64) v += t; }
    return v;
}
__device__ __forceinline__ float wave_prefix_max(float v, int lane) {
#pragma unroll
    for (int o = 1; o < 64; o <<= 1) { const float t = __shfl_up(v, o); if (lane >= o) v = fmaxf(v, t); }
    return v;
}
__device__ __forceinline__ float wave_suffix_max(float v, int lane) {
#pragma unroll
    for (int o = 1; o < 64; o <<= 1) { const float t = __shfl_down(v, o); if (lane + o < 64) v = fmaxf(v, t); }
    return v;
}
__device__ __forceinline__ float wave_max(float v) {
#pragma unroll
    for (int o = 32; o > 0; o >>= 1) v = fmaxf(v, __shfl_xor(v, o));
    return v;
}
__device__ __forceinline__ bf16x8 lds_frag(const bf16_t* base, int row, int kofs) { return *(const bf16x8*)(base + row * LP + kofs); }
__device__ __forceinline__ bf16_t f2bf(float x) { return (bf16_t)(cvt_pk_bf16(x, 0.f) & 0xffffu); }

struct L0Args {
    const bf16_t* z;
    const float* ml_conv; const float* gate_b; const float* ret_decay; const float* ret_norm; const float* ml_norm;
    bf16_t* RQ; bf16_t* RK; bf16_t* MQ; bf16_t* MK;
    float* LIF;
    bf16_t* ST;
    float* CM;
    float* MI;
    bf16_t* MG;
};

__device__ __forceinline__ void ph_l0_prep(const L0Args& a) {
    const int tfz = tid_fresh(); const int wid = tfz >> 6, lane = tfz & 63;
    for (int r = blockIdx.x * 8 + wid; r < NTOK; r += gridDim.x * 8) {
        const RowInfo ri = row_info(r);
        const bf16_t* zc = a.z + (size_t)r * AB_IN;
        {
            const int h = lane >> 4, hf = (lane >> 3) & 1, j0 = (lane & 7) * 4;
            const f32x4 q1 = ldz4(zc + h * 64 + j0), q2 = ldz4(zc + h * 64 + 32 + j0);
            const f32x4 k1 = ldz4(zc + 256 + h * 64 + j0), k2 = ldz4(zc + 256 + h * 64 + 32 + j0);
            f32x4 qo, ko;
            if (r >= NCTX) {
#pragma unroll
                for (int x = 0; x < 4; ++x) {
                    const int j = j0 + x;
                    const float pos = (j < 16) ? (float)(ri.t >> 6) : (float)(ri.t & 63);
                    const float inv = exp2f(-(float)(j & 15) * 0.83048202372184059f);
                    const float ang = pos * inv;
                    const float cs = __cosf(ang), sn = __sinf(ang);
                    qo[x] = hf ? (q1[x] * sn + q2[x] * cs) : (q1[x] * cs - q2[x] * sn);
                    ko[x] = hf ? (k1[x] * sn + k2[x] * cs) : (k1[x] * cs - k2[x] * sn);
                }
            } else { qo = hf ? q2 : q1; ko = hf ? k2 : k1; }
            const int d0 = h * 64 + hf * 32 + j0;
            st_bf16x4(a.RQ + (size_t)r * 256 + d0, qo[0], qo[1], qo[2], qo[3]);
            st_bf16x4(a.RK + (size_t)r * 256 + d0, ko[0] * 0.125f, ko[1] * 0.125f, ko[2] * 0.125f, ko[3] * 0.125f);
        }
#pragma unroll
        for (int rep = 0; rep < 2; ++rep) {
            const int ch = rep * 256 + lane * 4;
            f32x4 cv = ldz4(zc + 1536 + ch) * *(const f32x4*)(a.ml_conv + 512 + ch);
            if (ri.t > 0) cv += ldz4(zc + 1536 + ch - AB_IN) * *(const f32x4*)(a.ml_conv + ch);
            if (ri.t < ri.len - 1) cv += ldz4(zc + 1536 + ch + AB_IN) * *(const f32x4*)(a.ml_conv + 1024 + ch);
            float o[4];
#pragma unroll
            for (int x = 0; x < 4; ++x) o[x] = cv[x] * frcp_(1.0f + __expf(-cv[x])) * (rep == 0 ? 0.125f : 1.0f);
            st_bf16x4((rep == 0 ? a.MQ : a.MK) + (size_t)r * 256 + lane * 4, o[0], o[1], o[2], o[3]);
        }
        if (lane < 16) {
            const float val = ldz(zc + 3072 + lane) + a.gate_b[lane];
            const int d = lane >> 3, gi = (lane >> 2) & 1, h = lane & 3;
            a.LIF[(size_t)r * 16 + gi * 8 + d * 4 + h] = gi ? logsigmoidf_(val) : val;
        }
    }
}

__device__ __forceinline__ void ph_l0_local(const L0Args& a) {
    bf16_t* KT = (bf16_t*)g_shm;
    bf16_t* VT = (bf16_t*)(g_shm + 4 * 64 * LP * 2);
    float* SC = (float*)(g_shm + 4 * 64 * LP * 2 + 2 * 128 * LP * 2);
    const int tid = tid_fresh(), wid = tid >> 6, lane = tid & 63, fr = lane & 15, fq = lane >> 4;
    const int kd = tid & 63, jg = tid >> 6, dv = tid & 127, vg = tid >> 7;
    bf16_t pk[2][8], pv[2][16]; float pli = 0.f, plf = 0.f;
    auto prefetch = [&](int it) {
        const int g = it >> 2, h = it & 3, row0 = g * 64;
#pragma unroll
        for (int ty = 0; ty < 2; ++ty) {
            const bf16_t* src = (ty ? a.MK : a.RK) + (size_t)(row0 + jg * 8) * 256 + h * 64 + kd;
#pragma unroll
            for (int x = 0; x < 8; ++x) pk[ty][x] = src[(size_t)x * 256];
            const bf16_t* sv = a.z + (size_t)(row0 + vg * 16) * AB_IN + (ty ? 2048 : 512) + h * 128 + dv;
#pragma unroll
            for (int x = 0; x < 16; ++x) pv[ty][x] = sv[(size_t)x * AB_IN];
        }
        if (wid == 1 || wid == 2) { const int dir = wid - 1; pli = a.LIF[(size_t)(row0 + lane) * 16 + dir * 4 + h]; plf = a.LIF[(size_t)(row0 + lane) * 16 + 8 + dir * 4 + h]; }
    };
    if ((int)blockIdx.x < NCHUNK * 4) prefetch(blockIdx.x);
    for (int it = blockIdx.x; it < NCHUNK * 4; it += gridDim.x) {
        const int g = it >> 2, h = it & 3;
        __syncthreads();
        if (wid == 0) {
            const float l2f = log2f(1.0f - expf(a.ret_decay[h])), l2b = log2f(1.0f - expf(a.ret_decay[4 + h]));
            SC[lane] = exp2f((float)(63 - lane) * l2f);
            SC[64 + lane] = exp2f((float)lane * l2b);
        } else if (wid == 1 || wid == 2) {
            const int dir = wid - 1;
            const float bc = dir ? wave_incl_suffix(plf, lane) : wave_incl_prefix(plf, lane);
            const float btot = __shfl(bc, dir ? 0 : 63);
            const float lw = btot - bc + pli;
            const float mloc = wave_max(lw);
            SC[(2 + dir) * 64 + lane] = fexp_(lw - mloc);
            if (lane == 0) { float* cm = a.CM + ((size_t)(dir * 4 + h) * NCHUNK + g) * 2; cm[0] = btot; cm[1] = mloc; }
        }
        __syncthreads();
#pragma unroll
        for (int ty = 0; ty < 2; ++ty) {
#pragma unroll
            for (int dir = 0; dir < 2; ++dir) {
                const float* sc = SC + (ty * 2 + dir) * 64 + jg * 8;
                u32x4 o;
                o.x = cvt_pk_bf16(bf16_to_f32(pk[ty][0]) * sc[0], bf16_to_f32(pk[ty][1]) * sc[1]); o.y = cvt_pk_bf16(bf16_to_f32(pk[ty][2]) * sc[2], bf16_to_f32(pk[ty][3]) * sc[3]);
                o.z = cvt_pk_bf16(bf16_to_f32(pk[ty][4]) * sc[4], bf16_to_f32(pk[ty][5]) * sc[5]); o.w = cvt_pk_bf16(bf16_to_f32(pk[ty][6]) * sc[6], bf16_to_f32(pk[ty][7]) * sc[7]);
                *(u32x4*)(KT + (ty * 2 + dir) * 64 * LP + (((kd >> 2) & 3) * 16 + (kd >> 4) * 4 + (kd & 3)) * LP + jg * 8) = o;
            }
            u32x4 o0, o1;
            o0.x = (unsigned)pv[ty][0] | ((unsigned)pv[ty][1] << 16); o0.y = (unsigned)pv[ty][2] | ((unsigned)pv[ty][3] << 16);
            o0.z = (unsigned)pv[ty][4] | ((unsigned)pv[ty][5] << 16); o0.w = (unsigned)pv[ty][6] | ((unsigned)pv[ty][7] << 16);
            o1.x = (unsigned)pv[ty][8] | ((unsigned)pv[ty][9] << 16); o1.y = (unsigned)pv[ty][10] | ((unsigned)pv[ty][11] << 16);
            o1.z = (unsigned)pv[ty][12] | ((unsigned)pv[ty][13] << 16); o1.w = (unsigned)pv[ty][14] | ((unsigned)pv[ty][15] << 16);
            *(u32x4*)(VT + ty * 128 * LP + dv * LP + vg * 16) = o0;
            *(u32x4*)(VT + ty * 128 * LP + dv * LP + vg * 16 + 8) = o1;
        }
        if (it + (int)gridDim.x < NCHUNK * 4) prefetch(it + gridDim.x);
        __syncthreads();
#pragma unroll
        for (int ty = 0; ty < 2; ++ty) {
            const bf16x8 v0 = lds_frag(VT + ty * 128 * LP, wid * 16 + fr, fq * 8), v1 = lds_frag(VT + ty * 128 * LP, wid * 16 + fr, 32 + fq * 8);
#pragma unroll
            for (int dir = 0; dir < 2; ++dir) {
                const bf16_t* kt = KT + (ty * 2 + dir) * 64 * LP;
                bf16_t* st = a.ST + rec_off(ty, dir, h, g) + (size_t)(wid * 16 + fr) * 64 + fq * 16;
#pragma unroll
                for (int dp = 0; dp < 2; ++dp) {
                    f32x4 acc0 = {0.f, 0.f, 0.f, 0.f}, acc1 = {0.f, 0.f, 0.f, 0.f};
                    acc0 = __builtin_amdgcn_mfma_f32_16x16x32_bf16(lds_frag(kt, (2 * dp) * 16 + fr, fq * 8), v0, acc0, 0, 0, 0);
                    acc0 = __builtin_amdgcn_mfma_f32_16x16x32_bf16(lds_frag(kt, (2 * dp) * 16 + fr, 32 + fq * 8), v1, acc0, 0, 0, 0);
                    acc1 = __builtin_amdgcn_mfma_f32_16x16x32_bf16(lds_frag(kt, (2 * dp + 1) * 16 + fr, fq * 8), v0, acc1, 0, 0, 0);
                    acc1 = __builtin_amdgcn_mfma_f32_16x16x32_bf16(lds_frag(kt, (2 * dp + 1) * 16 + fr, 32 + fq * 8), v1, acc1, 0, 0, 0);
                    st_bf16x8(st + dp * 8, acc0[0], acc0[1], acc0[2], acc0[3], acc1[0], acc1[1], acc1[2], acc1[3]);
                }
            }
        }
        if (tid < 128) {
            const int dir = tid >> 6, d = tid & 63;
            const bf16_t* kt = KT + (2 + dir) * 64 * LP + (((d >> 2) & 3) * 16 + (d >> 4) * 4 + (d & 3)) * LP;
            float sum = 0.f;
#pragma unroll 16
            for (int j = 0; j < 64; ++j) sum += bf16_to_f32(kt[j]);
            ((float*)(a.ST + rec_off(1, dir, h, g) + 8192))[d] = sum;
        }
    }
}

__device__ __forceinline__ void ph_l0_prop(const L0Args& a) {
    for (int idx = blockIdx.x * NTHR + tid_fresh(); idx < 64 * 2048; idx += gridDim.x * NTHR) {
        const int seq = idx >> 11, e4 = idx & 2047;
        const int ty = seq >> 5, dir = (seq >> 4) & 1, h = (seq >> 2) & 3, b = seq & 3;
        const bool hasn = ty == 1 && e4 < 16;
        f32x4 S = {0.f, 0.f, 0.f, 0.f}, Sn = {0.f, 0.f, 0.f, 0.f};
        float m = 0.f;
        const float g64 = exp2f(64.0f * log2f(1.0f - expf(a.ret_decay[dir * 4 + h])));
        for (int s0 = 0; s0 < 132; s0 += 12) {
            f32x4 loc[12], locn[12]; float bt[12], ml[12];
#pragma unroll
            for (int i = 0; i < 12; ++i) {
                const int g = chunk_g(b, dir, s0 + i);
                bf16_t* rp = a.ST + rec_off(ty, dir, h, g);
                loc[i] = ldz4(rp + (size_t)e4 * 4);
                locn[i] = (f32x4){0.f, 0.f, 0.f, 0.f};
                if (hasn) locn[i] = *(const f32x4*)((const float*)(rp + 8192) + e4 * 4);
                if (ty == 1) { const float* cm = a.CM + ((size_t)(dir * 4 + h) * NCHUNK + g) * 2; bt[i] = cm[0]; ml[i] = cm[1]; } else { bt[i] = 0.f; ml[i] = 0.f; }
            }
#pragma unroll
            for (int i = 0; i < 12; ++i) {
                const int g = chunk_g(b, dir, s0 + i);
                float dec, wl;
                if (ty == 0) { dec = g64; wl = 1.0f; }
                else {
                    const float mn = fmaxf(bt[i] + m, ml[i]);
                    dec = expf(bt[i] + m - mn); wl = expf(ml[i] - mn);
                    if (e4 == 0) a.MI[(size_t)(dir * 4 + h) * NCHUNK + g] = m;
                    m = mn;
                }
                bf16_t* rp = a.ST + rec_off(ty, dir, h, g);
                st_bf16x4(rp + (size_t)e4 * 4, S[0], S[1], S[2], S[3]);
                if (hasn) *(f32x4*)((float*)(rp + 8192) + e4 * 4) = Sn;
                S = S * dec + loc[i] * wl;
                Sn = Sn * dec + locn[i] * wl;
            }
        }
    }
}

__device__ __forceinline__ void ph_l0_out(const L0Args& a) {
    bf16_t* Qs = (bf16_t*)g_shm;
    bf16_t* Ks = Qs + 64 * LP;
    bf16_t* ATT = Ks + 64 * LP;
    bf16_t* VT = ATT + 64 * LP;
    bf16_t* SF = VT + 128 * LP;
    bf16_t* SB = SF + 144 * LP;
    float* FV = (float*)(SB + 144 * LP);
    const int tid = tid_fresh(), wid = tid >> 6, lane = tid & 63, fr = lane & 15, fq = lane >> 4;
    u32x4 pq, pkk; bf16_t pv[16]; float pli = 0.f, plf = 0.f, pmi = 0.f;
    auto prefetch = [&](int it) {
        const int ty = it & 1, h = (it >> 1) & 3, g = it >> 3, row0 = g * 64;
        const int tp = tid_fresh();
        const int i = tp >> 3, c8 = tp & 7;
        const size_t go = (size_t)(row0 + i) * 256 + h * 64 + c8 * 8;
        pq = *(const u32x4*)((ty ? a.MQ : a.RQ) + go);
        pkk = *(const u32x4*)((ty ? a.MK : a.RK) + go);
        const int dv = tp & 127, vg = tp >> 7;
        const bf16_t* src = a.z + (size_t)(row0 + vg * 16) * AB_IN + (ty ? 2048 : 512) + h * 128 + dv;
#pragma unroll
        for (int x = 0; x < 16; ++x) pv[x] = src[(size_t)x * AB_IN];
        if (ty == 1 && tp < 128) {
            const int w2 = tp >> 6, l2 = tp & 63;
            pli = a.LIF[(size_t)(row0 + l2) * 16 + w2 * 4 + h]; plf = a.LIF[(size_t)(row0 + l2) * 16 + 8 + w2 * 4 + h];
            pmi = a.MI[(size_t)(w2 * 4 + h) * NCHUNK + g];
        }
    };
    if ((int)blockIdx.x < NCHUNK * 8) prefetch(blockIdx.x);
    for (int it = blockIdx.x; it < NCHUNK * 8; it += gridDim.x) {
        const int ty = it & 1, h = (it >> 1) & 3, g = it >> 3, row0 = g * 64;
        __syncthreads();
        {
            const int ts = tid_fresh();
            const int i = ts >> 3, c8 = ts & 7;
            *(u32x4*)(Qs + i * LP + c8 * 8) = pq;
            *(u32x4*)(Ks + i * LP + c8 * 8) = pkk;
            const int dv = ts & 127, vg = ts >> 7;
            u32x4 o0, o1;
            o0.x = (unsigned)pv[0] | ((unsigned)pv[1] << 16); o0.y = (unsigned)pv[2] | ((unsigned)pv[3] << 16); o0.z = (unsigned)pv[4] | ((unsigned)pv[5] << 16); o0.w = (unsigned)pv[6] | ((unsigned)pv[7] << 16);
            o1.x = (unsigned)pv[8] | ((unsigned)pv[9] << 16); o1.y = (unsigned)pv[10] | ((unsigned)pv[11] << 16); o1.z = (unsigned)pv[12] | ((unsigned)pv[13] << 16); o1.w = (unsigned)pv[14] | ((unsigned)pv[15] << 16);
            *(u32x4*)(VT + dv * LP + vg * 16) = o0;
            *(u32x4*)(VT + dv * LP + vg * 16 + 8) = o1;
            if (ts < 2 * 16 * 8) {
                const int dir = ts >> 7, rr = (ts >> 3) & 15, c = ts & 7;
                u32x4 o = {0u, 0u, 0u, 0u};
                if (ty == 1 && rr == 0) {
                    const float* np = (const float*)(a.ST + rec_off(1, dir, h, g) + 8192) + c * 8;
                    o.x = cvt_pk_bf16(np[0], np[1]); o.y = cvt_pk_bf16(np[2], np[3]); o.z = cvt_pk_bf16(np[4], np[5]); o.w = cvt_pk_bf16(np[6], np[7]);
                }
                *(u32x4*)((dir ? SB : SF) + (128 + rr) * LP + c * 8) = o;
            }
            if (ty == 1 && wid < 2) {
                const int dir = wid;
                const float bc = dir ? wave_incl_suffix(plf, lane) : wave_incl_prefix(plf, lane);
                const float aj = pli - bc;
                const float pm = dir ? wave_suffix_max(aj, lane) : wave_prefix_max(aj, lane);
                const float M = fmaxf(pmi, pm);
                float* fv = FV + dir * 256;
                fv[lane] = M; fv[64 + lane] = aj; fv[128 + lane] = fexp_(pmi - M); fv[192 + lane] = fexp_(-(bc + M));
            }
        }
        u32x4 ps[2][2];
        {
            const int tq = tid_fresh();
            const int sdv = tq >> 2, sd = (tq & 3) * 16;
#pragma unroll
            for (int dir = 0; dir < 2; ++dir) {
                const bf16_t* sp = a.ST + rec_off(ty, dir, h, g) + (size_t)sdv * 64 + sd;
                ps[dir][0] = *(const u32x4*)sp; ps[dir][1] = *(const u32x4*)(sp + 8);
            }
        }
        __syncthreads();
        const float l2f = (ty == 0) ? log2f(1.0f - expf(a.ret_decay[h])) : 0.f;
        const float l2b = (ty == 0) ? log2f(1.0f - expf(a.ret_decay[4 + h])) : 0.f;
        f32x4 otot[4];
#pragma unroll
        for (int x = 0; x < 4; ++x) otot[x] = (f32x4){0.f, 0.f, 0.f, 0.f};
        const int ndir = (ty == 0) ? 1 : 2;
        for (int pass = 0; pass < ndir; ++pass) {
            {
                const int itl = wid >> 1;
                const bf16x8 q0 = lds_frag(Qs, itl * 16 + fr, fq * 8), q1 = lds_frag(Qs, itl * 16 + fr, 32 + fq * 8);
                float rs = 0.f;
                const int i = itl * 16 + fr;
#pragma unroll
                for (int jj = 0; jj < 2; ++jj) {
                    const int jt = (wid & 1) * 2 + jj;
                    f32x4 acc = {0.f, 0.f, 0.f, 0.f};
                    acc = __builtin_amdgcn_mfma_f32_16x16x32_bf16(lds_frag(Ks, jt * 16 + fr, fq * 8), q0, acc, 0, 0, 0);
                    acc = __builtin_amdgcn_mfma_f32_16x16x32_bf16(lds_frag(Ks, jt * 16 + fr, 32 + fq * 8), q1, acc, 0, 0, 0);
                    float sv[4];
#pragma unroll
                    for (int r = 0; r < 4; ++r) {
                        const int j = jt * 16 + fq * 4 + r;
                        float dcy;
                        if (ty == 0) {
                            dcy = ((j <= i) ? exp2f((float)(i - j) * l2f) : 0.f) + ((j >= i) ? exp2f((float)(j - i) * l2b) : 0.f);
                        } else {
                            const float* fv = FV + pass * 256;
                            const bool ok = pass ? (j >= i) : (j <= i);
                            dcy = ok ? fexp_(fv[64 + j] - fv[i]) : 0.f;
                        }
                        sv[r] = acc[r] * dcy;
                        rs += sv[r];
                    }
                    u32x2 w; w.x = cvt_pk_bf16(sv[0], sv[1]); w.y = cvt_pk_bf16(sv[2], sv[3]);
                    *(u32x2*)(ATT + i * LP + jt * 16 + fq * 4) = w;
                }
                if (ty == 1) {
                    rs += __shfl_xor(rs, 16); rs += __shfl_xor(rs, 32);
                    if (fq == 0) FV[512 + (pass * 2 + (wid & 1)) * 64 + i] = rs;
                }
            }
            if (pass == 0) {
                const int tq = tid_fresh();
                const int sdv = tq >> 2, sd = (tq & 3) * 16;
#pragma unroll
                for (int dir = 0; dir < 2; ++dir) {
                    bf16_t* dst = (dir ? SB : SF) + sdv * LP + sd;
                    *(u32x4*)dst = ps[dir][0]; *(u32x4*)(dst + 8) = ps[dir][1];
                }
                if (it + (int)gridDim.x < NCHUNK * 8) prefetch(it + gridDim.x);
            }
            __syncthreads();
            {
                const bf16x8 v0 = lds_frag(VT, wid * 16 + fr, fq * 8), v1 = lds_frag(VT, wid * 16 + fr, 32 + fq * 8);
                const bf16_t* S1 = (ty == 0) ? SF : (pass ? SB : SF);
                const bf16x8 sf0 = lds_frag(S1, wid * 16 + fr, fq * 8), sf1 = lds_frag(S1, wid * 16 + fr, 32 + fq * 8);
                bf16x8 sb0 = sf0, sb1 = sf1;
                if (ty == 0) { sb0 = lds_frag(SB, wid * 16 + fr, fq * 8); sb1 = lds_frag(SB, wid * 16 + fr, 32 + fq * 8); }
                if (ty == 1 && wid == 0) {
                    const bf16x8 n0 = lds_frag(S1, 128 + fr, fq * 8), n1 = lds_frag(S1, 128 + fr, 32 + fq * 8);
#pragma unroll
                    for (int tt = 0; tt < 4; ++tt) {
                        f32x4 an = {0.f, 0.f, 0.f, 0.f};
                        an = __builtin_amdgcn_mfma_f32_16x16x32_bf16(n0, lds_frag(Qs, tt * 16 + fr, fq * 8), an, 0, 0, 0);
                        an = __builtin_amdgcn_mfma_f32_16x16x32_bf16(n1, lds_frag(Qs, tt * 16 + fr, 32 + fq * 8), an, 0, 0, 0);
                        if (fq == 0) FV[768 + pass * 64 + tt * 16 + fr] = an[0];
                    }
                }
                if (ty == 1) __syncthreads();
#pragma unroll
                for (int tt = 0; tt < 4; ++tt) {
                    const bf16x8 a0 = lds_frag(ATT, tt * 16 + fr, fq * 8), a1 = lds_frag(ATT, tt * 16 + fr, 32 + fq * 8);
                    const bf16x8 qq0 = lds_frag(Qs, tt * 16 + fr, fq * 8), qq1 = lds_frag(Qs, tt * 16 + fr, 32 + fq * 8);
                    f32x4 ao = {0.f, 0.f, 0.f, 0.f}, af = {0.f, 0.f, 0.f, 0.f}, ab = {0.f, 0.f, 0.f, 0.f};
                    ao = __builtin_amdgcn_mfma_f32_16x16x32_bf16(v0, a0, ao, 0, 0, 0);
                    ao = __builtin_amdgcn_mfma_f32_16x16x32_bf16(v1, a1, ao, 0, 0, 0);
                    af = __builtin_amdgcn_mfma_f32_16x16x32_bf16(sf0, qq0, af, 0, 0, 0);
                    af = __builtin_amdgcn_mfma_f32_16x16x32_bf16(sf1, qq1, af, 0, 0, 0);
                    const int i = tt * 16 + fr;
                    if (ty == 0) {
                        ab = __builtin_amdgcn_mfma_f32_16x16x32_bf16(sb0, qq0, ab, 0, 0, 0);
                        ab = __builtin_amdgcn_mfma_f32_16x16x32_bf16(sb1, qq1, ab, 0, 0, 0);
                        const float wf = exp2f((float)(i + 1) * l2f), wb = exp2f((float)(64 - i) * l2b);
                        otot[tt] += ao + af * wf + ab * wb;
                    } else {
                        const float* fv = FV + pass * 256;
                        const float wint = fv[128 + i], eden = fv[192 + i];
                        const float den = wint * FV[768 + pass * 64 + i] + FV[512 + (pass * 2) * 64 + i] + FV[512 + (pass * 2 + 1) * 64 + i];
                        const float inv = frcp_(fmaxf(fabsf(den), eden));
                        otot[tt] += (ao + af * wint) * inv;
                    }
                }
            }
            if (ty == 1) __syncthreads();
        }
        {
            float* ssw = FV + 896;
#pragma unroll
            for (int tt = 0; tt < 4; ++tt) {
                float ss = otot[tt][0] * otot[tt][0] + otot[tt][1] * otot[tt][1] + otot[tt][2] * otot[tt][2] + otot[tt][3] * otot[tt][3];
                ss += __shfl_xor(ss, 16); ss += __shfl_xor(ss, 32);
                if (fq == 0) ssw[wid * 64 + tt * 16 + fr] = ss;
            }
            __syncthreads();
            const float* nw = (ty ? a.ml_norm : a.ret_norm) + h * 128 + wid * 16 + fq * 4;
            const f32x4 nv = *(const f32x4*)nw;
#pragma unroll
            for (int tt = 0; tt < 4; ++tt) {
                const int i = tt * 16 + fr;
                float tot = 0.f;
#pragma unroll
                for (int w = 0; w < 8; ++w) tot += ssw[w * 64 + i];
                const float rsn = rsqrtf(tot * (1.0f / 128.0f) + EPSF);
                const f32x4 gz = ldz4(a.z + (size_t)(row0 + i) * AB_IN + (ty ? 2560 : 1024) + h * 128 + wid * 16 + fq * 4);
                float o[4];
#pragma unroll
                for (int r = 0; r < 4; ++r) {
                    const float gate = ty ? fsigmoid_(gz[r]) : gz[r] * fsigmoid_(gz[r]);
                    o[r] = otot[tt][r] * rsn * nv[r] * gate;
                }
                st_bf16x4(a.MG + (size_t)(row0 + i) * DM + ty * 512 + h * 128 + wid * 16 + fq * 4, o[0], o[1], o[2], o[3]);
            }
        }
    }
}


#define LP2 136
#define HREC 16384
struct L1Args {
    const bf16_t* z;
    const float* hgrn_lb; const float* hg_norm;
    bf16_t* HST;
    float* HDEC;
    bf16_t* MG;
    const float* shift; const float* w0; const float* w2; const float* a0; const float* a2; const float* g2;
    const float* kk_scale; const float* k_a; const float* r_k; const float* rw_norm;
    bf16_t* PKK; bf16_t* PV;
    float* PG;
    float* PW;
    bf16_t* PAB; bf16_t* PKE; bf16_t* PWR;
    float* PSC;
    float* PBON;
    float* RWO;
    bf16_t* WLR;
};
__device__ __forceinline__ size_t hrec_off(int dir, int h, int g) { return ((size_t)((dir * 4 + h) * NCHUNK + g)) * HREC; }
__device__ __forceinline__ bf16x8 lds_frag2(const bf16_t* base, int row, int kofs) { return *(const bf16x8*)(base + row * LP2 + kofs); }

__device__ __forceinline__ void ph_l1_local(const L1Args& a, int bi, int nb) {
    bf16_t* KD = (bf16_t*)g_shm;
    bf16_t* VT = KD + 2 * 128 * LP;
    bf16_t* RAW = VT + 128 * LP;
    const int tid = tid_fresh(), wid = tid >> 6, lane = tid & 63, fr = lane & 15, fq = lane >> 4;
    u32x4 praw[4]; bf16_t pv[16];
    auto prefetch = [&](int it) {
        const int g = it >> 2, h = it & 3, row0 = g * 64;
        const int tp = tid_fresh();
#pragma unroll
        for (int c = 0; c < 4; ++c) {
            const int idx = tp + NTHR * c, dir = idx >> 10, j = (idx >> 4) & 63, c8 = idx & 15;
            praw[c] = *(const u32x4*)(a.z + (size_t)(row0 + j) * CD_IN + 512 + dir * 512 + h * 128 + c8 * 8);
        }
        const int dv = tp & 127, vg = tp >> 7;
        const bf16_t* src = a.z + (size_t)(row0 + vg * 16) * CD_IN + 1536 + h * 128 + dv;
#pragma unroll
        for (int x = 0; x < 16; ++x) pv[x] = src[(size_t)x * CD_IN];
    };
    if (bi < NCHUNK * 4) prefetch(bi);
    for (int it = bi; it < NCHUNK * 4; it += nb) {
        const int g = it >> 2, h = it & 3;
        __syncthreads();
        {
            const int ts = tid_fresh();
#pragma unroll
            for (int c = 0; c < 4; ++c) {
                const int idx = ts + NTHR * c, dir = idx >> 10, j = (idx >> 4) & 63, c8 = idx & 15;
                *(u32x4*)(RAW + (dir * 64 + j) * 128 + c8 * 8) = praw[c];
            }
            const int dv = ts & 127, vg = ts >> 7;
            u32x4 o0, o1;
            o0.x = (unsigned)pv[0] | ((unsigned)pv[1] << 16); o0.y = (unsigned)pv[2] | ((unsigned)pv[3] << 16); o0.z = (unsigned)pv[4] | ((unsigned)pv[5] << 16); o0.w = (unsigned)pv[6] | ((unsigned)pv[7] << 16);
            o1.x = (unsigned)pv[8] | ((unsigned)pv[9] << 16); o1.y = (unsigned)pv[10] | ((unsigned)pv[11] << 16); o1.z = (unsigned)pv[12] | ((unsigned)pv[13] << 16); o1.w = (unsigned)pv[14] | ((unsigned)pv[15] << 16);
            *(u32x4*)(VT + dv * LP + vg * 16) = o0;
            *(u32x4*)(VT + dv * LP + vg * 16 + 8) = o1;
        }
        if (it + nb < NCHUNK * 4) prefetch(it + nb);
        __syncthreads();
        if (tid < 256) {
            const int dir = tid >> 7, d = tid & 127;
            const float p0 = a.hgrn_lb[h * 128 + d], p1 = a.hgrn_lb[512 + h * 128 + d];
            const float lb = 1.0f / (1.0f + expf(p0 - p1));
            const bf16_t* raw = RAW + dir * 64 * 128 + d;
            float E = 0.f;
            bf16_t* kd = KD + (dir * 128 + (((d >> 2) & 7) * 16 + (d >> 5) * 4 + (d & 3))) * LP;
#pragma unroll 8
            for (int s2 = 0; s2 < 64; ++s2) {
                const int j = dir ? s2 : 63 - s2;
                const float f = lb + (1.0f - lb) * fsigmoid_(bf16_to_f32(raw[j * 128]));
                kd[j] = f2bf((1.0f - f) * fexp_(E));
                E += flog_(f);
            }
            a.HDEC[((size_t)(dir * 4 + h) * NCHUNK + g) * 128 + d] = expf(E);
        }
        __syncthreads();
        const bf16x8 v0 = lds_frag(VT, wid * 16 + fr, fq * 8), v1 = lds_frag(VT, wid * 16 + fr, 32 + fq * 8);
#pragma unroll
        for (int dir = 0; dir < 2; ++dir) {
            bf16_t* st = a.HST + hrec_off(dir, h, g) + (size_t)(wid * 16 + fr) * 128 + fq * 32;
#pragma unroll
            for (int dp = 0; dp < 4; ++dp) {
                f32x4 acc0 = {0.f, 0.f, 0.f, 0.f}, acc1 = {0.f, 0.f, 0.f, 0.f};
                acc0 = __builtin_amdgcn_mfma_f32_16x16x32_bf16(lds_frag(KD + dir * 128 * LP, (2 * dp) * 16 + fr, fq * 8), v0, acc0, 0, 0, 0);
                acc0 = __builtin_amdgcn_mfma_f32_16x16x32_bf16(lds_frag(KD + dir * 128 * LP, (2 * dp) * 16 + fr, 32 + fq * 8), v1, acc0, 0, 0, 0);
                acc1 = __builtin_amdgcn_mfma_f32_16x16x32_bf16(lds_frag(KD + dir * 128 * LP, (2 * dp + 1) * 16 + fr, fq * 8), v0, acc1, 0, 0, 0);
                acc1 = __builtin_amdgcn_mfma_f32_16x16x32_bf16(lds_frag(KD + dir * 128 * LP, (2 * dp + 1) * 16 + fr, 32 + fq * 8), v1, acc1, 0, 0, 0);
                st_bf16x8(st + dp * 8, acc0[0], acc0[1], acc0[2], acc0[3], acc1[0], acc1[1], acc1[2], acc1[3]);
            }
        }
    }
}
__device__ __forceinline__ void ph_l1_prop(const L1Args& a, int bi, int nb) {
    for (int idx = bi * NTHR + tid_fresh(); idx < 32 * (HREC / 4); idx += nb * NTHR) {
        const int seq = idx / (HREC / 4), e4 = idx % (HREC / 4);
        const int dir = seq >> 4, h = (seq >> 2) & 3, b = seq & 3;
        const int d4 = (e4 & 31) * 4;
        f32x4 S = {0.f, 0.f, 0.f, 0.f};
        for (int s0 = 0; s0 < 132; s0 += 12) {
            f32x4 loc[12], dec[12];
#pragma unroll
            for (int i = 0; i < 12; ++i) {
                const int g = chunk_g(b, dir, s0 + i);
                loc[i] = ldz4(a.HST + hrec_off(dir, h, g) + (size_t)e4 * 4);
                dec[i] = *(const f32x4*)(a.HDEC + ((size_t)(dir * 4 + h) * NCHUNK + g) * 128 + d4);
            }
#pragma unroll
            for (int i = 0; i < 12; ++i) {
                const int g = chunk_g(b, dir, s0 + i);
                st_bf16x4(a.HST + hrec_off(dir, h, g) + (size_t)e4 * 4, S[0], S[1], S[2], S[3]);
                S = S * dec[i] + loc[i];
            }
        }
    }
}
__device__ __forceinline__ void ph_l1_out(const L1Args& a, int bi, int nb) {
    bf16_t* QA = (bf16_t*)g_shm;
    bf16_t* R2 = QA + 2 * 64 * LP2;
    bf16_t* ATT = R2 + 2 * 128 * LP2;
    bf16_t* VT = ATT + 64 * LP;
    float* ssw = (float*)(VT + 128 * LP);
    bf16_t* RAWF = R2 + 128 * LP2;
    bf16_t* RAWQ = ATT;
    const int tid = tid_fresh(), wid = tid >> 6, lane = tid & 63, fr = lane & 15, fq = lane >> 4;
    u32x4 praw[6]; bf16_t pv[16];
    auto prefetch = [&](int it) {
        const int g = it >> 2, h = it & 3, row0 = g * 64;
        const int tp = tid_fresh();
#pragma unroll
        for (int c = 0; c < 6; ++c) {
            const int idx = tp + NTHR * c, arr = idx >> 10, j = (idx >> 4) & 63, c8 = idx & 15;
            praw[c] = *(const u32x4*)(a.z + (size_t)(row0 + j) * CD_IN + (arr < 2 ? 512 + arr * 512 : 0) + h * 128 + c8 * 8);
        }
        const int dv = tp & 127, vg = tp >> 7;
        const bf16_t* src = a.z + (size_t)(row0 + vg * 16) * CD_IN + 1536 + h * 128 + dv;
#pragma unroll
        for (int x = 0; x < 16; ++x) pv[x] = src[(size_t)x * CD_IN];
    };
    if (bi < NCHUNK * 4) prefetch(bi);
    for (int it = bi; it < NCHUNK * 4; it += nb) {
        const int g = it >> 2, h = it & 3, row0 = g * 64;
        __syncthreads();
        {
            const int ts = tid_fresh();
#pragma unroll
            for (int c = 0; c < 6; ++c) {
                const int idx = ts + NTHR * c, arr = idx >> 10, j = (idx >> 4) & 63, c8 = idx & 15;
                bf16_t* dst = (arr < 2 ? RAWF + (arr * 64 + j) * 128 : RAWQ + j * 128) + c8 * 8;
                *(u32x4*)dst = praw[c];
            }
        }
        u32x4 ps[2][4];
        {
            const int tq = tid_fresh();
#pragma unroll
            for (int dir = 0; dir < 2; ++dir) {
                const bf16_t* sp = a.HST + hrec_off(dir, h, g);
#pragma unroll
                for (int c = 0; c < 4; ++c) { const int e = (c * NTHR + tq) * 8; ps[dir][c] = *(const u32x4*)(sp + e); }
            }
        }
        __syncthreads();
        if (tid < 256) {
            const int dir = tid >> 7, d = tid & 127;
            const float p0 = a.hgrn_lb[h * 128 + d], p1 = a.hgrn_lb[512 + h * 128 + d];
            const float lb = 1.0f / (1.0f + expf(p0 - p1));
            const bf16_t* rf = RAWF + dir * 64 * 128 + d;
            const bf16_t* rq = RAWQ + d;
            float B = 0.f;
#pragma unroll 8
            for (int s2 = 0; s2 < 64; ++s2) {
                const int j = dir ? 63 - s2 : s2;
                const float f = lb + (1.0f - lb) * fsigmoid_(bf16_to_f32(rf[j * 128]));
                B += flog_(f);
                QA[(dir * 64 + j) * LP2 + d] = f2bf(bf16_to_f32(rq[j * 128]) * fexp_(B));
                R2[(dir * 64 + j) * LP2 + d] = f2bf((1.0f - f) * fexp_(fminf(-B, 80.0f)));
            }
        }
        __syncthreads();
        {
            const int ts = tid_fresh();
            const int dv = ts & 127, vg = ts >> 7;
            u32x4 o0, o1;
            o0.x = (unsigned)pv[0] | ((unsigned)pv[1] << 16); o0.y = (unsigned)pv[2] | ((unsigned)pv[3] << 16); o0.z = (unsigned)pv[4] | ((unsigned)pv[5] << 16); o0.w = (unsigned)pv[6] | ((unsigned)pv[7] << 16);
            o1.x = (unsigned)pv[8] | ((unsigned)pv[9] << 16); o1.y = (unsigned)pv[10] | ((unsigned)pv[11] << 16); o1.z = (unsigned)pv[12] | ((unsigned)pv[13] << 16); o1.w = (unsigned)pv[14] | ((unsigned)pv[15] << 16);
            *(u32x4*)(VT + dv * LP + vg * 16) = o0;
            *(u32x4*)(VT + dv * LP + vg * 16 + 8) = o1;
        }
        {
            const int itl = wid >> 1, i = itl * 16 + fr;
#pragma unroll
            for (int jj = 0; jj < 2; ++jj) {
                const int jt = (wid & 1) * 2 + jj;
                f32x4 af = {0.f, 0.f, 0.f, 0.f}, ab = {0.f, 0.f, 0.f, 0.f};
#pragma unroll
                for (int ks = 0; ks < 4; ++ks) {
                    af = __builtin_amdgcn_mfma_f32_16x16x32_bf16(lds_frag2(R2, jt * 16 + fr, ks * 32 + fq * 8), lds_frag2(QA, itl * 16 + fr, ks * 32 + fq * 8), af, 0, 0, 0);
                    ab = __builtin_amdgcn_mfma_f32_16x16x32_bf16(lds_frag2(R2 + 64 * LP2, jt * 16 + fr, ks * 32 + fq * 8), lds_frag2(QA + 64 * LP2, itl * 16 + fr, ks * 32 + fq * 8), ab, 0, 0, 0);
                }
                float sv[4];
#pragma unroll
                for (int r = 0; r < 4; ++r) {
                    const int j = jt * 16 + fq * 4 + r;
                    sv[r] = ((j <= i) ? af[r] : 0.f) + ((j >= i) ? ab[r] : 0.f);
                }
                u32x2 w; w.x = cvt_pk_bf16(sv[0], sv[1]); w.y = cvt_pk_bf16(sv[2], sv[3]);
                *(u32x2*)(ATT + i * LP + jt * 16 + fq * 4) = w;
            }
        }
        __syncthreads();
        {
            const int tq = tid_fresh();
#pragma unroll
            for (int dir = 0; dir < 2; ++dir) {
#pragma unroll
                for (int c = 0; c < 4; ++c) {
                    const int e = (c * NTHR + tq) * 8;
                    const int dv = e >> 7, d = e & 127;
                    *(u32x4*)(R2 + (dir * 128 + dv) * LP2 + d) = ps[dir][c];
                }
            }
            if (it + nb < NCHUNK * 4) prefetch(it + nb);
        }
        __syncthreads();
        f32x4 o4[4];
        {
            const bf16x8 v0 = lds_frag(VT, wid * 16 + fr, fq * 8), v1 = lds_frag(VT, wid * 16 + fr, 32 + fq * 8);
#pragma unroll
            for (int tt = 0; tt < 4; ++tt) {
                f32x4 acc = {0.f, 0.f, 0.f, 0.f};
                acc = __builtin_amdgcn_mfma_f32_16x16x32_bf16(v0, lds_frag(ATT, tt * 16 + fr, fq * 8), acc, 0, 0, 0);
                acc = __builtin_amdgcn_mfma_f32_16x16x32_bf16(v1, lds_frag(ATT, tt * 16 + fr, 32 + fq * 8), acc, 0, 0, 0);
#pragma unroll
                for (int dir = 0; dir < 2; ++dir)
#pragma unroll
                    for (int ks = 0; ks < 4; ++ks)
                        acc = __builtin_amdgcn_mfma_f32_16x16x32_bf16(lds_frag2(R2 + dir * 128 * LP2, wid * 16 + fr, ks * 32 + fq * 8),
                                                                      lds_frag2(QA + dir * 64 * LP2, tt * 16 + fr, ks * 32 + fq * 8), acc, 0, 0, 0);
                o4[tt] = acc;
            }
        }
#pragma unroll
        for (int tt = 0; tt < 4; ++tt) {
            float ss = o4[tt][0] * o4[tt][0] + o4[tt][1] * o4[tt][1] + o4[tt][2] * o4[tt][2] + o4[tt][3] * o4[tt][3];
            ss += __shfl_xor(ss, 16); ss += __shfl_xor(ss, 32);
            if (fq == 0) ssw[wid * 64 + tt * 16 + fr] = ss;
        }
        __syncthreads();
        const f32x4 nv = *(const f32x4*)(a.hg_norm + h * 128 + wid * 16 + fq * 4);
#pragma unroll
        for (int tt = 0; tt < 4; ++tt) {
            const int i = tt * 16 + fr;
            float tot = 0.f;
#pragma unroll
            for (int w = 0; w < 8; ++w) tot += ssw[w * 64 + i];
            const float rsn = rsqrtf(tot * (1.0f / 128.0f) + EPSF);
            const f32x4 gz = ldz4(a.z + (size_t)(row0 + i) * CD_IN + 2048 + h * 128 + wid * 16 + fq * 4);
            st_bf16x4(a.MG + (size_t)(row0 + i) * DM + h * 128 + wid * 16 + fq * 4,
                      o4[tt][0] * rsn * nv[0] * fsigmoid_(gz[0]), o4[tt][1] * rsn * nv[1] * fsigmoid_(gz[1]),
                      o4[tt][2] * rsn * nv[2] * fsigmoid_(gz[2]), o4[tt][3] * rsn * nv[3] * fsigmoid_(gz[3]));
        }
    }
}

__device__ __forceinline__ void ph_l1_wlr(const L1Args& a) {
    const int gt = blockIdx.x * NTHR + tid_fresh(), gs = gridDim.x * NTHR;
    for (int i = gt; i < 4 * 32768 + 65536; i += gs) {
        float v;
        if (i < 4 * 32768) { const int m = i >> 15, e = i & 32767, n = e >> 6, k = e & 63; v = (m < 2 ? a.w2 : a.a2)[((size_t)(m & 1) * 64 + k) * 512 + n]; }
        else { const int e = i - 4 * 32768, n = e >> 7, k = e & 127; v = a.g2[(size_t)k * 512 + n]; }
        a.WLR[i] = f2bf(v);
    }
}
#define FP 392
__device__ __forceinline__ void ph_l1_rwprep(const L1Args& a) {
    bf16_t* F = (bf16_t*)g_shm;
    float* SH = (float*)(F + 32 * FP);
    float* PT = SH + 3 * 1920;
    const int tid = tid_fresh(), wid = tid >> 6, lane = tid & 63, fr = lane & 15, fq = lane >> 4;
    const int tt = wid & 1, hg = wid >> 1;
    __syncthreads();
    for (int i = tid; i < 3 * 1920; i += NTHR) SH[i] = a.shift[i];
    for (int i = tid; i < 512; i += NTHR) { PT[i] = a.kk_scale[i]; PT[512 + i] = a.k_a[i]; PT[1024 + i] = a.r_k[i]; }
    for (int i = tid; i < 1024; i += NTHR) { PT[1536 + i] = a.w0[i]; PT[2560 + i] = a.a0[i]; }
    constexpr int NIT = NTOK / 32;
    const int G = gridDim.x, nfull = (NIT / G) * G, rem = NIT - nfull;
    const bool split = 2 * rem <= G;
    const int nmine = (int)blockIdx.x < nfull ? (nfull / G) : 0;
    const int extra = split ? ((int)blockIdx.x < 2 * rem ? 1 : 0) : ((int)blockIdx.x < rem ? 1 : 0);
    for (int q = 0; q < nmine + extra; ++q) {
        const bool tail = q >= nmine;
        const int it = !tail ? (int)blockIdx.x + q * G : nfull + (split ? ((int)blockIdx.x >> 1) : (int)blockIdx.x);
        const int i0 = (tail && split) ? ((int)blockIdx.x & 1) * 4 : 0, i1 = (tail && split) ? i0 + 4 : 8;
        const int row0 = it * 32;
        __syncthreads();
#pragma unroll 1
        for (int jb = 0; jb < 2; ++jb) {
            u32x2 zz[3][3];
#pragma unroll
            for (int j = 0; j < 3; ++j) {
                const int idx = tid + NTHR * (jb * 3 + j), tk = idx / 96, cg = idx - tk * 96;
                const int r = row0 + tk;
                const RowInfo ri = row_info(r);
                const bf16_t* zp = a.z + (size_t)r * CD_IN + 2560 + 1536 + cg * 4;
                zz[j][0] = *(const u32x2*)(zp - (ri.t > 0 ? CD_IN : 0));
                zz[j][1] = *(const u32x2*)zp;
                zz[j][2] = *(const u32x2*)(zp + (ri.t < ri.len - 1 ? CD_IN : 0));
            }
#pragma unroll
            for (int j = 0; j < 3; ++j) {
                const int idx = tid + NTHR * (jb * 3 + j), tk = idx / 96, cg = idx - tk * 96;
                const RowInfo ri = row_info(row0 + tk);
                const float mp = ri.t > 0 ? 1.0f : 0.0f, mn = ri.t < ri.len - 1 ? 1.0f : 0.0f;
                const int ch = 1536 + cg * 4;
                float o[4];
#pragma unroll
                for (int x = 0; x < 4; ++x) {
                    const unsigned wp_ = x < 2 ? zz[j][0].x : zz[j][0].y, wc_ = x < 2 ? zz[j][1].x : zz[j][1].y, wn_ = x < 2 ? zz[j][2].x : zz[j][2].y;
                    const float pv_ = __uint_as_float((x & 1) ? (wp_ & 0xffff0000u) : (wp_ << 16)), cv_ = __uint_as_float((x & 1) ? (wc_ & 0xffff0000u) : (wc_ << 16)),
                                nv_ = __uint_as_float((x & 1) ? (wn_ & 0xffff0000u) : (wn_ << 16));
                    const float cv = SH[ch + x] * pv_ * mp + SH[1920 + ch + x] * cv_ + SH[3840 + ch + x] * nv_ * mn;
                    const float sg = frcp_(1.0f + __expf(cg < 32 ? -2.0f * cv : -cv));
                    o[x] = (cg < 32) ? (2.0f * sg - 1.0f) : ((cg < 64) ? cv : sg);
                }
                st_bf16x4(F + tk * FP + cg * 4, o[0], o[1], o[2], o[3]);
            }
        }
        __syncthreads();
        const int r = row0 + tt * 16 + fr;
        const RowInfo ri = row_info(r);
        const float mp = ri.t > 0 ? 1.0f : 0.0f, mn = ri.t < ri.len - 1 ? 1.0f : 0.0f;
        const bf16_t* zc = a.z + (size_t)r * CD_IN + 2560;
        const bf16_t* zpv = zc - (ri.t > 0 ? CD_IN : 0);
        const bf16_t* znx = zc + (ri.t < ri.len - 1 ? CD_IN : 0);
        const bf16_t* fbp = F + (tt * 16 + fr) * FP + fq * 8;
        auto conv_from = [&](const u32x2 (&zr)[3], int ch) -> f32x4 {
            f32x4 o;
#pragma unroll
            for (int x = 0; x < 4; ++x) {
                const unsigned wp_ = x < 2 ? zr[0].x : zr[0].y, wc_ = x < 2 ? zr[1].x : zr[1].y, wn_ = x < 2 ? zr[2].x : zr[2].y;
                const float pv_ = __uint_as_float((x & 1) ? (wp_ & 0xffff0000u) : (wp_ << 16)), cv_ = __uint_as_float((x & 1) ? (wc_ & 0xffff0000u) : (wc_ << 16)),
                            nv_ = __uint_as_float((x & 1) ? (wn_ & 0xffff0000u) : (wn_ << 16));
                o[x] = SH[ch + x] * pv_ * mp + SH[1920 + ch + x] * cv_ + SH[3840 + ch + x] * nv_ * mn;
            }
            return o;
        };
        bf16x8 wa[12]; u32x2 zr[3][3];
        auto issue = [&](int idx) {
            const int h = hg + 4 * (idx >> 2), nt = idx & 3;
            const int n = h * 64 + (nt >> 1) * 32 + 8 * (fr >> 2) + 4 * (nt & 1) + (fr & 3), ch = h * 64 + (nt >> 1) * 32 + 8 * fq + 4 * (nt & 1);
#pragma unroll
            for (int m = 0; m < 4; ++m)
#pragma unroll
                for (int ks = 0; ks < 2; ++ks) wa[m * 2 + ks] = *(const bf16x8*)(a.WLR + (size_t)m * 32768 + n * 64 + ks * 32 + fq * 8);
#pragma unroll
            for (int ks = 0; ks < 4; ++ks) wa[8 + ks] = *(const bf16x8*)(a.WLR + 131072 + (size_t)n * 128 + ks * 32 + fq * 8);
#pragma unroll
            for (int arr = 0; arr < 3; ++arr) {
                zr[arr][0] = *(const u32x2*)(zpv + arr * 512 + ch); zr[arr][1] = *(const u32x2*)(zc + arr * 512 + ch); zr[arr][2] = *(const u32x2*)(znx + arr * 512 + ch);
            }
        };
        issue(i0);
        float rn = 0.f, br0 = 0.f, kr0 = 0.f, br1 = 0.f, kr1 = 0.f, bonus = 0.f;
        u32x2 sv_pv = {0u, 0u}, sv_kk = {0u, 0u}, sv_ab[2] = {{0u, 0u}, {0u, 0u}}, sv_ke[2] = {{0u, 0u}, {0u, 0u}}, sv_wr[2] = {{0u, 0u}, {0u, 0u}};
#pragma unroll 1
        for (int idx = i0; idx < i1; ++idx) {
            const int h = hg + 4 * (idx >> 2), nt = idx & 3;
            const bool odd = nt & 1;
            auto emit = [&](bf16_t* dst, u32x2& stash, float x0, float x1, float x2, float x3) {
                u32x2 w; w.x = cvt_pk_bf16(x0, x1); w.y = cvt_pk_bf16(x2, x3);
                if (odd) { u32x4 q; q.x = stash.x; q.y = stash.y; q.z = w.x; q.w = w.y; *(u32x4*)(dst - 4) = q; }
                else stash = w;
            };
            if (nt == 0) {
                u32x2 zk[4][3];
#pragma unroll
                for (int q = 0; q < 4; ++q) { const int ch = 512 + h * 64 + q * 16 + fq * 4; zk[q][0] = *(const u32x2*)(zpv + ch); zk[q][1] = *(const u32x2*)(zc + ch); zk[q][2] = *(const u32x2*)(znx + ch); }
                float ssk = 0.f;
#pragma unroll
                for (int q = 0; q < 4; ++q) {
                    const int chh = h * 64 + q * 16 + fq * 4;
                    const f32x4 kq4 = conv_from(zk[q], 512 + chh) * *(const f32x4*)(PT + chh);
                    ssk += kq4[0] * kq4[0] + kq4[1] * kq4[1] + kq4[2] * kq4[2] + kq4[3] * kq4[3];
                }
                ssk += __shfl_xor(ssk, 16); ssk += __shfl_xor(ssk, 32);
                rn = rsqrtf(ssk + EPSF);
                br0 = 0.f; kr0 = 0.f; br1 = 0.f; kr1 = 0.f; bonus = 0.f;
            }
            f32x4 acc[5];
#pragma unroll
            for (int m = 0; m < 5; ++m) acc[m] = (f32x4){0.f, 0.f, 0.f, 0.f};
#pragma unroll
            for (int m = 0; m < 4; ++m)
#pragma unroll
                for (int ks = 0; ks < 2; ++ks) acc[m] = __builtin_amdgcn_mfma_f32_16x16x32_bf16(wa[m * 2 + ks], *(const bf16x8*)(fbp + (m * 2 + ks) * 32), acc[m], 0, 0, 0);
#pragma unroll
            for (int ks = 0; ks < 4; ++ks) acc[4] = __builtin_amdgcn_mfma_f32_16x16x32_bf16(wa[8 + ks], *(const bf16x8*)(fbp + (8 + ks) * 32), acc[4], 0, 0, 0);
            const int ch = h * 64 + (nt >> 1) * 32 + 8 * fq + 4 * (nt & 1);
            const f32x4 rv = conv_from(zr[0], ch), kv = conv_from(zr[1], 512 + ch), vv = conv_from(zr[2], 1024 + ch);
            if (idx + 1 < i1) issue(idx + 1);
            const f32x4 kn = kv * *(const f32x4*)(PT + ch) * rn;
            const size_t o = (size_t)r * 512 + ch;
            emit(a.PV + o, sv_pv, vv[0], vv[1], vv[2], vv[3]);
            *(f32x4*)(a.PG + o) = acc[4];
            emit(a.PKK + o, sv_kk, kn[0], kn[1], kn[2], kn[3]);
            const f32x4 kav = *(const f32x4*)(PT + 512 + ch), rkv = *(const f32x4*)(PT + 1024 + ch);
#pragma unroll
            for (int d = 0; d < 2; ++d) {
                const size_t od = (size_t)d * NTOK * 512 + o;
                const f32x4 w0v = *(const f32x4*)(PT + 1536 + d * 512 + ch), a0v = *(const f32x4*)(PT + 2560 + d * 512 + ch);
                f32x4 wv; float ab[4], ke[4], wr[4];
                float brs = 0.f, krs = 0.f;
#pragma unroll
                for (int x = 0; x < 4; ++x) {
                    const float pw = acc[d][x] + w0v[x], pa = acc[2 + d][x] + a0v[x];
                    const float sp_ = fmaxf(-pw, 0.0f) + flog_(1.0f + fexp_(-fabsf(pw)));
                    const float w = fexp_(-fexp_(-sp_ - 0.5f));
                    const float av = fsigmoid_(pa);
                    wv[x] = w;
                    ke[x] = kv[x] * (1.0f + (av - 1.0f) * kav[x]);
                    ab[x] = kn[x] * av;
                    wr[x] = w * rv[x];
                    brs += ab[x] * rv[x]; krs += ke[x] * rv[x]; bonus += rv[x] * ke[x] * rkv[x];
                }
                if (d == 0) { br0 += brs; kr0 += krs; } else { br1 += brs; kr1 += krs; }
                *(f32x4*)(a.PW + od) = wv;
                emit(a.PAB + od, sv_ab[d], ab[0], ab[1], ab[2], ab[3]);
                emit(a.PKE + od, sv_ke[d], ke[0], ke[1], ke[2], ke[3]);
                emit(a.PWR + od, sv_wr[d], wr[0], wr[1], wr[2], wr[3]);
            }
            if (nt == 3) {
#pragma unroll
                for (int o2 = 16; o2 < 64; o2 <<= 1) { br0 += __shfl_xor(br0, o2); kr0 += __shfl_xor(kr0, o2); br1 += __shfl_xor(br1, o2); kr1 += __shfl_xor(kr1, o2); bonus += __shfl_xor(bonus, o2); }
                if (fq == 0) {
                    float* sc0 = a.PSC + ((size_t)r) * 16 + h * 2; sc0[0] = br0; sc0[1] = kr0;
                    float* sc1 = a.PSC + ((size_t)NTOK + r) * 16 + h * 2; sc1[0] = br1; sc1[1] = kr1;
                    a.PBON[(size_t)r * 8 + h] = bonus;
                }
            }
        }
    }
}

#define RW_NB 32
template <int CTRL> __device__ __forceinline__ float dppf(float v) { return __int_as_float(__builtin_amdgcn_update_dpp(0, __float_as_int(v), CTRL, 0xF, 0xF, true)); }
__device__ __forceinline__ int rw_row(int b, int dir, int s) {
    if (s < TC) return b * TC + (dir ? (TC - 1 - s) : s);
    const int s2 = s - TC; return NCTX + b * TL + (dir ? (TL - 1 - s2) : s2);
}
#define RW2_STR 400
__device__ __forceinline__ void ph_l1_rwkv2(const L1Args& a, int bi, int nblk) {
    float* OUT = (float*)g_shm;
    float* BUF = OUT + 2 * RW_NB * 32;
    const int tid = tid_fresh(), wid = tid >> 6, lane = tid & 63;
    constexpr int NBT = (TC + TL) / RW_NB;
    constexpr int NPC = 53;
    typedef float f32x2 __attribute__((ext_vector_type(2)));
    for (int u = bi; u < 128; u += nblk) {
        const int seq = u >> 1, half = u & 1;
        const int dir = seq & 1, h = (seq >> 1) & 7, b = seq >> 4;
        const size_t dof = (size_t)dir * NTOK * 512;
        const int lt = tid - 256, lw = lt >> 6, ll = lt & 63;
        const int sgn = dir ? -1 : 1;
        const char* gb0 = (const char*)a.PKK;
        const int p32 = lt & 31, qa = p32 >> 3, ca = p32 & 7, s0 = lt >> 5;
        const bf16_t* arrA = qa == 0 ? a.PKK : (qa == 1 ? a.PAB + dof : (qa == 2 ? a.PKE + dof : a.PWR + dof));
        const unsigned offA = (unsigned)(size_t)((const char*)(arrA + h * 64 + ca * 8) - gb0) + (unsigned)(sgn * s0) * 1024u;
        const int dA = s0 * RW2_STR + (qa == 0 ? 0 : 64 + qa * 64) + ca * 8;
        unsigned offX = 0u, offD = 0u; int dX = 0;
        if (lw < 2) { const int c = lt & 15, s1 = lt >> 4;
            offX = (unsigned)(size_t)((const char*)(a.PW + dof + h * 64 + c * 4) - gb0) + (unsigned)(sgn * s1) * 2048u; dX = s1 * RW2_STR + 64 + c * 4; }
        else if (lw == 2) { const int c = ll & 3, s3 = ll >> 2;
            offX = (unsigned)(size_t)((const char*)(a.PV + h * 64 + half * 32 + c * 8) - gb0) + (unsigned)(sgn * s3) * 1024u; dX = s3 * RW2_STR + 320 + c * 16;
            offD = (unsigned)(size_t)((const char*)(a.PSC + (size_t)dir * NTOK * 16 + h * 2) - gb0) + (unsigned)(sgn * ll) * 64u; }
        const unsigned offF = (unsigned)((dof + (size_t)h * 64 + half * 32 + (ll & 7) * 4) * 4) + (unsigned)(sgn * (ll >> 3)) * 2048u;
        u32x4 raw[8];
        auto issue = [&](int bt) {
            const unsigned rowb = (unsigned)rw_row(b, dir, bt * RW_NB);
            const unsigned oA = offA + rowb * 1024u, stA = (unsigned)(sgn * 8) * 1024u;
#pragma unroll
            for (int j = 0; j < 4; ++j) raw[j] = *(const u32x4*)(gb0 + (size_t)(oA + (unsigned)j * stA));
            if (lw < 2) {
                const unsigned oX = offX + rowb * 2048u, stX = (unsigned)(sgn * 8) * 2048u;
#pragma unroll
                for (int j = 0; j < 4; ++j) raw[4 + j] = *(const u32x4*)(gb0 + (size_t)(oX + (unsigned)j * stX));
            } else if (lw == 2) {
                const unsigned oX = offX + rowb * 1024u, stX = (unsigned)(sgn * 16) * 1024u;
#pragma unroll
                for (int j = 0; j < 2; ++j) raw[4 + j] = *(const u32x4*)(gb0 + (size_t)(oX + (unsigned)j * stX));
                if (ll < 32) { const u32x2 t2 = *(const u32x2*)(gb0 + (size_t)(offD + rowb * 64u)); raw[6].x = t2.x; raw[6].y = t2.y; }
            }
        };
        auto cvt8 = [&](const u32x4 w, f32x4& l4, f32x4& h4) {
            l4[0] = __uint_as_float(w.x << 16); l4[1] = __uint_as_float(w.x & 0xffff0000u); l4[2] = __uint_as_float(w.y << 16); l4[3] = __uint_as_float(w.y & 0xffff0000u);
            h4[0] = __uint_as_float(w.z << 16); h4[1] = __uint_as_float(w.z & 0xffff0000u); h4[2] = __uint_as_float(w.w << 16); h4[3] = __uint_as_float(w.w & 0xffff0000u);
        };
        auto commit = [&](int bt) {
            float* bb = BUF + (bt & 1) * RW_NB * RW2_STR;
#pragma unroll
            for (int j = 0; j < 4; ++j) {
                f32x4 l4, h4; cvt8(raw[j], l4, h4);
                float* d = bb + dA + 8 * j * RW2_STR;
                *(f32x4*)d = l4; *(f32x4*)(d + 4) = h4;
            }
            if (lw < 2) {
#pragma unroll
                for (int j = 0; j < 4; ++j) *(u32x4*)(bb + dX + 8 * j * RW2_STR) = raw[4 + j];
            } else if (lw == 2) {
#pragma unroll
                for (int j = 0; j < 2; ++j) {
                    f32x4 l4, h4; cvt8(raw[4 + j], l4, h4);
                    float* d = bb + dX + 16 * j * RW2_STR;
                    *(f32x4*)d = (f32x4){l4[0], l4[1], l4[1], l4[0]}; *(f32x4*)(d + 4) = (f32x4){l4[2], l4[3], l4[3], l4[2]};
                    *(f32x4*)(d + 8) = (f32x4){h4[0], h4[1], h4[1], h4[0]}; *(f32x4*)(d + 12) = (f32x4){h4[2], h4[3], h4[3], h4[2]};
                }
                if (ll < 32) { u32x2 t2; t2.x = raw[6].x; t2.y = raw[6].y; *(u32x2*)(bb + ll * RW2_STR + 384) = t2; }
            }
        };
        auto flush = [&](int bt) {
            if (lw == 3) {
                const unsigned rowb = (unsigned)rw_row(b, dir, bt * RW_NB);
                const unsigned oF = offF + rowb * 2048u, stF = (unsigned)(sgn * 8) * 2048u;
#pragma unroll
                for (int r = 0; r < 4; ++r) {
                    const f32x4 v4 = *(const f32x4*)(OUT + (bt & 1) * RW_NB * 32 + (ll + 64 * r) * 4);
                    *(f32x4*)((char*)a.RWO + (size_t)(oF + (unsigned)r * stF)) = v4;
                }
            }
        };
        __syncthreads();
        if (wid >= 4) { issue(0); commit(0); issue(1); }
        f32x2 S0 = {0.f, 0.f}, S1 = {0.f, 0.f}, S2 = {0.f, 0.f}, S3 = {0.f, 0.f};
        const int dr = lane >> 4, l16 = lane & 15, rp = (wid & 3) * 4 + dr, hi8 = l16 >> 3;
        const int vo = 320 + rp * 4 + hi8 * 2, oo = rp * 2 + hi8;
        for (int bt = 0; bt < NBT; ++bt) {
            asm volatile("s_waitcnt lgkmcnt(0)" ::: "memory");
            __builtin_amdgcn_s_barrier();
            asm volatile("" ::: "memory");
            if (wid >= 4) {
                if (bt + 1 < NBT) commit(bt + 1);
                if (bt + 2 < NBT) issue(bt + 2);
                if (bt > 0) flush(bt - 1);
            } else {
                const float* base = BUF + (bt & 1) * RW_NB * RW2_STR;
                float* outp = OUT + (bt & 1) * RW_NB * 32 + oo;
                const float* bs = base;
                f32x4 kk4 = *(const f32x4*)(bs + l16 * 4), w4 = *(const f32x4*)(bs + 64 + l16 * 4), ab4 = *(const f32x4*)(bs + 128 + l16 * 4),
                      ke4 = *(const f32x4*)(bs + 192 + l16 * 4), wr4 = *(const f32x4*)(bs + 256 + l16 * 4);
                f32x2 v2 = *(const f32x2*)(bs + vo), sc2 = *(const f32x2*)(bs + 384);
#pragma unroll
                for (int si = 0; si < RW_NB; ++si) {
                    const float* bn = base + (si + 1 < RW_NB ? si + 1 : si) * RW2_STR;
                    const f32x4 nkk4 = *(const f32x4*)(bn + l16 * 4), nw4 = *(const f32x4*)(bn + 64 + l16 * 4), nab4 = *(const f32x4*)(bn + 128 + l16 * 4),
                                nke4 = *(const f32x4*)(bn + 192 + l16 * 4), nwr4 = *(const f32x4*)(bn + 256 + l16 * 4);
                    const f32x2 nv2 = *(const f32x2*)(bn + vo), nsc2 = *(const f32x2*)(bn + 384);
                    float o;
                    asm volatile(
                        "v_pk_mul_f32 v[236:237], %[S0], %[kkl] op_sel_hi:[1,0]\n\t"
                        "v_pk_mul_f32 v[238:239], %[S0], %[wrl] op_sel_hi:[1,0]\n\t"
                        "v_pk_fma_f32 v[236:237], %[S1], %[kkl], v[236:237] op_sel:[0,1,0]\n\t"
                        "v_pk_fma_f32 v[238:239], %[S1], %[wrl], v[238:239] op_sel:[0,1,0]\n\t"
                        "v_pk_fma_f32 v[236:237], %[S2], %[kkh], v[236:237] op_sel_hi:[1,0,1]\n\t"
                        "v_pk_fma_f32 v[238:239], %[S2], %[wrh], v[238:239] op_sel_hi:[1,0,1]\n\t"
                        "v_pk_fma_f32 v[236:237], %[S3], %[kkh], v[236:237] op_sel:[0,1,0]\n\t"
                        "v_pk_fma_f32 v[238:239], %[S3], %[wrh], v[238:239] op_sel:[0,1,0]\n\t"
                        "v_pk_mul_f32 v[244:245], %[S0], %[wl] op_sel_hi:[1,0]\n\t"
                        "v_add_f32_dpp v240, v237, v236 row_ror:8 row_mask:0xf bank_mask:0xf bound_ctrl:1\n\t"
                        "v_add_f32_dpp v242, v239, v238 row_ror:8 row_mask:0xf bank_mask:0xf bound_ctrl:1\n\t"
                        "v_pk_mul_f32 v[246:247], %[S1], %[wl] op_sel:[0,1]\n\t"
                        "v_add_f32_dpp v240, v240, v240 quad_perm:[1,0,3,2] row_mask:0xf bank_mask:0xf bound_ctrl:1\n\t"
                        "v_add_f32_dpp v242, v242, v242 quad_perm:[1,0,3,2] row_mask:0xf bank_mask:0xf bound_ctrl:1\n\t"
                        "v_pk_mul_f32 v[248:249], %[S2], %[wh] op_sel_hi:[1,0]\n\t"
                        "v_add_f32_dpp v240, v240, v240 quad_perm:[2,3,0,1] row_mask:0xf bank_mask:0xf bound_ctrl:1\n\t"
                        "v_add_f32_dpp v242, v242, v242 quad_perm:[2,3,0,1] row_mask:0xf bank_mask:0xf bound_ctrl:1\n\t"
                        "v_pk_mul_f32 v[250:251], %[S3], %[wh] op_sel:[0,1]\n\t"
                        "v_add_f32_dpp v240, v240, v240 row_half_mirror row_mask:0xf bank_mask:0xf bound_ctrl:1\n\t"
                        "v_add_f32_dpp v242, v242, v242 row_half_mirror row_mask:0xf bank_mask:0xf bound_ctrl:1\n\t"
                        "v_pk_fma_f32 v[244:245], %[v2], %[kel], v[244:245] op_sel_hi:[1,0,1]\n\t"
                        "v_mov_b32_dpp v241, v240 row_ror:8 row_mask:0xf bank_mask:0xf bound_ctrl:1\n\t"
                        "v_pk_fma_f32 v[246:247], %[v2], %[kel], v[246:247] op_sel:[0,1,0]\n\t"
                        "v_pk_fma_f32 v[248:249], %[v2], %[keh], v[248:249] op_sel_hi:[1,0,1]\n\t"
                        "v_pk_fma_f32 %[S0], v[240:241], %[abl], v[244:245] op_sel_hi:[1,0,1] neg_lo:[1,0,0] neg_hi:[1,0,0]\n\t"
                        "v_pk_fma_f32 v[250:251], %[v2], %[keh], v[250:251] op_sel:[0,1,0]\n\t"
                        "v_pk_fma_f32 %[S1], v[240:241], %[abl], v[246:247] op_sel:[0,1,0] neg_lo:[1,0,0] neg_hi:[1,0,0]\n\t"
                        "v_fma_f32 v243, -v240, %[br], v242\n\t"
                        "v_pk_fma_f32 %[S2], v[240:241], %[abh], v[248:249] op_sel_hi:[1,0,1] neg_lo:[1,0,0] neg_hi:[1,0,0]\n\t"
                        "v_fma_f32 %[o], %[vx], %[kr], v243\n\t"
                        "v_pk_fma_f32 %[S3], v[240:241], %[abh], v[250:251] op_sel:[0,1,0] neg_lo:[1,0,0] neg_hi:[1,0,0]"
                        : [S0] "+v"(S0), [S1] "+v"(S1), [S2] "+v"(S2), [S3] "+v"(S3), [o] "=&v"(o)
                        : [kkl] "v"(__builtin_shufflevector(kk4, kk4, 0, 1)), [kkh] "v"(__builtin_shufflevector(kk4, kk4, 2, 3)),
                          [wrl] "v"(__builtin_shufflevector(wr4, wr4, 0, 1)), [wrh] "v"(__builtin_shufflevector(wr4, wr4, 2, 3)),
                          [wl] "v"(__builtin_shufflevector(w4, w4, 0, 1)), [wh] "v"(__builtin_shufflevector(w4, w4, 2, 3)),
                          [abl] "v"(__builtin_shufflevector(ab4, ab4, 0, 1)), [abh] "v"(__builtin_shufflevector(ab4, ab4, 2, 3)),
                          [kel] "v"(__builtin_shufflevector(ke4, ke4, 0, 1)), [keh] "v"(__builtin_shufflevector(ke4, ke4, 2, 3)),
                          [v2] "v"(v2), [vx] "v"(v2.x), [br] "v"(sc2.x), [kr] "v"(sc2.y)
                        : "v236", "v237", "v238", "v239", "v240", "v241", "v242", "v243", "v244", "v245", "v246", "v247", "v248", "v249", "v250", "v251");
                    outp[si * 32] = o;
                    kk4 = nkk4; w4 = nw4; ab4 = nab4; ke4 = nke4; wr4 = nwr4; v2 = nv2; sc2 = nsc2;
                }
            }
        }
        __syncthreads();
        if (wid >= 4) flush(NBT - 1);
    }
}
__device__ __forceinline__ void ph_l1_rwmerge(const L1Args& a) {
    const int tid = tid_fresh(), h = tid >> 6;
    for (int r = NCTX + blockIdx.x; r < NTOK; r += gridDim.x) {
        const size_t o = (size_t)r * 512 + tid;
        const float v = a.RWO[o] + a.RWO[(size_t)NTOK * 512 + o];
        const float ss = wave_sum(v * v);
        const float nv = v * rsqrtf(ss * (1.0f / 64.0f) + EPSF) * a.rw_norm[tid];
        const float outv = (nv + a.PBON[(size_t)r * 8 + h] * bf16_to_f32(a.PV[o])) * a.PG[o];
        a.MG[(size_t)r * DM + 512 + tid] = f2bf(outv);
    }
}

struct ConvArgs { const float* ab_in; const float* ab_out; const float* cd_in; const float* cd_out; const float* wgu; const float* wdn;
                  bf16_t* ab_inT; bf16_t* ab_outT; bf16_t* cd_inT; bf16_t* cd_outT; bf16_t* wguT; bf16_t* wdnT; };


#define XB_TMO      128
#define XB_XCNT(j)  (256  + 64 * (j))
#define XB_XSUB(j)  (1280 + 64 * (j))
#define XB_XGEN(j)  (2304 + 64 * (j))
#define XB_TOP      3328
#define XB_TOPGEN   3392
#define XCD_BAR_WORDS 3456
#define XB_SPIN_CAP (1u << 18)
#define LAS __attribute__((address_space(3)))

__device__ __forceinline__ unsigned xb_ld(unsigned* p)              { return __hip_atomic_load(p, __ATOMIC_RELAXED, __HIP_MEMORY_SCOPE_AGENT); }
__device__ __forceinline__ unsigned xb_add(unsigned* p, unsigned v) { return __hip_atomic_fetch_add(p, v, __ATOMIC_RELAXED, __HIP_MEMORY_SCOPE_AGENT); }
__device__ __forceinline__ unsigned xb_xcc_id() { return (unsigned)__builtin_amdgcn_s_getreg((3 << 11) | 20) & 0xFu; }
#define XB_SPIN(cond, bar) do { unsigned _sp = 0; while (cond) { __builtin_amdgcn_s_sleep(1); \
    if ((++_sp & 255u) == 0u) { if (xb_ld(&(bar)[XB_TMO])) break; if (_sp > XB_SPIN_CAP) { atomicAdd(&(bar)[XB_TMO], 1u); break; } } } } while (0)

struct XcdBarrier {
    unsigned* bar; unsigned x;
    volatile LAS unsigned* st;
};

__device__ __forceinline__ XcdBarrier xcd_barrier_post(unsigned* bar, volatile LAS unsigned* st) {
    XcdBarrier b; b.bar = bar; b.x = xb_xcc_id(); b.st = st;
    if (threadIdx.x == 0) (void)xb_add(&bar[XB_XCNT(b.x)], 1u);
    return b;
}
__device__ __forceinline__ void xcd_barrier_complete(unsigned* bar, unsigned x, unsigned& nloc, unsigned& nx) {
    const unsigned G = gridDim.x * gridDim.y * gridDim.z;
    unsigned sum, cnt, mine, sp = 0u;
    for (;;) {
        sum = 0u; cnt = 0u; mine = 0u;
#pragma unroll
        for (unsigned j = 0; j < 16; ++j) { const unsigned c = xb_ld(&bar[XB_XCNT(j)]); sum += c; cnt += (c > 0u) ? 1u : 0u; mine = (j == x) ? c : mine; }
        if (sum == G) break;
        __builtin_amdgcn_s_sleep(1);
        if ((++sp & 255u) == 0u) { if (xb_ld(&bar[XB_TMO])) break; if (sp > XB_SPIN_CAP) { atomicAdd(&bar[XB_TMO], 1u); break; } }
    }
    nloc = mine > 0u ? mine : 1u; nx = cnt > 0u ? cnt : 1u;
}

__device__ __forceinline__ void xcd_barrier(const XcdBarrier& b) {
    asm volatile("s_waitcnt vmcnt(0)" ::: "memory");
    __syncthreads();
    if (threadIdx.x == 0) {
        unsigned* bar = b.bar;
        __builtin_amdgcn_s_waitcnt(0);
        unsigned nloc = b.st[0], nx = b.st[1];
        if (nloc == 0u) { xcd_barrier_complete(bar, b.x, nloc, nx); b.st[0] = nloc; b.st[1] = nx; }
        const unsigned old = xb_add(&bar[XB_XSUB(b.x)], 1u);
        const unsigned gen = old / nloc;
        if (old + 1u == (gen + 1u) * nloc) {
            __builtin_amdgcn_fence(__ATOMIC_RELEASE, "agent");
            asm volatile("s_waitcnt vmcnt(0)" ::: "memory");
            const unsigned og = xb_add(&bar[XB_TOP], 1u);
            const unsigned tg = og / nx;
            if (og + 1u == (tg + 1u) * nx) xb_add(&bar[XB_TOPGEN], 1u);
            else XB_SPIN(xb_ld(&bar[XB_TOPGEN]) == tg, bar);
            __builtin_amdgcn_fence(__ATOMIC_ACQUIRE, "agent");
            xb_add(&bar[XB_XGEN(b.x)], 1u);
            asm volatile("s_waitcnt vmcnt(0)" ::: "memory");
        } else {
            XB_SPIN(xb_ld(&bar[XB_XGEN(b.x)]) == gen, bar);
            __builtin_amdgcn_fence(__ATOMIC_ACQUIRE, "agent");
            asm volatile("s_waitcnt vmcnt(0)" ::: "memory");
        }
    }
    __syncthreads();
}


__device__ __forceinline__ void sub_barrier(unsigned* bar, int word, unsigned n) {
    asm volatile("s_waitcnt vmcnt(0)" ::: "memory");
    __syncthreads();
    if (threadIdx.x == 0) {
        __builtin_amdgcn_s_waitcnt(0);
        __builtin_amdgcn_fence(__ATOMIC_RELEASE, "agent");
        asm volatile("s_waitcnt vmcnt(0)" ::: "memory");
        (void)xb_add(&bar[word], 1u);
        XB_SPIN(xb_ld(&bar[word]) < n, bar);
        __builtin_amdgcn_fence(__ATOMIC_ACQUIRE, "agent");
        asm volatile("s_waitcnt vmcnt(0)" ::: "memory");
    }
    __syncthreads();
}

struct FwdParams {
    const float* x; const float* c; const float* ctx; const float* c_ctx; const float* mod_w; const float* mod_b;
    const float* norm_mix; const float* norm_ffn; const float* norm_final;
    const float* router_w; const float* router_b; const float* bgu; const float* bdn;
    float* out;
    unsigned* bar; int* meta;
    float* mvec; float* H; bf16_t* Ub; bf16_t* ZB; float* P; float* Y;
    int* top_e; float* top_w; int* slot_of; int* list;
    float* slot_w;
    bf16_t* ab_inT; bf16_t* ab_outT; bf16_t* cd_inT; bf16_t* cd_outT; bf16_t* wguT; bf16_t* wdnT;
    ConvArgs cv; L0Args l0; L1Args l1;
};
#define LIST_INTS (NTOK * 4 + NEXP * 256)

__device__ __forceinline__ void ph_mod(const FwdParams& p) {
    float* sc = (float*)g_shm;
    float* part = sc + 5 * 1024;
    const int tid = tid_fresh();
    __syncthreads();
    for (int i = tid; i < 5 * 1024; i += NTHR) { const int b = i >> 10, k = i & 1023; sc[i] = siluf_(b < 4 ? p.c[b * 1024 + k] : p.c_ctx[k]); }
    __syncthreads();
    for (int cg = blockIdx.x; cg < 256; cg += gridDim.x) {
        const int colidx0 = cg * 48, layer = colidx0 / 6144, col0 = colidx0 % 6144;
        if (tid < 384) {
            const int cl = tid % 48, kp = tid / 48;
            const float* W = p.mod_w + (size_t)layer * 1024 * 6144 + col0 + cl;
            float a0 = 0.f, a1 = 0.f, a2 = 0.f, a3 = 0.f, a4 = 0.f;
#pragma unroll 8
            for (int k = kp * 128; k < kp * 128 + 128; ++k) {
                const float w = W[(size_t)k * 6144];
                a0 += sc[k] * w; a1 += sc[1024 + k] * w; a2 += sc[2048 + k] * w; a3 += sc[3072 + k] * w; a4 += sc[4096 + k] * w;
            }
            float* pp = part + (kp * 48 + cl) * 5;
            pp[0] = a0; pp[1] = a1; pp[2] = a2; pp[3] = a3; pp[4] = a4;
        }
        __syncthreads();
        if (tid < 240) {
            const int cl = tid / 5, rr = tid % 5;
            float sum = p.mod_b[layer * 6144 + col0 + cl];
#pragma unroll
            for (int kp = 0; kp < 8; ++kp) sum += part[(kp * 48 + cl) * 5 + rr];
            p.mvec[((size_t)layer * 5 + rr) * 6144 + col0 + cl] = sum;
        }
        __syncthreads();
    }
}
__device__ __forceinline__ const float* row_src(const float* src_ctx, const float* src_lat, int r) { return r < NCTX ? src_ctx + (size_t)r * DM : src_lat + (size_t)(r - NCTX) * DM; }
__device__ __forceinline__ int row_mrow(int r) { return r < NCTX ? 4 : (r - NCTX) / TL; }
__device__ __forceinline__ void ph_normmod(const float* src_ctx, const float* src_lat, const float* gain, const float* mvl, int row0, int row1, bf16_t* out) {
    const int tfz = tid_fresh(); const int wid = tfz >> 6, lane = tfz & 63;
    const int stride = gridDim.x * 8;
    int r = row0 + blockIdx.x * 8 + wid;
    float4 x[4], xn[4];
    if (r < row1) { const float4* src = (const float4*)row_src(src_ctx, src_lat, r);
#pragma unroll
        for (int i = 0; i < 4; ++i) x[i] = src[lane + 64 * i]; }
    for (; r < row1; r += stride) {
        const int rn = r + stride;
        if (rn < row1) { const float4* src = (const float4*)row_src(src_ctx, src_lat, rn);
#pragma unroll
            for (int i = 0; i < 4; ++i) xn[i] = src[lane + 64 * i]; }
        const float* mv = mvl + (size_t)row_mrow(r) * 6144;
        float ss = 0.f;
#pragma unroll
        for (int i = 0; i < 4; ++i) ss += x[i].x * x[i].x + x[i].y * x[i].y + x[i].z * x[i].z + x[i].w * x[i].w;
        const float rs = rsqrtf(wave_sum(ss) * (1.0f / DM) + EPSF);
#pragma unroll
        for (int i = 0; i < 4; ++i) {
            const int c4 = lane + 64 * i;
            const float4 g = ((const float4*)gain)[c4], sh = ((const float4*)mv)[c4], sc = ((const float4*)(mv + 1024))[c4];
            st_bf16x4(out + (size_t)r * DM + c4 * 4, x[i].x * rs * g.x * (1.0f + sc.x) + sh.x, x[i].y * rs * g.y * (1.0f + sc.y) + sh.y,
                      x[i].z * rs * g.z * (1.0f + sc.z) + sh.z, x[i].w * rs * g.w * (1.0f + sc.w) + sh.w);
        }
#pragma unroll
        for (int i = 0; i < 4; ++i) x[i] = xn[i];
    }
}
__device__ __forceinline__ void ph_norm_router(const FwdParams& p, int layer, int row0, int row1) {
    float* RW = (float*)g_shm;
    float* lgs = RW + 1024 * 32;
    int* hist = (int*)(lgs + 8 * 32);
    const int tid = tid_fresh(), wid = tid >> 6, lane = tid & 63;
    const float* mvl = p.mvec + (size_t)layer * 5 * 6144;
    const float* gain = p.norm_ffn + layer * DM;
    const float* rw = p.router_w + (size_t)layer * 1024 * 32;
    const float* rb = p.router_b + layer * 32;
    int* meta = p.meta + layer * 128;
    __syncthreads();
    if (tid < 32) hist[tid] = 0;
    for (int i = tid; i < 1024 * 8; i += NTHR) {
        const int k = i >> 3, c8 = i & 7;
        const int i2 = k >> 5, kq = (k >> 2) & 7, c = k & 3;
        *(float4*)(RW + (32 * i2 + 8 * c + kq) * 32 + c8 * 4) = *(const float4*)(rw + k * 32 + c8 * 4);
    }
    __syncthreads();
    const int e4 = lane & 7, kq = lane >> 3;
    const int stride = gridDim.x * 8;
    int r = row0 + blockIdx.x * 8 + wid;
    float4 hn[4];
    if (r < row1) {
#pragma unroll
        for (int i = 0; i < 4; ++i) hn[i] = ((const float4*)(p.H + (size_t)r * DM))[lane + 64 * i]; }
    for (; r < row1; r += stride) {
        const float* mv = mvl + (size_t)row_mrow(r) * 6144;
        float4 hh[4]; float ss = 0.f;
#pragma unroll
        for (int i = 0; i < 4; ++i) {
            hh[i] = hn[i];
            ss += hh[i].x * hh[i].x + hh[i].y * hh[i].y + hh[i].z * hh[i].z + hh[i].w * hh[i].w;
        }
        if (r + stride < row1) {
#pragma unroll
            for (int i = 0; i < 4; ++i) hn[i] = ((const float4*)(p.H + (size_t)(r + stride) * DM))[lane + 64 * i]; }
        const float rs = rsqrtf(wave_sum(ss) * (1.0f / DM) + EPSF);
#pragma unroll
        for (int i = 0; i < 4; ++i) {
            const int c4 = lane + 64 * i;
            const float4 g = ((const float4*)gain)[c4], sh = ((const float4*)(mv + 3072))[c4], sc = ((const float4*)(mv + 4096))[c4];
            hh[i].x = hh[i].x * rs * g.x * (1.0f + sc.x) + sh.x; hh[i].y = hh[i].y * rs * g.y * (1.0f + sc.y) + sh.y;
            hh[i].z = hh[i].z * rs * g.z * (1.0f + sc.z) + sh.z; hh[i].w = hh[i].w * rs * g.w * (1.0f + sc.w) + sh.w;
            st_bf16x4(p.Ub + (size_t)r * DM + c4 * 4, hh[i].x, hh[i].y, hh[i].z, hh[i].w);
        }
        float l0 = 0.f, l1 = 0.f, l2 = 0.f, l3 = 0.f;
#pragma unroll
        for (int i2 = 0; i2 < 32; ++i2) {
            const int srcl = kq + 8 * (i2 & 7);
            const float4 hv = hh[i2 >> 3];
            const float x0 = __shfl(hv.x, srcl), x1 = __shfl(hv.y, srcl), x2 = __shfl(hv.z, srcl), x3 = __shfl(hv.w, srcl);
            const float* wp = RW + (32 * i2 + kq) * 32 + e4 * 4;
            const float4 w0 = *(const float4*)wp, w1 = *(const float4*)(wp + 8 * 32), w2 = *(const float4*)(wp + 16 * 32), w3 = *(const float4*)(wp + 24 * 32);
            l0 += x0 * w0.x + x1 * w1.x + x2 * w2.x + x3 * w3.x;
            l1 += x0 * w0.y + x1 * w1.y + x2 * w2.y + x3 * w3.y;
            l2 += x0 * w0.z + x1 * w1.z + x2 * w2.z + x3 * w3.z;
            l3 += x0 * w0.w + x1 * w1.w + x2 * w2.w + x3 * w3.w;
        }
#pragma unroll
        for (int o = 8; o < 64; o <<= 1) { l0 += __shfl_xor(l0, o); l1 += __shfl_xor(l1, o); l2 += __shfl_xor(l2, o); l3 += __shfl_xor(l3, o); }
        if (lane < 8) { float* lg = lgs + wid * 32 + e4 * 4; lg[0] = l0 + rb[e4 * 4]; lg[1] = l1 + rb[e4 * 4 + 1]; lg[2] = l2 + rb[e4 * 4 + 2]; lg[3] = l3 + rb[e4 * 4 + 3]; }
        float val = (lane < 32) ? lgs[wid * 32 + lane] : -INFINITY;
        float tv[4]; int ti[4];
#pragma unroll
        for (int k = 0; k < 4; ++k) {
            float bv = val; int bi = lane;
#pragma unroll
            for (int o = 1; o < 64; o <<= 1) {
                const float ov = __shfl_xor(bv, o); const int oi = __shfl_xor(bi, o);
                if (ov > bv || (ov == bv && oi < bi)) { bv = ov; bi = oi; }
            }
            tv[k] = bv; ti[k] = bi;
            if (lane == bi) val = -INFINITY;
        }
        const float w0 = 1.0f, w1 = expf(tv[1] - tv[0]), w2 = expf(tv[2] - tv[0]), w3 = expf(tv[3] - tv[0]);
        const float inv = 1.0f / (w0 + w1 + w2 + w3);
        if (lane == 0) {
            *(int4*)(p.top_e + (size_t)r * 4) = make_int4(ti[0], ti[1], ti[2], ti[3]);
            *(float4*)(p.top_w + (size_t)r * 4) = make_float4(w0 * inv, w1 * inv, w2 * inv, w3 * inv);
            atomicAdd(&hist[ti[0]], 1); atomicAdd(&hist[ti[1]], 1); atomicAdd(&hist[ti[2]], 1); atomicAdd(&hist[ti[3]], 1);
        }
    }
    __syncthreads();
    if (tid < 32 && hist[tid] != 0) atomicAdd(&meta[tid], hist[tid]);
}
__device__ __forceinline__ void ph_assign(const FwdParams& p, int layer, int row0, int row1) {
    int* hist = (int*)g_shm; int* base = hist + 32; int* lcur = base + 32;
    const int tid = tid_fresh();
    int* meta = p.meta + layer * 128;
    int* list = p.list + (size_t)layer * LIST_INTS;
    __syncthreads();
    if (tid < 32) { hist[tid] = 0; lcur[tid] = 0; }
    __syncthreads();
    const int npairs = (row1 - row0) * 4;
    for (int i = blockIdx.x * NTHR + tid; i < npairs; i += gridDim.x * NTHR) atomicAdd(&hist[p.top_e[(size_t)row0 * 4 + i]], 1);
    __syncthreads();
    if (tid < 32) {
        int off = 0;
        for (int e = 0; e < tid; ++e) off += (meta[e] + 255) & ~255;
        if (blockIdx.x == 0) meta[64 + tid] = off;
        base[tid] = off + (hist[tid] ? atomicAdd(&meta[32 + tid], hist[tid]) : 0);
    }
    __syncthreads();
    for (int i = blockIdx.x * NTHR + tid; i < npairs; i += gridDim.x * NTHR) {
        const int e = p.top_e[(size_t)row0 * 4 + i];
        const int slot = base[e] + atomicAdd(&lcur[e], 1);
        list[slot] = row0 + (i >> 2);
        p.slot_of[(size_t)row0 * 4 + i] = slot;
        p.slot_w[slot] = p.top_w[(size_t)row0 * 4 + i];
    }
}
template <bool FINAL>
__device__ __forceinline__ void ph_combine(const FwdParams& p, int layer, int row0, int row1) {
    const int tfz = tid_fresh(); const int wid = tfz >> 6, lane = tfz & 63;
    const float* mvl = p.mvec + (size_t)layer * 5 * 6144;
    const bf16_t* YS = (const bf16_t*)p.P;
    const int stride = gridDim.x * 8;
    int r = row0 + blockIdx.x * 8 + wid;
    int4 sl_n = make_int4(0, 0, 0, 0);
    u32x2 ya[4][4], yn[4][4]; float4 ha[4], hnx[4];
    auto load_rows = [&](int rr, const int4& sl, u32x2 (&y)[4][4], float4 (&h)[4]) {
#pragma unroll
        for (int i = 0; i < 4; ++i) {
            const int c4 = lane + 64 * i;
            y[0][i] = *(const u32x2*)(YS + (size_t)sl.x * DM + c4 * 4); y[1][i] = *(const u32x2*)(YS + (size_t)sl.y * DM + c4 * 4);
            y[2][i] = *(const u32x2*)(YS + (size_t)sl.z * DM + c4 * 4); y[3][i] = *(const u32x2*)(YS + (size_t)sl.w * DM + c4 * 4);
            h[i] = ((const float4*)(p.H + (size_t)rr * DM))[c4];
        }
    };
    if (r < row1) {
        const int4 sl0 = *(const int4*)(p.slot_of + (size_t)r * 4);
        load_rows(r, sl0, ya, ha);
        if (r + stride < row1) sl_n = *(const int4*)(p.slot_of + (size_t)(r + stride) * 4);
    }
    for (; r < row1; r += stride) {
        const int rn = r + stride;
        if (rn < row1) {
            load_rows(rn, sl_n, yn, hnx);
            if (rn + stride < row1) sl_n = *(const int4*)(p.slot_of + (size_t)(rn + stride) * 4);
        }
        const float* mv = mvl + (size_t)row_mrow(r) * 6144;
        float4 hh[4]; float ss = 0.f;
#pragma unroll
        for (int i = 0; i < 4; ++i) {
            const int c4 = lane + 64 * i;
            float ys4[4];
#pragma unroll
            for (int x = 0; x < 4; ++x) {
                float acc = 0.f;
#pragma unroll
                for (int k = 0; k < 4; ++k) { const unsigned w = x < 2 ? ya[k][i].x : ya[k][i].y; acc += __uint_as_float((x & 1) ? (w & 0xffff0000u) : (w << 16)); }
                ys4[x] = acc;
            }
            const float4 gt = ((const float4*)(mv + 5120))[c4];
            float4 h = ha[i];
            h.x += gt.x * ys4[0]; h.y += gt.y * ys4[1]; h.z += gt.z * ys4[2]; h.w += gt.w * ys4[3];
            hh[i] = h;
            if (!FINAL) ((float4*)(p.H + (size_t)r * DM))[c4] = h;
            ss += h.x * h.x + h.y * h.y + h.z * h.z + h.w * h.w;
        }
        const float rs = rsqrtf(wave_sum(ss) * (1.0f / DM) + EPSF);
        if (FINAL) {
#pragma unroll
            for (int i = 0; i < 4; ++i) {
                const int c4 = lane + 64 * i;
                const float4 g = ((const float4*)p.norm_final)[c4];
                ((float4*)(p.out + (size_t)(r - NCTX) * DM))[c4] = make_float4(hh[i].x * rs * g.x, hh[i].y * rs * g.y, hh[i].z * rs * g.z, hh[i].w * rs * g.w);
            }
        } else {
            const float* mv1 = p.mvec + (size_t)(layer + 1) * 5 * 6144 + (size_t)row_mrow(r) * 6144;
            const float* gain = p.norm_mix + (layer + 1) * DM;
#pragma unroll
            for (int i = 0; i < 4; ++i) {
                const int c4 = lane + 64 * i;
                const float4 g = ((const float4*)gain)[c4], sh = ((const float4*)mv1)[c4], sc = ((const float4*)(mv1 + 1024))[c4];
                st_bf16x4(p.Ub + (size_t)r * DM + c4 * 4, hh[i].x * rs * g.x * (1.0f + sc.x) + sh.x, hh[i].y * rs * g.y * (1.0f + sc.y) + sh.y,
                          hh[i].z * rs * g.z * (1.0f + sc.z) + sh.z, hh[i].w * rs * g.w * (1.0f + sc.w) + sh.w);
            }
        }
#pragma unroll
        for (int k = 0; k < 4; ++k)
#pragma unroll
            for (int i = 0; i < 4; ++i) ya[k][i] = yn[k][i];
#pragma unroll
        for (int i = 0; i < 4; ++i) ha[i] = hnx[i];
    }
}

__global__ void __launch_bounds__(NTHR, 2) k_fwd(FwdParams p) {
    volatile LAS unsigned* xbw = (volatile LAS unsigned*)(g_shm + LDS_BYTES - 16);
    if (threadIdx.x == 0) { xbw[0] = 0u; xbw[1] = 0u; xbw[2] = 0u; xbw[3] = 0u; }
    __syncthreads();
    XcdBarrier bar = xcd_barrier_post(p.bar, xbw);
    {
        int base = 0;
        const int bi = blockIdx.x, nb = gridDim.x;
        base = convert_matrix<2>(p.cv.ab_in, AB_IN, 3328, p.cv.ab_inT, base, bi, nb);
        base = convert_matrix<0>(p.cv.ab_out, 1024, 1024, p.cv.ab_outT, base, bi, nb);
        base = convert_matrix<2>(p.cv.cd_in, CD_IN, 4608, p.cv.cd_inT, base, bi, nb);
        base = convert_matrix<0>(p.cv.cd_out, 1024, 1024, p.cv.cd_outT, base, bi, nb);
        convert_experts(p.cv.wgu, p.cv.wdn, p.cv.wguT, p.cv.wdnT, 0, NEXP, bi, nb);
        ph_mod(p);
        ph_l1_wlr(p.l1);
    }
    xcd_barrier(bar);
    ph_normmod(p.ctx, p.x, p.norm_mix, p.mvec, 0, NTOK, p.Ub);
    xcd_barrier(bar);
    ph_gemm_bf16out(p.Ub, 0, NTOK, p.ab_inT, AB_IN, 3328, p.ZB, AB_IN);
    xcd_barrier(bar);
    ph_l0_prep(p.l0);
    xcd_barrier(bar);
    ph_l0_local(p.l0);
    xcd_barrier(bar);
    ph_l0_prop(p.l0);
    xcd_barrier(bar);
    ph_l0_out(p.l0);
    xcd_barrier(bar);
    ph_gemm_resid(p.Ub, 0, NTOK, p.ab_outT, p.ctx, p.x, p.mvec + 2048, p.H);
    xcd_barrier(bar);
    ph_norm_router(p, 0, 0, NTOK);
    xcd_barrier(bar);
    ph_assign(p, 0, 0, NTOK);
    xcd_barrier(bar);
    ph_moe_gu(p.Ub, p.meta, p.list, p.wguT, p.bgu, p.ZB);
    xcd_barrier(bar);
    ph_moe_dn(p.ZB, p.meta, p.wdnT, p.bdn, (bf16_t*)p.P, p.slot_w);
    xcd_barrier(bar);
    ph_combine<false>(p, 0, 0, NTOK);
    xcd_barrier(bar);
    ph_gemm_bf16out(p.Ub, 0, NTOK, p.cd_inT, CD_IN, 4608, p.ZB, CD_IN);
    xcd_barrier(bar);
    ph_l1_rwprep(p.l1);
    xcd_barrier(bar);
    {
        const int nrw = (int)gridDim.x >> 1;
        if ((int)blockIdx.x < nrw) ph_l1_rwkv2(p.l1, blockIdx.x, nrw);
        else {
            const int bi = (int)blockIdx.x - nrw, nb = (int)gridDim.x - nrw;
            ph_l1_local(p.l1, bi, nb);
            sub_barrier(p.bar, 0, (unsigned)nb);
            ph_l1_prop(p.l1, bi, nb);
            sub_barrier(p.bar, 64, (unsigned)nb);
            ph_l1_out(p.l1, bi, nb);
            convert_experts(p.cv.wgu, p.cv.wdn, p.cv.wguT, p.cv.wdnT, NEXP, 2 * NEXP, bi, nb);
        }
    }
    xcd_barrier(bar);
    ph_l1_rwmerge(p.l1);
    xcd_barrier(bar);
    ph_gemm_resid(p.Ub, NCTX, NLAT, p.cd_outT, p.H, p.H + (size_t)NCTX * DM, p.mvec + 5 * 6144 + 2048, p.H);
    xcd_barrier(bar);
    ph_norm_router(p, 1, NCTX, NTOK);
    xcd_barrier(bar);
    ph_assign(p, 1, NCTX, NTOK);
    xcd_barrier(bar);
    ph_moe_gu(p.Ub, p.meta + 128, p.list + LIST_INTS, p.wguT + (size_t)NEXP * 2048 * 1024, p.bgu + NEXP * 2048, p.ZB);
    xcd_barrier(bar);
    ph_moe_dn(p.ZB, p.meta + 128, p.wdnT + (size_t)NEXP * 1024 * 1024, p.bdn + NEXP * 1024, (bf16_t*)p.P, p.slot_w);
    xcd_barrier(bar);
    ph_combine<true>(p, 1, NCTX, NTOK);
}

extern "C" void kernel_launch(void* const* d_in, const int* in_sizes, int n_in, void* d_out, int out_size, void* d_ws, size_t ws_size,
                              hipStream_t stream) {
    const size_t NT1024 = (size_t)NTOK * 1024, NT512 = (size_t)NTOK * 512;
    char* wp = (char*)d_ws;
    auto carve = [&](size_t bytes) { char* q = wp; wp += (bytes + 255) & ~(size_t)255; return q; };
    const size_t CTL_BYTES = (size_t)XCD_BAR_WORDS * 4 + 256 * 4 + (size_t)2 * LIST_INTS * 4;
    char* ctl = carve(CTL_BYTES);
    unsigned* bar = (unsigned*)ctl;
    int* meta = (int*)(ctl + (size_t)XCD_BAR_WORDS * 4);
    int* list = (int*)(ctl + (size_t)XCD_BAR_WORDS * 4 + 256 * 4);
    FwdParams p{};
    p.x = (const float*)d_in[0]; p.c = (const float*)d_in[1]; p.ctx = (const float*)d_in[2]; p.c_ctx = (const float*)d_in[3];
    p.mod_w = (const float*)d_in[4]; p.mod_b = (const float*)d_in[5]; p.norm_mix = (const float*)d_in[6]; p.norm_ffn = (const float*)d_in[7];
    p.norm_final = (const float*)d_in[8];
    p.router_w = (const float*)d_in[30]; p.router_b = (const float*)d_in[31]; p.bgu = (const float*)d_in[33]; p.bdn = (const float*)d_in[35];
    p.out = (float*)d_out;
    p.bar = bar; p.meta = meta; p.list = list;
    p.mvec = (float*)carve((size_t)2 * 5 * 6144 * 4);
    p.ab_inT = (bf16_t*)carve((size_t)3328 * 1024 * 2);
    p.ab_outT = (bf16_t*)carve((size_t)1024 * 1024 * 2);
    p.cd_inT = (bf16_t*)carve((size_t)4608 * 1024 * 2);
    p.cd_outT = (bf16_t*)carve((size_t)1024 * 1024 * 2);
    p.wguT = (bf16_t*)carve((size_t)2 * NEXP * 2048 * 1024 * 2);
    p.wdnT = (bf16_t*)carve((size_t)2 * NEXP * 1024 * 1024 * 2);
    p.H = (float*)carve(NT1024 * 4);
    p.Ub = (bf16_t*)carve(NT1024 * 2);
    p.ZB = (bf16_t*)carve((size_t)NTOK * CD_IN * 2);
    const size_t P_BYTES = (size_t)805306368;
    p.P = (float*)carve(P_BYTES);
    float* O = (float*)carve(NT512 * 4 * 4);
    p.Y = O;
    p.top_e = (int*)carve((size_t)NTOK * 4 * 4);
    p.top_w = (float*)carve((size_t)NTOK * 4 * 4);
    p.slot_of = (int*)carve((size_t)NTOK * 4 * 4);
    bf16_t* WLR = (bf16_t*)carve((size_t)196608 * 2);
    p.slot_w = (float*)carve((size_t)LIST_INTS * 4);
    if ((size_t)(wp - (char*)d_ws) > ws_size) return;

    p.cv.ab_in = (const float*)d_in[9]; p.cv.ab_out = (const float*)d_in[10]; p.cv.cd_in = (const float*)d_in[16]; p.cv.cd_out = (const float*)d_in[17];
    p.cv.wgu = (const float*)d_in[32]; p.cv.wdn = (const float*)d_in[34];
    p.cv.ab_inT = p.ab_inT; p.cv.ab_outT = p.ab_outT; p.cv.cd_inT = p.cd_inT; p.cv.cd_outT = p.cd_outT; p.cv.wguT = p.wguT; p.cv.wdnT = p.wdnT;
    {
        char* pp = (char*)p.P;
        auto sub = [&](size_t bytes) { char* q = pp; pp += (bytes + 255) & ~(size_t)255; return q; };
        L0Args& a = p.l0;
        a.z = p.ZB; a.ml_conv = (const float*)d_in[13]; a.gate_b = (const float*)d_in[14]; a.ret_decay = (const float*)d_in[11];
        a.ret_norm = (const float*)d_in[12]; a.ml_norm = (const float*)d_in[15];
        a.RQ = (bf16_t*)sub((size_t)NTOK * 256 * 2); a.RK = (bf16_t*)sub((size_t)NTOK * 256 * 2);
        a.MQ = (bf16_t*)sub((size_t)NTOK * 256 * 2); a.MK = (bf16_t*)sub((size_t)NTOK * 256 * 2);
        a.LIF = (float*)sub((size_t)NTOK * 16 * 4);
        a.ST = (bf16_t*)sub((size_t)16 * NCHUNK * REC * 2);
        a.CM = (float*)sub((size_t)8 * NCHUNK * 2 * 4);
        a.MI = (float*)sub((size_t)8 * NCHUNK * 4);
        a.MG = p.Ub;
        if ((size_t)(pp - (char*)p.P) > P_BYTES) return;
    }
    {
        char* pp = (char*)p.P;
        auto sub = [&](size_t bytes) { char* q = pp; pp += (bytes + 255) & ~(size_t)255; return q; };
        L1Args& a = p.l1;
        a.z = p.ZB; a.hgrn_lb = (const float*)d_in[18]; a.hg_norm = (const float*)d_in[19];
        a.HST = (bf16_t*)sub((size_t)8 * NCHUNK * HREC * 2);
        a.HDEC = (float*)sub((size_t)8 * NCHUNK * 128 * 4);
        a.MG = p.Ub;
        a.shift = (const float*)d_in[20]; a.w0 = (const float*)d_in[21]; a.w2 = (const float*)d_in[22]; a.a0 = (const float*)d_in[23];
        a.a2 = (const float*)d_in[24]; a.g2 = (const float*)d_in[25]; a.kk_scale = (const float*)d_in[26]; a.k_a = (const float*)d_in[27];
        a.r_k = (const float*)d_in[28]; a.rw_norm = (const float*)d_in[29];
        a.PKK = (bf16_t*)sub(NT512 * 2); a.PV = (bf16_t*)sub(NT512 * 2);
        a.PG = (float*)sub(NT512 * 4);
        a.PW = (float*)sub(NT512 * 2 * 4);
        a.PAB = (bf16_t*)sub(NT512 * 2 * 2); a.PKE = (bf16_t*)sub(NT512 * 2 * 2); a.PWR = (bf16_t*)sub(NT512 * 2 * 2);
        a.PSC = (float*)sub((size_t)2 * NTOK * 16 * 4);
        a.PBON = (float*)sub((size_t)NTOK * 8 * 4);
        a.RWO = O; a.WLR = WLR;
        if ((size_t)(pp - (char*)p.P) > P_BYTES) return;
    }
    static int grid = 0;
    if (grid == 0) {
        int dev = 0, cus = 0;
        if (hipGetDevice(&dev) != hipSuccess || hipDeviceGetAttribute(&cus, hipDeviceAttributeMultiprocessorCount, dev) != hipSuccess) { grid = -1; return; }
        if (hipFuncSetAttribute((const void*)k_fwd, hipFuncAttributeMaxDynamicSharedMemorySize, LDS_BYTES) != hipSuccess) { grid = -1; return; }
        int per_cu = 0;
        if (hipOccupancyMaxActiveBlocksPerMultiprocessor(&per_cu, (const void*)k_fwd, NTHR, LDS_BYTES) != hipSuccess || per_cu < 1) { (void)hipGetLastError(); }
        grid = cus > 0 ? cus : 256;
    }
    if (grid < 0) return;
    (void)hipMemsetAsync(ctl, 0, CTL_BYTES, stream);
    k_fwd<<<grid, NTHR, LDS_BYTES, stream>>>(p);
}
```

```cpp
#include <hip/hip_runtime.h>
#include <stdint.h>
#include <stddef.h>

#define DM 1024
#define NB 4
#define TL 8192
#define TC 256
#define NCTX (NB * TC)
#define NLAT (NB * TL)
#define NTOK (NCTX + NLAT)
#define AB_IN 3088
#define CD_IN 4480
#define NEXP 32
#define EPSF 1e-6f

typedef unsigned short bf16_t;
typedef unsigned u32x2 __attribute__((ext_vector_type(2)));
typedef unsigned u32x4 __attribute__((ext_vector_type(4)));
__device__ __forceinline__ unsigned cvt_pk_bf16(float lo, float hi) { unsigned r; asm volatile("v_cvt_pk_bf16_f32 %0, %1, %2" : "=v"(r) : "v"(lo), "v"(hi)); return r; }
typedef __bf16 bf16x2_t __attribute__((ext_vector_type(2)));
typedef float f32x2_t __attribute__((ext_vector_type(2)));
__device__ __forceinline__ unsigned cvt_pk_bf16_nat(float lo, float hi) { const f32x2_t v = {lo, hi}; return __builtin_bit_cast(unsigned, __builtin_convertvector(v, bf16x2_t)); }
__device__ __forceinline__ void st_bf16x8(bf16_t* p, float a, float b, float c, float d, float e, float f, float g, float h) { u32x4 w; w.x = cvt_pk_bf16_nat(a, b); w.y = cvt_pk_bf16_nat(c, d); w.z = cvt_pk_bf16_nat(e, f); w.w = cvt_pk_bf16_nat(g, h); *(u32x4*)p = w; }
__device__ __forceinline__ void st_bf16x4(bf16_t* p, float a, float b, float c, float d) { u32x2 w; w.x = cvt_pk_bf16(a, b); w.y = cvt_pk_bf16(c, d); *(u32x2*)p = w; }
__device__ __forceinline__ float sigmoidf_(float x) { return 1.0f / (1.0f + expf(-x)); }
__device__ __forceinline__ float siluf_(float x) { return x / (1.0f + expf(-x)); }
__device__ __forceinline__ float logsigmoidf_(float x) { return fminf(x, 0.0f) - log1pf(expf(-fabsf(x))); }
__device__ __forceinline__ float softplusf_(float x) { return fmaxf(x, 0.0f) + log1pf(expf(-fabsf(x))); }

__device__ __forceinline__ float fexp_(float x) { return __expf(x); }
__device__ __forceinline__ float frcp_(float x) { return __builtin_amdgcn_rcpf(x); }
__device__ __forceinline__ float fsigmoid_(float x) { return frcp_(1.0f + __expf(-x)); }
__device__ __forceinline__ float flog_(float x) { return __logf(x); }
__device__ __forceinline__ float wave_sum(float v) {
#pragma unroll
    for (int o = 32; o > 0; o >>= 1) v += __shfl_xor(v, o);
    return v;
}
__device__ __forceinline__ float block_sum(float v, float* red) {
    v = wave_sum(v);
    const int w = threadIdx.x >> 6, nw = blockDim.x >> 6;
    __syncthreads();
    if ((threadIdx.x & 63) == 0) red[w] = v;
    __syncthreads();
    float s = 0.f;
    for (int i = 0; i < nw; ++i) s += red[i];
    return s;
}

struct RowInfo { int t, len, mrow; };
__device__ __forceinline__ RowInfo row_info(int r) {
    RowInfo ri;
    if (r < NCTX) { ri.t = r % TC; ri.len = TC; ri.mrow = 4; }
    else { const int rr = r - NCTX; ri.t = rr % TL; ri.len = TL; ri.mrow = rr / TL; }
    return ri;
}

typedef short bf16x8 __attribute__((ext_vector_type(8)));
typedef float f32x4 __attribute__((ext_vector_type(4)));
#define NTHR 512
__device__ __forceinline__ int tid_fresh() { int t = threadIdx.x; asm volatile("" : "+v"(t)); return t; }
#define LDS_BYTES 147456
#define LDS_TAB 131072
extern __shared__ __attribute__((aligned(16))) char g_shm[];

__device__ __forceinline__ float bf16_to_f32(bf16_t v) { return __uint_as_float(((unsigned)v) << 16); }
__device__ __forceinline__ float ldz(const bf16_t* p) { return bf16_to_f32(*p); }
__device__ __forceinline__ f32x4 ldz4(const bf16_t* p) { const u32x2 w = *(const u32x2*)p; f32x4 r; r[0] = __uint_as_float(w.x << 16); r[1] = __uint_as_float(w.x & 0xffff0000u); r[2] = __uint_as_float(w.y << 16); r[3] = __uint_as_float(w.y & 0xffff0000u); return r; }

template <int MODE>
__device__ __forceinline__ int src_col(int sn) {
    if (MODE == 2) { const int rho = sn & 31, nn = rho >> 4, ii = rho & 15; sn = (sn & ~31) + 8 * (ii >> 2) + 4 * nn + (ii & 3); }
    if (MODE == 1) {
        const int u = sn >> 8, within = sn & 255, bj = within >> 7, q = within & 127, rho = q & 31, nn = rho >> 4, ii = rho & 15;
        sn = (bj ? 1024 : 0) + u * 128 + (q & ~31) + 8 * (ii >> 2) + 4 * nn + (ii & 3);
    }
    return sn;
}
template <int MODE>
__device__ __forceinline__ void convert_tile(const float* __restrict__ W, int N, bf16_t* __restrict__ Wt, int n0, int k0) {
    float (*tile)[129] = (float (*)[129])g_shm;
    const int tid = tid_fresh();
    const int kr = tid >> 5, n4 = (tid & 31) * 4;
    const int sn = src_col<MODE>(n0 + n4);
    f32x4 v[4];
#pragma unroll
    for (int i = 0; i < 4; ++i) {
        v[i] = (f32x4){0.f, 0.f, 0.f, 0.f};
        if (sn < N) v[i] = *(const f32x4*)(W + (size_t)(k0 + kr + 16 * i) * N + sn);
    }
    __syncthreads();
#pragma unroll
    for (int i = 0; i < 4; ++i) { float* t = &tile[kr + 16 * i][n4]; t[0] = v[i][0]; t[1] = v[i][1]; t[2] = v[i][2]; t[3] = v[i][3]; }
    __syncthreads();
    const int n = tid >> 2, k16 = (tid & 3) * 16;
    u32x4 o0, o1;
    o0.x = cvt_pk_bf16(tile[k16 + 0][n], tile[k16 + 1][n]); o0.y = cvt_pk_bf16(tile[k16 + 2][n], tile[k16 + 3][n]);
    o0.z = cvt_pk_bf16(tile[k16 + 4][n], tile[k16 + 5][n]); o0.w = cvt_pk_bf16(tile[k16 + 6][n], tile[k16 + 7][n]);
    o1.x = cvt_pk_bf16(tile[k16 + 8][n], tile[k16 + 9][n]); o1.y = cvt_pk_bf16(tile[k16 + 10][n], tile[k16 + 11][n]);
    o1.z = cvt_pk_bf16(tile[k16 + 12][n], tile[k16 + 13][n]); o1.w = cvt_pk_bf16(tile[k16 + 14][n], tile[k16 + 15][n]);
    bf16_t* dst = Wt + (size_t)(n0 + n) * 1024 + k0 + k16;
    *(u32x4*)dst = o0; *(u32x4*)(dst + 8) = o1;
}
template <int MODE>
__device__ __forceinline__ int convert_matrix(const float* W, int N, int Npad, bf16_t* Wt, int base, int bi, int G) {
    const int ntiles = (Npad >> 7) * 16;
    for (int it = base + ((bi - base % G) + G) % G; it < base + ntiles; it += G) {
        const int l = it - base;
        convert_tile<MODE>(W, N, Wt, (l >> 4) * 128, (l & 15) * 64);
    }
    return base + ntiles;
}
__device__ __forceinline__ void lds_barrier() { asm volatile("s_waitcnt lgkmcnt(0)" ::: "memory"); __builtin_amdgcn_s_barrier(); asm volatile("" ::: "memory"); }
__device__ __forceinline__ void convert_experts(const float* __restrict__ wgu, const float* __restrict__ wdn, bf16_t* __restrict__ wguT, bf16_t* __restrict__ wdnT, int le0, int le1, int bi, int G) {
    float (*tile)[129] = (float (*)[129])g_shm;
    const int tid = tid_fresh();
    const int kr = tid >> 5, n4 = (tid & 31) * 4;
    const int n = tid >> 2, k16 = (tid & 3) * 16;
    const int total = (le1 - le0) * 384;
    f32x4 v[4];
    auto issue = [&](int item) {
        const int e = le0 + item / 384, t = item % 384;
        const bool gu = t < 256; const int l = gu ? t : t - 256;
        const int n0 = (l >> 4) * 128, k0 = (l & 15) * 64, N = gu ? 2048 : 1024;
        const float* W = gu ? wgu + (size_t)e * 1024 * 2048 : wdn + (size_t)e * 1024 * 1024;
        const int sn = gu ? src_col<1>(n0 + n4) : src_col<2>(n0 + n4);
#pragma unroll
        for (int i = 0; i < 4; ++i) v[i] = *(const f32x4*)(W + (size_t)(k0 + kr + 16 * i) * N + sn);
    };
    __syncthreads();
    int item = bi;
    if (item < total) issue(item);
    for (; item < total; item += G) {
        lds_barrier();
#pragma unroll
        for (int i = 0; i < 4; ++i) { float* t = &tile[kr + 16 * i][n4]; t[0] = v[i][0]; t[1] = v[i][1]; t[2] = v[i][2]; t[3] = v[i][3]; }
        const int e = le0 + item / 384, t = item % 384;
        const bool gu = t < 256; const int l = gu ? t : t - 256;
        bf16_t* dst = (gu ? wguT + (size_t)e * 2048 * 1024 : wdnT + (size_t)e * 1024 * 1024) + (size_t)((l >> 4) * 128 + n) * 1024 + (l & 15) * 64 + k16;
        if (item + G < total) issue(item + G);
        lds_barrier();
        u32x4 o0, o1;
        o0.x = cvt_pk_bf16(tile[k16 + 0][n], tile[k16 + 1][n]); o0.y = cvt_pk_bf16(tile[k16 + 2][n], tile[k16 + 3][n]);
        o0.z = cvt_pk_bf16(tile[k16 + 4][n], tile[k16 + 5][n]); o0.w = cvt_pk_bf16(tile[k16 + 6][n], tile[k16 + 7][n]);
        o1.x = cvt_pk_bf16(tile[k16 + 8][n], tile[k16 + 9][n]); o1.y = cvt_pk_bf16(tile[k16 + 10][n], tile[k16 + 11][n]);
        o1.z = cvt_pk_bf16(tile[k16 + 12][n], tile[k16 + 13][n]); o1.w = cvt_pk_bf16(tile[k16 + 14][n], tile[k16 + 15][n]);
        *(u32x4*)dst = o0; *(u32x4*)(dst + 8) = o1;
    }
    __syncthreads();
}

__device__ __forceinline__ int lds_byte(int r, int c) { const int st = (r >> 4) * 2 + (c >> 5), rr = r & 15, cc = c & 31, ob = rr * 64 + cc * 2; return st * 1024 + (ob ^ (((ob >> 9) & 1) << 5)); }
__device__ __forceinline__ void stage_rc(int b, int& R, int& C) { const int st = b / 1024, sb = b % 1024, swz = sb ^ (((sb >> 9) & 1) << 5); R = (st >> 1) * 16 + swz / 64; C = (st & 1) * 32 + (swz % 64) / 2; }

#define G_HT (128 * 64)
#define G_SA(b, h) (shm + ((b) * 2 + (h)) * G_HT)
#define G_SB(b, h) (shm + (4 + (b) * 2 + (h)) * G_HT)
#define G_GLDS(src, dst) __builtin_amdgcn_global_load_lds((const unsigned*)(src), (unsigned*)(dst), 16, 0, 0)
#define G_STAGE_A(P, h, kt) do { G_GLDS(Ab + (size_t)(unsigned)((h ? a10 : a00) + (unsigned)(kt) * 128u), (char*)(P) + tb); G_GLDS(Ab + (size_t)(unsigned)((h ? a11 : a01) + (unsigned)(kt) * 128u), (char*)(P) + tb + 8192); } while (0)
#define G_STAGE_B(P, h, kt) do { G_GLDS(Bb + (size_t)(unsigned)(bofs + (unsigned)((h) * (128 * 2048)) + (unsigned)(kt) * 128u), (char*)(P) + tb); G_GLDS(Bb + (size_t)(unsigned)(bofs + (unsigned)((h) * (128 * 2048) + 64 * 2048) + (unsigned)(kt) * 128u), (char*)(P) + tb + 8192); } while (0)
#define G_LDA(dst, b, h) for (int m = 0; m < 4; ++m) for (int k = 0; k < 2; ++k) dst[m][k] = *reinterpret_cast<const bf16x8*>((char*)G_SA(b, h) + lds_byte(wr * 64 + m * 16 + fr, k * 32 + fq * 8))
#define G_LDB(dst, b, h) for (int n = 0; n < 2; ++n) for (int k = 0; k < 2; ++k) dst[n][k] = *reinterpret_cast<const bf16x8*>((char*)G_SB(b, h) + lds_byte(wc * 32 + n * 16 + fr, k * 32 + fq * 8))
#define G_MMA(ai, bj, At_, Bt_) do { __builtin_amdgcn_s_setprio(1); \
    for (int m = 0; m < 4; ++m) for (int n = 0; n < 2; ++n) for (int k = 0; k < 2; ++k) \
        acc[ai][bj][m][n] = __builtin_amdgcn_mfma_f32_16x16x32_bf16(Bt_[n][k], At_[m][k], acc[ai][bj][m][n], 0, 0, 0); \
    __builtin_amdgcn_s_setprio(0); } while (0)
#define G_WAIT_V(n) asm volatile("s_waitcnt vmcnt(" #n ")" ::: "memory")
#define G_WAIT_L(n) asm volatile("s_waitcnt lgkmcnt(" #n ")" ::: "memory")
#define G_BAR __builtin_amdgcn_s_barrier()
#define G_SCHED __builtin_amdgcn_sched_barrier(0)

#define G_STAGE_AX(P, X0, X1, kt) do { G_GLDS(Ab + (size_t)(unsigned)((X0) + (unsigned)(kt) * 128u), (char*)(P) + tb); G_GLDS(Ab + (size_t)(unsigned)((X1) + (unsigned)(kt) * 128u), (char*)(P) + tb + 8192); } while (0)
#define G_STAGE_BX(P, XB, h, kt) do { G_GLDS(Bb + (size_t)(unsigned)((XB) + (unsigned)((h) * (128 * 2048)) + (unsigned)(kt) * 128u), (char*)(P) + tb); G_GLDS(Bb + (size_t)(unsigned)((XB) + (unsigned)((h) * (128 * 2048) + 64 * 2048) + (unsigned)(kt) * 128u), (char*)(P) + tb + 8192); } while (0)
template <class Sched>
__device__ __forceinline__ void gemm_stream(const bf16_t* __restrict__ A, const bf16_t* __restrict__ Bt, const Sched& S) {
    typename Sched::U cur, nxt;
    if (!S.get(0, cur)) return;
    bf16_t* shm = (bf16_t*)g_shm;
    const int tid = tid_fresh();
    const int tb = tid * 16;
    int R0, C0; stage_rc(tb, R0, C0);
    const char* Ab = (const char*)A; const char* Bb = (const char*)Bt;
    unsigned a00, a01, a10, a11, bofs;
    S.addrs(cur, R0, C0, a00, a01, a10, a11, bofs);
    const int wid = tid >> 6, lane = tid & 63, wr = wid >> 2, wc = wid & 3, fr = lane & 15, fq = lane >> 4;
    bf16x8 At[4][2], B0[2][2], B1[2][2];
    constexpr int nt = 16;
    G_STAGE_BX(G_SB(0, 0), bofs, 0, 0); G_STAGE_AX(G_SA(0, 0), a00, a01, 0);
    G_STAGE_BX(G_SB(0, 1), bofs, 1, 0); G_STAGE_AX(G_SA(0, 1), a10, a11, 0);
    if (wr == 1) G_BAR;
    G_WAIT_V(4); G_BAR;
    G_STAGE_BX(G_SB(1, 0), bofs, 0, 1); G_STAGE_AX(G_SA(1, 0), a00, a01, 1); G_STAGE_BX(G_SB(1, 1), bofs, 1, 1);
    G_WAIT_V(6); G_BAR;
    bool more = true;
    for (int ui = 0; more; ++ui) {
        more = S.get(ui + 1, nxt);
        unsigned n00 = a00, n01 = a01, n10 = a10, n11 = a11, nb = bofs;
        if (more) S.addrs(nxt, R0, C0, n00, n01, n10, n11, nb);
        f32x4 acc[2][2][4][2] = {};
        for (int t = 0; t < nt; t += 2) {
            const bool last = (t == nt - 2);
            const unsigned s00 = last ? n00 : a00, s01 = last ? n01 : a01, s10 = last ? n10 : a10, s11 = last ? n11 : a11, sb = last ? nb : bofs;
            const int k2 = last ? 0 : t + 2, k3 = last ? 1 : t + 3;
            G_LDB(B0, 0, 0); G_SCHED; G_LDA(At, 0, 0); G_STAGE_AX(G_SA(1, 1), a10, a11, t + 1);
            G_WAIT_L(8); G_BAR; G_WAIT_L(0); G_MMA(0, 0, At, B0); G_BAR; G_SCHED;
            G_LDB(B1, 0, 1); G_STAGE_BX(G_SB(0, 0), sb, 0, k2);
            G_BAR; G_WAIT_L(0); G_MMA(0, 1, At, B1); G_BAR;
            G_LDA(At, 0, 1); G_STAGE_AX(G_SA(0, 0), s00, s01, k2);
            G_BAR; G_WAIT_L(0); G_MMA(1, 0, At, B0); G_BAR; G_SCHED;
            G_STAGE_BX(G_SB(0, 1), sb, 1, k2);
            G_WAIT_V(6); G_BAR; G_MMA(1, 1, At, B1); G_BAR;
            G_LDB(B0, 1, 0); G_SCHED; G_LDA(At, 1, 0); G_STAGE_AX(G_SA(0, 1), s10, s11, k2);
            G_WAIT_L(8); G_BAR; G_WAIT_L(0); G_MMA(0, 0, At, B0); G_BAR; G_SCHED;
            G_LDB(B1, 1, 1); G_STAGE_BX(G_SB(1, 0), sb, 0, k3);
            G_BAR; G_WAIT_L(0); G_MMA(0, 1, At, B1); G_BAR;
            G_LDA(At, 1, 1); G_STAGE_AX(G_SA(1, 0), s00, s01, k3);
            G_BAR; G_WAIT_L(0); G_MMA(1, 0, At, B0); G_BAR; G_SCHED;
            G_STAGE_BX(G_SB(1, 1), sb, 1, k3);
            G_WAIT_V(6); G_BAR; G_MMA(1, 1, At, B1); G_BAR;
        }
        S.epi(cur, acc, wr, wc, fr, fq);
        cur = nxt; a00 = n00; a01 = n01; a10 = n10; a11 = n11; bofs = nb;
    }
    G_WAIT_V(0);
    if (wr == 0) G_BAR;
}

__device__ __forceinline__ bool dense_unit(int i, int nM, int nN, int& pm, int& pn) {
    const int G = gridDim.x, c = blockIdx.x;
    const int v = (G % 8 == 0) ? ((c % 8) * (G / 8) + c / 8) : c;
    const long L = (long)i * G + v;
    const int nwg = nM * nN;
    if (L >= nwg) return false;
    const int wgid = (int)L;
    const int nig = 16 * nN, gid = wgid / nig, fm = gid * 16, gsz = (nM - fm) < 16 ? (nM - fm) : 16;
    pm = fm + ((wgid % nig) % gsz); pn = (wgid % nig) / gsz;
    return true;
}
struct UDense { int pm, pn; };
template <class Derived> struct DenseBase {
    typedef UDense U;
    int nM, nN, row_base;
    __device__ __forceinline__ bool get(int i, U& u) const { return dense_unit(i, nM, nN, u.pm, u.pn); }
    __device__ __forceinline__ void addrs(const U& u, int R0, int C0, unsigned& a00, unsigned& a01, unsigned& a10, unsigned& a11, unsigned& bofs) const {
        const unsigned r = (unsigned)(row_base + u.pm * 256 + R0);
        a00 = (r * 1024u + C0) * 2u; a01 = a00 + 64u * 2048u; a10 = a00 + 128u * 2048u; a11 = a00 + 192u * 2048u;
        bofs = ((unsigned)(u.pn * 256 + R0) * 1024u + C0) * 2u;
    }
};
struct SchedBf16 : DenseBase<SchedBf16> {
    bf16_t* C; int ldc, N;
    __device__ __forceinline__ void epi(const UDense& u, const f32x4 (&acc)[2][2][4][2], int wr, int wc, int fr, int fq) const {
        const int row0 = row_base + u.pm * 256, col0 = u.pn * 256;
#pragma unroll
        for (int ai = 0; ai < 2; ++ai)
#pragma unroll
            for (int m = 0; m < 4; ++m) {
                bf16_t* rowp = C + (size_t)(row0 + ai * 128 + wr * 64 + m * 16 + fr) * ldc;
#pragma unroll
                for (int bj = 0; bj < 2; ++bj) {
                    const int c = col0 + bj * 128 + wc * 32 + fq * 8;
                    const f32x4 x = acc[ai][bj][m][0], y = acc[ai][bj][m][1];
                    if (c < N) st_bf16x8(rowp + c, x[0], x[1], x[2], x[3], y[0], y[1], y[2], y[3]);
                }
            }
    }
};
struct SchedResid : DenseBase<SchedResid> {
    const float* src_ctx; const float* src_lat; const float* gate; float* H;
    __device__ __forceinline__ void epi(const UDense& u, const f32x4 (&acc)[2][2][4][2], int wr, int wc, int fr, int fq) const {
        const int row0 = row_base + u.pm * 256, col0 = u.pn * 256;
#pragma unroll
        for (int ai = 0; ai < 2; ++ai)
#pragma unroll
            for (int m = 0; m < 4; ++m) {
                const int r = row0 + ai * 128 + wr * 64 + m * 16 + fr;
                const float* sp = r < NCTX ? src_ctx + (size_t)r * DM : src_lat + (size_t)(r - NCTX) * DM;
                const float* gp = gate + (size_t)(r < NCTX ? 4 : (r - NCTX) / TL) * 6144;
                float* hp = H + (size_t)r * DM;
#pragma unroll
                for (int bj = 0; bj < 2; ++bj)
#pragma unroll
                    for (int n = 0; n < 2; ++n) {
                        const int c = col0 + bj * 128 + wc * 32 + n * 16 + fq * 4;
                        const f32x4 x = *(const f32x4*)(sp + c), g = *(const f32x4*)(gp + c);
                        *(f32x4*)(hp + c) = x + g * acc[ai][bj][m][n];
                    }
            }
    }
};
__device__ __forceinline__ void ph_gemm_bf16out(const bf16_t* A, int row_base, int M, const bf16_t* Bt, int N, int Npad, bf16_t* C, int ldc) {
    SchedBf16 S; S.nM = M / 256; S.nN = Npad / 256; S.row_base = row_base; S.C = C; S.ldc = ldc; S.N = N;
    gemm_stream(A, Bt, S);
}
__device__ __forceinline__ void ph_gemm_resid(const bf16_t* A, int row_base, int M, const bf16_t* Bt, const float* src_ctx, const float* src_lat, const float* gate, float* H) {
    SchedResid S; S.nM = M / 256; S.nN = 4; S.row_base = row_base; S.src_ctx = src_ctx; S.src_lat = src_lat; S.gate = gate; S.H = H;
    gemm_stream(A, Bt, S);
}

struct UMoe { int e, pm, pn, off; };
__device__ __forceinline__ void moe_table(const int* __restrict__ meta, int nN) {
    int* TAB = (int*)(g_shm + LDS_TAB);
    __syncthreads();
    if (threadIdx.x == 0) {
        int us = 0;
        for (int x = 0; x < NEXP; ++x) { const int nrt = (meta[x] + 255) >> 8; TAB[x] = us; TAB[32 + x] = nrt; TAB[64 + x] = meta[64 + x]; us += nrt * nN; }
        TAB[96] = us;
    }
    __syncthreads();
}
__device__ __forceinline__ bool moe_unit(int i, int nN, UMoe& u) {
    const int* TAB = (const int*)(g_shm + LDS_TAB);
    const int G = gridDim.x, c = blockIdx.x;
    const int v = (G % 8 == 0) ? ((c % 8) * (G / 8) + c / 8) : c;
    const int L = i * G + v;
    if (L >= TAB[96]) return false;
    int x = 0;
#pragma unroll
    for (int st = 16; st > 0; st >>= 1) if (TAB[x + st] <= L) x += st;
    const int wgid = L - TAB[x], nrt = TAB[32 + x];
    const int nig = 8 * nN, gid = wgid / nig, fm = gid * 8, gsz = (nrt - fm) < 8 ? (nrt - fm) : 8;
    u.e = x; u.off = TAB[64 + x]; u.pm = fm + ((wgid % nig) % gsz); u.pn = (wgid % nig) / gsz;
    return true;
}
struct SchedGU {
    typedef UMoe U;
    const int* meta; const int* list; const float* bgu; bf16_t* act;
    __device__ __forceinline__ bool get(int i, U& u) const { return moe_unit(i, 8, u); }
    __device__ __forceinline__ void addrs(const U& u, int R0, int C0, unsigned& a00, unsigned& a01, unsigned& a10, unsigned& a11, unsigned& bofs) const {
        const int* lp = list + u.off + u.pm * 256 + R0;
        a00 = ((unsigned)lp[0] * 1024u + C0) * 2u; a01 = ((unsigned)lp[64] * 1024u + C0) * 2u; a10 = ((unsigned)lp[128] * 1024u + C0) * 2u; a11 = ((unsigned)lp[192] * 1024u + C0) * 2u;
        bofs = ((unsigned)(u.e * 2048 + u.pn * 256 + R0) * 1024u + C0) * 2u;
    }
    __device__ __forceinline__ void epi(const U& u, const f32x4 (&acc)[2][2][4][2], int wr, int wc, int fr, int fq) const {
        const int s0 = u.off + u.pm * 256;
        const float* bg_ = bgu + (size_t)u.e * 2048;
        const int ch = u.pn * 128 + wc * 32 + fq * 8;
        const f32x4 bg0 = *(const f32x4*)(bg_ + ch), bg1 = *(const f32x4*)(bg_ + ch + 4), bl0 = *(const f32x4*)(bg_ + 1024 + ch), bl1 = *(const f32x4*)(bg_ + 1024 + ch + 4);
#pragma unroll
        for (int ai = 0; ai < 2; ++ai)
#pragma unroll
            for (int m = 0; m < 4; ++m) {
                const int slot = s0 + ai * 128 + wr * 64 + m * 16 + fr;
                float o[8];
#pragma unroll
                for (int n = 0; n < 2; ++n)
#pragma unroll
                    for (int j = 0; j < 4; ++j) {
                        float g = acc[ai][0][m][n][j] + (n ? bg1[j] : bg0[j]), l = acc[ai][1][m][n][j] + (n ? bl1[j] : bl0[j]);
                        g = fminf(g, 7.0f); l = fminf(fmaxf(l, -7.0f), 7.0f);
                        o[n * 4 + j] = g * frcp_(1.0f + __expf(-1.702f * g)) * (l + 1.0f);
                    }
                st_bf16x8(act + (size_t)slot * 1024 + ch, o[0], o[1], o[2], o[3], o[4], o[5], o[6], o[7]);
            }
    }
};
struct SchedDN {
    typedef UMoe U;
    const int* meta; const float* bdn; bf16_t* ys; const float* slot_w;
    __device__ __forceinline__ bool get(int i, U& u) const { return moe_unit(i, 4, u); }
    __device__ __forceinline__ void addrs(const U& u, int R0, int C0, unsigned& a00, unsigned& a01, unsigned& a10, unsigned& a11, unsigned& bofs) const {
        const unsigned r = (unsigned)(u.off + u.pm * 256 + R0);
        a00 = (r * 1024u + C0) * 2u; a01 = a00 + 64u * 2048u; a10 = a00 + 128u * 2048u; a11 = a00 + 192u * 2048u;
        bofs = ((unsigned)(u.e * 1024 + u.pn * 256 + R0) * 1024u + C0) * 2u;
    }
    __device__ __forceinline__ void epi(const U& u, const f32x4 (&acc)[2][2][4][2], int wr, int wc, int fr, int fq) const {
        const int s0 = u.off + u.pm * 256, col0 = u.pn * 256;
        const float* bd_ = bdn + (size_t)u.e * 1024;
#pragma unroll
        for (int bj = 0; bj < 2; ++bj) {
            const int c = col0 + bj * 128 + wc * 32 + fq * 8;
            const f32x4 b0 = *(const f32x4*)(bd_ + c), b1 = *(const f32x4*)(bd_ + c + 4);
#pragma unroll
            for (int ai = 0; ai < 2; ++ai)
#pragma unroll
                for (int m = 0; m < 4; ++m) {
                    const int slot = s0 + ai * 128 + wr * 64 + m * 16 + fr;
                    const float w = slot_w[slot];
                    const f32x4 x = (acc[ai][bj][m][0] + b0) * w, y = (acc[ai][bj][m][1] + b1) * w;
                    st_bf16x8(ys + (size_t)slot * 1024 + c, x[0], x[1], x[2], x[3], y[0], y[1], y[2], y[3]);
                }
        }
    }
};
__device__ __forceinline__ void ph_moe_gu(const bf16_t* V, const int* meta, const int* list, const bf16_t* WguT, const float* bgu, bf16_t* act) {
    SchedGU S; S.meta = meta; S.list = list; S.bgu = bgu; S.act = act;
    moe_table(meta, 8);
    gemm_stream(V, WguT, S);
}
__device__ __forceinline__ void ph_moe_dn(const bf16_t* act, const int* meta, const bf16_t* WdnT, const float* bdn, bf16_t* ys, const float* slot_w) {
    SchedDN S; S.meta = meta; S.bdn = bdn; S.ys = ys; S.slot_w = slot_w;
    moe_table(meta, 4);
    gemm_stream(act, WdnT, S);
}

#define NCHUNK 528
#define REC 8320
#define LP 72
__device__ __forceinline__ size_t rec_off(int type, int dir, int h, int g) { return ((size_t)(((type * 2 + dir) * 4 + h) * NCHUNK + g)) * REC; }
__device__ __forceinline__ int chunk_g(int b, int dir, int s) {
    if (s < 4) return b * 4 + (dir ? 3 - s : s);
    const int s2 = s - 4; return 16 + b * 128 + (dir ? 127 - s2 : s2);
}
__device__ __forceinline__ float wave_incl_prefix(float v, int lane) {
#pragma unroll
    for (int o = 1; o < 64; o <<= 1) { const float t = __shfl_up(v, o); if (lane >= o) v += t; }
    return v;
}
__device__ __forceinline__ float wave_incl_suffix(float v, int lane) {
#pragma unroll
    for (int o = 1; o < 64; o <<= 1) { const float t = __shfl_down(v, o); if (lane + o < 64) v += t; }
    return v;
}
__device__ __forceinline__ float wave_prefix_max(float v, int lane) {
#pragma unroll
    for (int o = 1; o < 64; o <<= 1) { const float t = __shfl_up(v, o); if (lane >= o) v = fmaxf(v, t); }
    return v;
}
__device__ __forceinline__ float wave_suffix_max(float v, int lane) {
#pragma unroll
    for (int o = 1; o < 64; o <<= 1) { const float t = __shfl_down(v, o); if (lane + o < 64) v = fmaxf(v, t); }
    return v;
}
__device__ __forceinline__ float wave_max(float v) {
#pragma unroll
    for (int o = 32; o > 0; o >>= 1) v = fmaxf(v, __shfl_xor(v, o));
    return v;
}
__device__ __forceinline__ bf16x8 lds_frag(const bf16_t* base, int row, int kofs) { return *(const bf16x8*)(base + row * LP + kofs); }
__device__ __forceinline__ bf16_t f2bf(float x) { return (bf16_t)(cvt_pk_bf16(x, 0.f) & 0xffffu); }

struct L0Args {
    const bf16_t* z;
    const float* ml_conv; const float* gate_b; const float* ret_decay; const float* ret_norm; const float* ml_norm;
    bf16_t* RQ; bf16_t* RK; bf16_t* MQ; bf16_t* MK;
    float* LIF;
    bf16_t* ST;
    float* CM;
    float* MI;
    bf16_t* MG;
};

__device__ __forceinline__ void ph_l0_prep(const L0Args& a) {
    const int tfz = tid_fresh(); const int wid = tfz >> 6, lane = tfz & 63;
    for (int r = blockIdx.x * 8 + wid; r < NTOK; r += gridDim.x * 8) {
        const RowInfo ri = row_info(r);
        const bf16_t* zc = a.z + (size_t)r * AB_IN;
        {
            const int h = lane >> 4, hf = (lane >> 3) & 1, j0 = (lane & 7) * 4;
            const f32x4 q1 = ldz4(zc + h * 64 + j0), q2 = ldz4(zc + h * 64 + 32 + j0);
            const f32x4 k1 = ldz4(zc + 256 + h * 64 + j0), k2 = ldz4(zc + 256 + h * 64 + 32 + j0);
            f32x4 qo, ko;
            if (r >= NCTX) {
#pragma unroll
                for (int x = 0; x < 4; ++x) {
                    const int j = j0 + x;
                    const float pos = (j < 16) ? (float)(ri.t >> 6) : (float)(ri.t & 63);
                    const float inv = exp2f(-(float)(j & 15) * 0.83048202372184059f);
                    const float ang = pos * inv;
                    const float cs = __cosf(ang), sn = __sinf(ang);
                    qo[x] = hf ? (q1[x] * sn + q2[x] * cs) : (q1[x] * cs - q2[x] * sn);
                    ko[x] = hf ? (k1[x] * sn + k2[x] * cs) : (k1[x] * cs - k2[x] * sn);
                }
            } else { qo = hf ? q2 : q1; ko = hf ? k2 : k1; }
            const int d0 = h * 64 + hf * 32 + j0;
            st_bf16x4(a.RQ + (size_t)r * 256 + d0, qo[0], qo[1], qo[2], qo[3]);
            st_bf16x4(a.RK + (size_t)r * 256 + d0, ko[0] * 0.125f, ko[1] * 0.125f, ko[2] * 0.125f, ko[3] * 0.125f);
        }
#pragma unroll
        for (int rep = 0; rep < 2; ++rep) {
            const int ch = rep * 256 + lane * 4;
            f32x4 cv = ldz4(zc + 1536 + ch) * *(const f32x4*)(a.ml_conv + 512 + ch);
            if (ri.t > 0) cv += ldz4(zc + 1536 + ch - AB_IN) * *(const f32x4*)(a.ml_conv + ch);
            if (ri.t < ri.len - 1) cv += ldz4(zc + 1536 + ch + AB_IN) * *(const f32x4*)(a.ml_conv + 1024 + ch);
            float o[4];
#pragma unroll
            for (int x = 0; x < 4; ++x) o[x] = cv[x] * frcp_(1.0f + __expf(-cv[x])) * (rep == 0 ? 0.125f : 1.0f);
            st_bf16x4((rep == 0 ? a.MQ : a.MK) + (size_t)r * 256 + lane * 4, o[0], o[1], o[2], o[3]);
        }
        if (lane < 16) {
            const float val = ldz(zc + 3072 + lane) + a.gate_b[lane];
            const int d = lane >> 3, gi = (lane >> 2) & 1, h = lane & 3;
            a.LIF[(size_t)r * 16 + gi * 8 + d * 4 + h] = gi ? logsigmoidf_(val) : val;
        }
    }
}

__device__ __forceinline__ void ph_l0_local(const L0Args& a) {
    bf16_t* KT = (bf16_t*)g_shm;
    bf16_t* VT = (bf16_t*)(g_shm + 4 * 64 * LP * 2);
    float* SC = (float*)(g_shm + 4 * 64 * LP * 2 + 2 * 128 * LP * 2);
    const int tid = tid_fresh(), wid = tid >> 6, lane = tid & 63, fr = lane & 15, fq = lane >> 4;
    const int kd = tid & 63, jg = tid >> 6, dv = tid & 127, vg = tid >> 7;
    bf16_t pk[2][8], pv[2][16]; float pli = 0.f, plf = 0.f;
    auto prefetch = [&](int it) {
        const int g = it >> 2, h = it & 3, row0 = g * 64;
#pragma unroll
        for (int ty = 0; ty < 2; ++ty) {
            const bf16_t* src = (ty ? a.MK : a.RK) + (size_t)(row0 + jg * 8) * 256 + h * 64 + kd;
#pragma unroll
            for (int x = 0; x < 8; ++x) pk[ty][x] = src[(size_t)x * 256];
            const bf16_t* sv = a.z + (size_t)(row0 + vg * 16) * AB_IN + (ty ? 2048 : 512) + h * 128 + dv;
#pragma unroll
            for (int x = 0; x < 16; ++x) pv[ty][x] = sv[(size_t)x * AB_IN];
        }
        if (wid == 1 || wid == 2) { const int dir = wid - 1; pli = a.LIF[(size_t)(row0 + lane) * 16 + dir * 4 + h]; plf = a.LIF[(size_t)(row0 + lane) * 16 + 8 + dir * 4 + h]; }
    };
    if ((int)blockIdx.x < NCHUNK * 4) prefetch(blockIdx.x);
    for (int it = blockIdx.x; it < NCHUNK * 4; it += gridDim.x) {
        const int g = it >> 2, h = it & 3;
        __syncthreads();
        if (wid == 0) {
            const float l2f = log2f(1.0f - expf(a.ret_decay[h])), l2b = log2f(1.0f - expf(a.ret_decay[4 + h]));
            SC[lane] = exp2f((float)(63 - lane) * l2f);
            SC[64 + lane] = exp2f((float)lane * l2b);
        } else if (wid == 1 || wid == 2) {
            const int dir = wid - 1;
            const float bc = dir ? wave_incl_suffix(plf, lane) : wave_incl_prefix(plf, lane);
            const float btot = __shfl(bc, dir ? 0 : 63);
            const float lw = btot - bc + pli;
            const float mloc = wave_max(lw);
            SC[(2 + dir) * 64 + lane] = fexp_(lw - mloc);
            if (lane == 0) { float* cm = a.CM + ((size_t)(dir * 4 + h) * NCHUNK + g) * 2; cm[0] = btot; cm[1] = mloc; }
        }
        __syncthreads();
#pragma unroll
        for (int ty = 0; ty < 2; ++ty) {
#pragma unroll
            for (int dir = 0; dir < 2; ++dir) {
                const float* sc = SC + (ty * 2 + dir) * 64 + jg * 8;
                u32x4 o;
                o.x = cvt_pk_bf16(bf16_to_f32(pk[ty][0]) * sc[0], bf16_to_f32(pk[ty][1]) * sc[1]); o.y = cvt_pk_bf16(bf16_to_f32(pk[ty][2]) * sc[2], bf16_to_f32(pk[ty][3]) * sc[3]);
                o.z = cvt_pk_bf16(bf16_to_f32(pk[ty][4]) * sc[4], bf16_to_f32(pk[ty][5]) * sc[5]); o.w = cvt_pk_bf16(bf16_to_f32(pk[ty][6]) * sc[6], bf16_to_f32(pk[ty][7]) * sc[7]);
                *(u32x4*)(KT + (ty * 2 + dir) * 64 * LP + (((kd >> 2) & 3) * 16 + (kd >> 4) * 4 + (kd & 3)) * LP + jg * 8) = o;
            }
            u32x4 o0, o1;
            o0.x = (unsigned)pv[ty][0] | ((unsigned)pv[ty][1] << 16); o0.y = (unsigned)pv[ty][2] | ((unsigned)pv[ty][3] << 16);
            o0.z = (unsigned)pv[ty][4] | ((unsigned)pv[ty][5] << 16); o0.w = (unsigned)pv[ty][6] | ((unsigned)pv[ty][7] << 16);
            o1.x = (unsigned)pv[ty][8] | ((unsigned)pv[ty][9] << 16); o1.y = (unsigned)pv[ty][10] | ((unsigned)pv[ty][11] << 16);
            o1.z = (unsigned)pv[ty][12] | ((unsigned)pv[ty][13] << 16); o1.w = (unsigned)pv[ty][14] | ((unsigned)pv[ty][15] << 16);
            *(u32x4*)(VT + ty * 128 * LP + dv * LP + vg * 16) = o0;
            *(u32x4*)(VT + ty * 128 * LP + dv * LP + vg * 16 + 8) = o1;
        }
        if (it + (int)gridDim.x < NCHUNK * 4) prefetch(it + gridDim.x);
        __syncthreads();
#pragma unroll
        for (int ty = 0; ty < 2; ++ty) {
            const bf16x8 v0 = lds_frag(VT + ty * 128 * LP, wid * 16 + fr, fq * 8), v1 = lds_frag(VT + ty * 128 * LP, wid * 16 + fr, 32 + fq * 8);
#pragma unroll
            for (int dir = 0; dir < 2; ++dir) {
                const bf16_t* kt = KT + (ty * 2 + dir) * 64 * LP;
                bf16_t* st = a.ST + rec_off(ty, dir, h, g) + (size_t)(wid * 16 + fr) * 64 + fq * 16;
#pragma unroll
                for (int dp = 0; dp < 2; ++dp) {
                    f32x4 acc0 = {0.f, 0.f, 0.f, 0.f}, acc1 = {0.f, 0.f, 0.f, 0.f};
                    acc0 = __builtin_amdgcn_mfma_f32_16x16x32_bf16(lds_frag(kt, (2 * dp) * 16 + fr, fq * 8), v0, acc0, 0, 0, 0);
                    acc0 = __builtin_amdgcn_mfma_f32_16x16x32_bf16(lds_frag(kt, (2 * dp) * 16 + fr, 32 + fq * 8), v1, acc0, 0, 0, 0);
                    acc1 = __builtin_amdgcn_mfma_f32_16x16x32_bf16(lds_frag(kt, (2 * dp + 1) * 16 + fr, fq * 8), v0, acc1, 0, 0, 0);
                    acc1 = __builtin_amdgcn_mfma_f32_16x16x32_bf16(lds_frag(kt, (2 * dp + 1) * 16 + fr, 32 + fq * 8), v1, acc1, 0, 0, 0);
                    st_bf16x8(st + dp * 8, acc0[0], acc0[1], acc0[2], acc0[3], acc1[0], acc1[1], acc1[2], acc1[3]);
                }
            }
        }
        if (tid < 128) {
            const int dir = tid >> 6, d = tid & 63;
            const bf16_t* kt = KT + (2 + dir) * 64 * LP + (((d >> 2) & 3) * 16 + (d >> 4) * 4 + (d & 3)) * LP;
            float sum = 0.f;
#pragma unroll 16
            for (int j = 0; j < 64; ++j) sum += bf16_to_f32(kt[j]);
            ((float*)(a.ST + rec_off(1, dir, h, g) + 8192))[d] = sum;
        }
    }
}

__device__ __forceinline__ void ph_l0_prop(const L0Args& a) {
    for (int idx = blockIdx.x * NTHR + tid_fresh(); idx < 64 * 2048; idx += gridDim.x * NTHR) {
        const int seq = idx >> 11, e4 = idx & 2047;
        const int ty = seq >> 5, dir = (seq >> 4) & 1, h = (seq >> 2) & 3, b = seq & 3;
        const bool hasn = ty == 1 && e4 < 16;
        f32x4 S = {0.f, 0.f, 0.f, 0.f}, Sn = {0.f, 0.f, 0.f, 0.f};
        float m = 0.f;
        const float g64 = exp2f(64.0f * log2f(1.0f - expf(a.ret_decay[dir * 4 + h])));
        for (int s0 = 0; s0 < 132; s0 += 12) {
            f32x4 loc[12], locn[12]; float bt[12], ml[12];
#pragma unroll
            for (int i = 0; i < 12; ++i) {
                const int g = chunk_g(b, dir, s0 + i);
                bf16_t* rp = a.ST + rec_off(ty, dir, h, g);
                loc[i] = ldz4(rp + (size_t)e4 * 4);
                locn[i] = (f32x4){0.f, 0.f, 0.f, 0.f};
                if (hasn) locn[i] = *(const f32x4*)((const float*)(rp + 8192) + e4 * 4);
                if (ty == 1) { const float* cm = a.CM + ((size_t)(dir * 4 + h) * NCHUNK + g) * 2; bt[i] = cm[0]; ml[i] = cm[1]; } else { bt[i] = 0.f; ml[i] = 0.f; }
            }
#pragma unroll
            for (int i = 0; i < 12; ++i) {
                const int g = chunk_g(b, dir, s0 + i);
                float dec, wl;
                if (ty == 0) { dec = g64; wl = 1.0f; }
                else {
                    const float mn = fmaxf(bt[i] + m, ml[i]);
                    dec = expf(bt[i] + m - mn); wl = expf(ml[i] - mn);
                    if (e4 == 0) a.MI[(size_t)(dir * 4 + h) * NCHUNK + g] = m;
                    m = mn;
                }
                bf16_t* rp = a.ST + rec_off(ty, dir, h, g);
                st_bf16x4(rp + (size_t)e4 * 4, S[0], S[1], S[2], S[3]);
                if (hasn) *(f32x4*)((float*)(rp + 8192) + e4 * 4) = Sn;
                S = S * dec + loc[i] * wl;
                Sn = Sn * dec + locn[i] * wl;
            }
        }
    }
}

__device__ __forceinline__ void ph_l0_out(const L0Args& a) {
    bf16_t* Qs = (bf16_t*)g_shm;
    bf16_t* Ks = Qs + 64 * LP;
    bf16_t* ATT = Ks + 64 * LP;
    bf16_t* VT = ATT + 64 * LP;
    bf16_t* SF = VT + 128 * LP;
    bf16_t* SB = SF + 144 * LP;
    float* FV = (float*)(SB + 144 * LP);
    const int tid = tid_fresh(), wid = tid >> 6, lane = tid & 63, fr = lane & 15, fq = lane >> 4;
    u32x4 pq, pkk; bf16_t pv[16]; float pli = 0.f, plf = 0.f, pmi = 0.f;
    auto prefetch = [&](int it) {
        const int ty = it & 1, h = (it >> 1) & 3, g = it >> 3, row0 = g * 64;
        const int tp = tid_fresh();
        const int i = tp >> 3, c8 = tp & 7;
        const size_t go = (size_t)(row0 + i) * 256 + h * 64 + c8 * 8;
        pq = *(const u32x4*)((ty ? a.MQ : a.RQ) + go);
        pkk = *(const u32x4*)((ty ? a.MK : a.RK) + go);
        const int dv = tp & 127, vg = tp >> 7;
        const bf16_t* src = a.z + (size_t)(row0 + vg * 16) * AB_IN + (ty ? 2048 : 512) + h * 128 + dv;
#pragma unroll
        for (int x = 0; x < 16; ++x) pv[x] = src[(size_t)x * AB_IN];
        if (ty == 1 && tp < 128) {
            const int w2 = tp >> 6, l2 = tp & 63;
            pli = a.LIF[(size_t)(row0 + l2) * 16 + w2 * 4 + h]; plf = a.LIF[(size_t)(row0 + l2) * 16 + 8 + w2 * 4 + h];
            pmi = a.MI[(size_t)(w2 * 4 + h) * NCHUNK + g];
        }
    };
    if ((int)blockIdx.x < NCHUNK * 8) prefetch(blockIdx.x);
    for (int it = blockIdx.x; it < NCHUNK * 8; it += gridDim.x) {
        const int ty = it & 1, h = (it >> 1) & 3, g = it >> 3, row0 = g * 64;
        __syncthreads();
        {
            const int ts = tid_fresh();
            const int i = ts >> 3, c8 = ts & 7;
            *(u32x4*)(Qs + i * LP + c8 * 8) = pq;
            *(u32x4*)(Ks + i * LP + c8 * 8) = pkk;
            const int dv = ts & 127, vg = ts >> 7;
            u32x4 o0, o1;
            o0.x = (unsigned)pv[0] | ((unsigned)pv[1] << 16); o0.y = (unsigned)pv[2] | ((unsigned)pv[3] << 16); o0.z = (unsigned)pv[4] | ((unsigned)pv[5] << 16); o0.w = (unsigned)pv[6] | ((unsigned)pv[7] << 16);
            o1.x = (unsigned)pv[8] | ((unsigned)pv[9] << 16); o1.y = (unsigned)pv[10] | ((unsigned)pv[11] << 16); o1.z = (unsigned)pv[12] | ((unsigned)pv[13] << 16); o1.w = (unsigned)pv[14] | ((unsigned)pv[15] << 16);
            *(u32x4*)(VT + dv * LP + vg * 16) = o0;
            *(u32x4*)(VT + dv * LP + vg * 16 + 8) = o1;
            if (ts < 2 * 16 * 8) {
                const int dir = ts >> 7, rr = (ts >> 3) & 15, c = ts & 7;
                u32x4 o = {0u, 0u, 0u, 0u};
                if (ty == 1 && rr == 0) {
                    const float* np = (const float*)(a.ST + rec_off(1, dir, h, g) + 8192) + c * 8;
                    o.x = cvt_pk_bf16(np[0], np[1]); o.y = cvt_pk_bf16(np[2], np[3]); o.z = cvt_pk_bf16(np[4], np[5]); o.w = cvt_pk_bf16(np[6], np[7]);
                }
                *(u32x4*)((dir ? SB : SF) + (128 + rr) * LP + c * 8) = o;
            }
            if (ty == 1 && wid < 2) {
                const int dir = wid;
                const float bc = dir ? wave_incl_suffix(plf, lane) : wave_incl_prefix(plf, lane);
                const float aj = pli - bc;
                const float pm = dir ? wave_suffix_max(aj, lane) : wave_prefix_max(aj, lane);
                const float M = fmaxf(pmi, pm);
                float* fv = FV + dir * 256;
                fv[lane] = M; fv[64 + lane] = aj; fv[128 + lane] = fexp_(pmi - M); fv[192 + lane] = fexp_(-(bc + M));
            }
        }
        u32x4 ps[2][2];
        {
            const int tq = tid_fresh();
            const int sdv = tq >> 2, sd = (tq & 3) * 16;
#pragma unroll
            for (int dir = 0; dir < 2; ++dir) {
                const bf16_t* sp = a.ST + rec_off(ty, dir, h, g) + (size_t)sdv * 64 + sd;
                ps[dir][0] = *(const u32x4*)sp; ps[dir][1] = *(const u32x4*)(sp + 8);
            }
        }
        __syncthreads();
        const float l2f = (ty == 0) ? log2f(1.0f - expf(a.ret_decay[h])) : 0.f;
        const float l2b = (ty == 0) ? log2f(1.0f - expf(a.ret_decay[4 + h])) : 0.f;
        f32x4 otot[4];
#pragma unroll
        for (int x = 0; x < 4; ++x) otot[x] = (f32x4){0.f, 0.f, 0.f, 0.f};
        const int ndir = (ty == 0) ? 1 : 2;
        for (int pass = 0; pass < ndir; ++pass) {
            {
                const int itl = wid >> 1;
                const bf16x8 q0 = lds_frag(Qs, itl * 16 + fr, fq * 8), q1 = lds_frag(Qs, itl * 16 + fr, 32 + fq * 8);
                float rs = 0.f;
                const int i = itl * 16 + fr;
#pragma unroll
                for (int jj = 0; jj < 2; ++jj) {
                    const int jt = (wid & 1) * 2 + jj;
                    f32x4 acc = {0.f, 0.f, 0.f, 0.f};
                    acc = __builtin_amdgcn_mfma_f32_16x16x32_bf16(lds_frag(Ks, jt * 16 + fr, fq * 8), q0, acc, 0, 0, 0);
                    acc = __builtin_amdgcn_mfma_f32_16x16x32_bf16(lds_frag(Ks, jt * 16 + fr, 32 + fq * 8), q1, acc, 0, 0, 0);
                    float sv[4];
#pragma unroll
                    for (int r = 0; r < 4; ++r) {
                        const int j = jt * 16 + fq * 4 + r;
                        float dcy;
                        if (ty == 0) {
                            dcy = ((j <= i) ? exp2f((float)(i - j) * l2f) : 0.f) + ((j >= i) ? exp2f((float)(j - i) * l2b) : 0.f);
                        } else {
                            const float* fv = FV + pass * 256;
                            const bool ok = pass ? (j >= i) : (j <= i);
                            dcy = ok ? fexp_(fv[64 + j] - fv[i]) : 0.f;
                        }
                        sv[r] = acc[r] * dcy;
                        rs += sv[r];
                    }
                    u32x2 w; w.x = cvt_pk_bf16(sv[0], sv[1]); w.y = cvt_pk_bf16(sv[2], sv[3]);
                    *(u32x2*)(ATT + i * LP + jt * 16 + fq * 4) = w;
                }
                if (ty == 1) {
                    rs += __shfl_xor(rs, 16); rs += __shfl_xor(rs, 32);
                    if (fq == 0) FV[512 + (pass * 2 + (wid & 1)) * 64 + i] = rs;
                }
            }
            if (pass == 0) {
                const int tq = tid_fresh();
                const int sdv = tq >> 2, sd = (tq & 3) * 16;
#pragma unroll
                for (int dir = 0; dir < 2; ++dir) {
                    bf16_t* dst = (dir ? SB : SF) + sdv * LP + sd;
                    *(u32x4*)dst = ps[dir][0]; *(u32x4*)(dst + 8) = ps[dir][1];
                }
                if (it + (int)gridDim.x < NCHUNK * 8) prefetch(it + gridDim.x);
            }
            __syncthreads();
            {
                const bf16x8 v0 = lds_frag(VT, wid * 16 + fr, fq * 8), v1 = lds_frag(VT, wid * 16 + fr, 32 + fq * 8);
                const bf16_t* S1 = (ty == 0) ? SF : (pass ? SB : SF);
                const bf16x8 sf0 = lds_frag(S1, wid * 16 + fr, fq * 8), sf1 = lds_frag(S1, wid * 16 + fr, 32 + fq * 8);
                bf16x8 sb0 = sf0, sb1 = sf1;
                if (ty == 0) { sb0 = lds_frag(SB, wid * 16 + fr, fq * 8); sb1 = lds_frag(SB, wid * 16 + fr, 32 + fq * 8); }
                if (ty == 1 && wid == 0) {
                    const bf16x8 n0 = lds_frag(S1, 128 + fr, fq * 8), n1 = lds_frag(S1, 128 + fr, 32 + fq * 8);
#pragma unroll
                    for (int tt = 0; tt < 4; ++tt) {
                        f32x4 an = {0.f, 0.f, 0.f, 0.f};
                        an = __builtin_amdgcn_mfma_f32_16x16x32_bf16(n0, lds_frag(Qs, tt * 16 + fr, fq * 8), an, 0, 0, 0);
                        an = __builtin_amdgcn_mfma_f32_16x16x32_bf16(n1, lds_frag(Qs, tt * 16 + fr, 32 + fq * 8), an, 0, 0, 0);
                        if (fq == 0) FV[768 + pass * 64 + tt * 16 + fr] = an[0];
                    }
                }
                if (ty == 1) __syncthreads();
#pragma unroll
                for (int tt = 0; tt < 4; ++tt) {
                    const bf16x8 a0 = lds_frag(ATT, tt * 16 + fr, fq * 8), a1 = lds_frag(ATT, tt * 16 + fr, 32 + fq * 8);
                    const bf16x8 qq0 = lds_frag(Qs, tt * 16 + fr, fq * 8), qq1 = lds_frag(Qs, tt * 16 + fr, 32 + fq * 8);
                    f32x4 ao = {0.f, 0.f, 0.f, 0.f}, af = {0.f, 0.f, 0.f, 0.f}, ab = {0.f, 0.f, 0.f, 0.f};
                    ao = __builtin_amdgcn_mfma_f32_16x16x32_bf16(v0, a0, ao, 0, 0, 0);
                    ao = __builtin_amdgcn_mfma_f32_16x16x32_bf16(v1, a1, ao, 0, 0, 0);
                    af = __builtin_amdgcn_mfma_f32_16x16x32_bf16(sf0, qq0, af, 0, 0, 0);
                    af = __builtin_amdgcn_mfma_f32_16x16x32_bf16(sf1, qq1, af, 0, 0, 0);
                    const int i = tt * 16 + fr;
                    if (ty == 0) {
                        ab = __builtin_amdgcn_mfma_f32_16x16x32_bf16(sb0, qq0, ab, 0, 0, 0);
                        ab = __builtin_amdgcn_mfma_f32_16x16x32_bf16(sb1, qq1, ab, 0, 0, 0);
                        const float wf = exp2f((float)(i + 1) * l2f), wb = exp2f((float)(64 - i) * l2b);
                        otot[tt] += ao + af * wf + ab * wb;
                    } else {
                        const float* fv = FV + pass * 256;
                        const float wint = fv[128 + i], eden = fv[192 + i];
                        const float den = wint * FV[768 + pass * 64 + i] + FV[512 + (pass * 2) * 64 + i] + FV[512 + (pass * 2 + 1) * 64 + i];
                        const float inv = frcp_(fmaxf(fabsf(den), eden));
                        otot[tt] += (ao + af * wint) * inv;
                    }
                }
            }
            if (ty == 1) __syncthreads();
        }
        {
            float* ssw = FV + 896;
#pragma unroll
            for (int tt = 0; tt < 4; ++tt) {
                float ss = otot[tt][0] * otot[tt][0] + otot[tt][1] * otot[tt][1] + otot[tt][2] * otot[tt][2] + otot[tt][3] * otot[tt][3];
                ss += __shfl_xor(ss, 16); ss += __shfl_xor(ss, 32);
                if (fq == 0) ssw[wid * 64 + tt * 16 + fr] = ss;
            }
            __syncthreads();
            const float* nw = (ty ? a.ml_norm : a.ret_norm) + h * 128 + wid * 16 + fq * 4;
            const f32x4 nv = *(const f32x4*)nw;
#pragma unroll
            for (int tt = 0; tt < 4; ++tt) {
                const int i = tt * 16 + fr;
                float tot = 0.f;
#pragma unroll
                for (int w = 0; w < 8; ++w) tot += ssw[w * 64 + i];
                const float rsn = rsqrtf(tot * (1.0f / 128.0f) + EPSF);
                const f32x4 gz = ldz4(a.z + (size_t)(row0 + i) * AB_IN + (ty ? 2560 : 1024) + h * 128 + wid * 16 + fq * 4);
                float o[4];
#pragma unroll
                for (int r = 0; r < 4; ++r) {
                    const float gate = ty ? fsigmoid_(gz[r]) : gz[r] * fsigmoid_(gz[r]);
                    o[r] = otot[tt][r] * rsn * nv[r] * gate;
                }
                st_bf16x4(a.MG + (size_t)(row0 + i) * DM + ty * 512 + h * 128 + wid * 16 + fq * 4, o[0], o[1], o[2], o[3]);
            }
        }
    }
}


#define LP2 136
#define HREC 16384
struct L1Args {
    const bf16_t* z;
    const float* hgrn_lb; const float* hg_norm;
    bf16_t* HST;
    float* HDEC;
    bf16_t* MG;
    const float* shift; const float* w0; const float* w2; const float* a0; const float* a2; const float* g2;
    const float* kk_scale; const float* k_a; const float* r_k; const float* rw_norm;
    bf16_t* PKK; bf16_t* PV;
    float* PG;
    float* PW;
    bf16_t* PAB; bf16_t* PKE; bf16_t* PWR;
    float* PSC;
    float* PBON;
    float* RWO;
    bf16_t* WLR;
};
__device__ __forceinline__ size_t hrec_off(int dir, int h, int g) { return ((size_t)((dir * 4 + h) * NCHUNK + g)) * HREC; }
__device__ __forceinline__ bf16x8 lds_frag2(const bf16_t* base, int row, int kofs) { return *(const bf16x8*)(base + row * LP2 + kofs); }

__device__ __forceinline__ void ph_l1_local(const L1Args& a, int bi, int nb) {
    bf16_t* KD = (bf16_t*)g_shm;
    bf16_t* VT = KD + 2 * 128 * LP;
    bf16_t* RAW = VT + 128 * LP;
    const int tid = tid_fresh(), wid = tid >> 6, lane = tid & 63, fr = lane & 15, fq = lane >> 4;
    u32x4 praw[4]; bf16_t pv[16];
    auto prefetch = [&](int it) {
        const int g = it >> 2, h = it & 3, row0 = g * 64;
        const int tp = tid_fresh();
#pragma unroll
        for (int c = 0; c < 4; ++c) {
            const int idx = tp + NTHR * c, dir = idx >> 10, j = (idx >> 4) & 63, c8 = idx & 15;
            praw[c] = *(const u32x4*)(a.z + (size_t)(row0 + j) * CD_IN + 512 + dir * 512 + h * 128 + c8 * 8);
        }
        const int dv = tp & 127, vg = tp >> 7;
        const bf16_t* src = a.z + (size_t)(row0 + vg * 16) * CD_IN + 1536 + h * 128 + dv;
#pragma unroll
        for (int x = 0; x < 16; ++x) pv[x] = src[(size_t)x * CD_IN];
    };
    if (bi < NCHUNK * 4) prefetch(bi);
    for (int it = bi; it < NCHUNK * 4; it += nb) {
        const int g = it >> 2, h = it & 3;
        __syncthreads();
        {
            const int ts = tid_fresh();
#pragma unroll
            for (int c = 0; c < 4; ++c) {
                const int idx = ts + NTHR * c, dir = idx >> 10, j = (idx >> 4) & 63, c8 = idx & 15;
                *(u32x4*)(RAW + (dir * 64 + j) * 128 + c8 * 8) = praw[c];
            }
            const int dv = ts & 127, vg = ts >> 7;
            u32x4 o0, o1;
            o0.x = (unsigned)pv[0] | ((unsigned)pv[1] << 16); o0.y = (unsigned)pv[2] | ((unsigned)pv[3] << 16); o0.z = (unsigned)pv[4] | ((unsigned)pv[5] << 16); o0.w = (unsigned)pv[6] | ((unsigned)pv[7] << 16);
            o1.x = (unsigned)pv[8] | ((unsigned)pv[9] << 16); o1.y = (unsigned)pv[10] | ((unsigned)pv[11] << 16); o1.z = (unsigned)pv[12] | ((unsigned)pv[13] << 16); o1.w = (unsigned)pv[14] | ((unsigned)pv[15] << 16);
            *(u32x4*)(VT + dv * LP + vg * 16) = o0;
            *(u32x4*)(VT + dv * LP + vg * 16 + 8) = o1;
        }
        if (it + nb < NCHUNK * 4) prefetch(it + nb);
        __syncthreads();
        if (tid < 256) {
            const int dir = tid >> 7, d = tid & 127;
            const float p0 = a.hgrn_lb[h * 128 + d], p1 = a.hgrn_lb[512 + h * 128 + d];
            const float lb = 1.0f / (1.0f + expf(p0 - p1));
            const bf16_t* raw = RAW + dir * 64 * 128 + d;
            float E = 0.f;
            bf16_t* kd = KD + (dir * 128 + (((d >> 2) & 7) * 16 + (d >> 5) * 4 + (d & 3))) * LP;
#pragma unroll 8
            for (int s2 = 0; s2 < 64; ++s2) {
                const int j = dir ? s2 : 63 - s2;
                const float f = lb + (1.0f - lb) * fsigmoid_(bf16_to_f32(raw[j * 128]));
                kd[j] = f2bf((1.0f - f) * fexp_(E));
                E += flog_(f);
            }
            a.HDEC[((size_t)(dir * 4 + h) * NCHUNK + g) * 128 + d] = expf(E);
        }
        __syncthreads();
        const bf16x8 v0 = lds_frag(VT, wid * 16 + fr, fq * 8), v1 = lds_frag(VT, wid * 16 + fr, 32 + fq * 8);
#pragma unroll
        for (int dir = 0; dir < 2; ++dir) {
            bf16_t* st = a.HST + hrec_off(dir, h, g) + (size_t)(wid * 16 + fr) * 128 + fq * 32;
#pragma unroll
            for (int dp = 0; dp < 4; ++dp) {
                f32x4 acc0 = {0.f, 0.f, 0.f, 0.f}, acc1 = {0.f, 0.f, 0.f, 0.f};
                acc0 = __builtin_amdgcn_mfma_f32_16x16x32_bf16(lds_frag(KD + dir * 128 * LP, (2 * dp) * 16 + fr, fq * 8), v0, acc0, 0, 0, 0);
                acc0 = __builtin_amdgcn_mfma_f32_16x16x32_bf16(lds_frag(KD + dir * 128 * LP, (2 * dp) * 16 + fr, 32 + fq * 8), v1, acc0, 0, 0, 0);
                acc1 = __builtin_amdgcn_mfma_f32_16x16x32_bf16(lds_frag(KD + dir * 128 * LP, (2 * dp + 1) * 16 + fr, fq * 8), v0, acc1, 0, 0, 0);
                acc1 = __builtin_amdgcn_mfma_f32_16x16x32_bf16(lds_frag(KD + dir * 128 * LP, (2 * dp + 1) * 16 + fr, 32 + fq * 8), v1, acc1, 0, 0, 0);
                st_bf16x8(st + dp * 8, acc0[0], acc0[1], acc0[2], acc0[3], acc1[0], acc1[1], acc1[2], acc1[3]);
            }
        }
    }
}
__device__ __forceinline__ void ph_l1_prop(const L1Args& a, int bi, int nb) {
    for (int idx = bi * NTHR + tid_fresh(); idx < 32 * (HREC / 4); idx += nb * NTHR) {
        const int seq = idx / (HREC / 4), e4 = idx % (HREC / 4);
        const int dir = seq >> 4, h = (seq >> 2) & 3, b = seq & 3;
        const int d4 = (e4 & 31) * 4;
        f32x4 S = {0.f, 0.f, 0.f, 0.f};
        for (int s0 = 0; s0 < 132; s0 += 12) {
            f32x4 loc[12], dec[12];
#pragma unroll
            for (int i = 0; i < 12; ++i) {
                const int g = chunk_g(b, dir, s0 + i);
                loc[i] = ldz4(a.HST + hrec_off(dir, h, g) + (size_t)e4 * 4);
                dec[i] = *(const f32x4*)(a.HDEC + ((size_t)(dir * 4 + h) * NCHUNK + g) * 128 + d4);
            }
#pragma unroll
            for (int i = 0; i < 12; ++i) {
                const int g = chunk_g(b, dir, s0 + i);
                st_bf16x4(a.HST + hrec_off(dir, h, g) + (size_t)e4 * 4, S[0], S[1], S[2], S[3]);
                S = S * dec[i] + loc[i];
            }
        }
    }
}
__device__ __forceinline__ void ph_l1_out(const L1Args& a, int bi, int nb) {
    bf16_t* QA = (bf16_t*)g_shm;
    bf16_t* R2 = QA + 2 * 64 * LP2;
    bf16_t* ATT = R2 + 2 * 128 * LP2;
    bf16_t* VT = ATT + 64 * LP;
    float* ssw = (float*)(VT + 128 * LP);
    bf16_t* RAWF = R2 + 128 * LP2;
    bf16_t* RAWQ = ATT;
    const int tid = tid_fresh(), wid = tid >> 6, lane = tid & 63, fr = lane & 15, fq = lane >> 4;
    u32x4 praw[6]; bf16_t pv[16];
    auto prefetch = [&](int it) {
        const int g = it >> 2, h = it & 3, row0 = g * 64;
        const int tp = tid_fresh();
#pragma unroll
        for (int c = 0; c < 6; ++c) {
            const int idx = tp + NTHR * c, arr = idx >> 10, j = (idx >> 4) & 63, c8 = idx & 15;
            praw[c] = *(const u32x4*)(a.z + (size_t)(row0 + j) * CD_IN + (arr < 2 ? 512 + arr * 512 : 0) + h * 128 + c8 * 8);
        }
        const int dv = tp & 127, vg = tp >> 7;
        const bf16_t* src = a.z + (size_t)(row0 + vg * 16) * CD_IN + 1536 + h * 128 + dv;
#pragma unroll
        for (int x = 0; x < 16; ++x) pv[x] = src[(size_t)x * CD_IN];
    };
    if (bi < NCHUNK * 4) prefetch(bi);
    for (int it = bi; it < NCHUNK * 4; it += nb) {
        const int g = it >> 2, h = it & 3, row0 = g * 64;
        __syncthreads();
        {
            const int ts = tid_fresh();
#pragma unroll
            for (int c = 0; c < 6; ++c) {
                const int idx = ts + NTHR * c, arr = idx >> 10, j = (idx >> 4) & 63, c8 = idx & 15;
                bf16_t* dst = (arr < 2 ? RAWF + (arr * 64 + j) * 128 : RAWQ + j * 128) + c8 * 8;
                *(u32x4*)dst = praw[c];
            }
        }
        u32x4 ps[2][4];
        {
            const int tq = tid_fresh();
#pragma unroll
            for (int dir = 0; dir < 2; ++dir) {
                const bf16_t* sp = a.HST + hrec_off(dir, h, g);
#pragma unroll
                for (int c = 0; c < 4; ++c) { const int e = (c * NTHR + tq) * 8; ps[dir][c] = *(const u32x4*)(sp + e); }
            }
        }
        __syncthreads();
        if (tid < 256) {
            const int dir = tid >> 7, d = tid & 127;
            const float p0 = a.hgrn_lb[h * 128 + d], p1 = a.hgrn_lb[512 + h * 128 + d];
            const float lb = 1.0f / (1.0f + expf(p0 - p1));
            const bf16_t* rf = RAWF + dir * 64 * 128 + d;
            const bf16_t* rq = RAWQ + d;
            float B = 0.f;
#pragma unroll 8
            for (int s2 = 0; s2 < 64; ++s2) {
                const int j = dir ? 63 - s2 : s2;
                const float f = lb + (1.0f - lb) * fsigmoid_(bf16_to_f32(rf[j * 128]));
                B += flog_(f);
                QA[(dir * 64 + j) * LP2 + d] = f2bf(bf16_to_f32(rq[j * 128]) * fexp_(B));
                R2[(dir * 64 + j) * LP2 + d] = f2bf((1.0f - f) * fexp_(fminf(-B, 80.0f)));
            }
        }
        __syncthreads();
        {
            const int ts = tid_fresh();
            const int dv = ts & 127, vg = ts >> 7;
            u32x4 o0, o1;
            o0.x = (unsigned)pv[0] | ((unsigned)pv[1] << 16); o0.y = (unsigned)pv[2] | ((unsigned)pv[3] << 16); o0.z = (unsigned)pv[4] | ((unsigned)pv[5] << 16); o0.w = (unsigned)pv[6] | ((unsigned)pv[7] << 16);
            o1.x = (unsigned)pv[8] | ((unsigned)pv[9] << 16); o1.y = (unsigned)pv[10] | ((unsigned)pv[11] << 16); o1.z = (unsigned)pv[12] | ((unsigned)pv[13] << 16); o1.w = (unsigned)pv[14] | ((unsigned)pv[15] << 16);
            *(u32x4*)(VT + dv * LP + vg * 16) = o0;
            *(u32x4*)(VT + dv * LP + vg * 16 + 8) = o1;
        }
        {
            const int itl = wid >> 1, i = itl * 16 + fr;
#pragma unroll
            for (int jj = 0; jj < 2; ++jj) {
                const int jt = (wid & 1) * 2 + jj;
                f32x4 af = {0.f, 0.f, 0.f, 0.f}, ab = {0.f, 0.f, 0.f, 0.f};
#pragma unroll
                for (int ks = 0; ks < 4; ++ks) {
                    af = __builtin_amdgcn_mfma_f32_16x16x32_bf16(lds_frag2(R2, jt * 16 + fr, ks * 32 + fq * 8), lds_frag2(QA, itl * 16 + fr, ks * 32 + fq * 8), af, 0, 0, 0);
                    ab = __builtin_amdgcn_mfma_f32_16x16x32_bf16(lds_frag2(R2 + 64 * LP2, jt * 16 + fr, ks * 32 + fq * 8), lds_frag2(QA + 64 * LP2, itl * 16 + fr, ks * 32 + fq * 8), ab, 0, 0, 0);
                }
                float sv[4];
#pragma unroll
                for (int r = 0; r < 4; ++r) {
                    const int j = jt * 16 + fq * 4 + r;
                    sv[r] = ((j <= i) ? af[r] : 0.f) + ((j >= i) ? ab[r] : 0.f);
                }
                u32x2 w; w.x = cvt_pk_bf16(sv[0], sv[1]); w.y = cvt_pk_bf16(sv[2], sv[3]);
                *(u32x2*)(ATT + i * LP + jt * 16 + fq * 4) = w;
            }
        }
        __syncthreads();
        {
            const int tq = tid_fresh();
#pragma unroll
            for (int dir = 0; dir < 2; ++dir) {
#pragma unroll
                for (int c = 0; c < 4; ++c) {
                    const int e = (c * NTHR + tq) * 8;
                    const int dv = e >> 7, d = e & 127;
                    *(u32x4*)(R2 + (dir * 128 + dv) * LP2 + d) = ps[dir][c];
                }
            }
            if (it + nb < NCHUNK * 4) prefetch(it + nb);
        }
        __syncthreads();
        f32x4 o4[4];
        {
            const bf16x8 v0 = lds_frag(VT, wid * 16 + fr, fq * 8), v1 = lds_frag(VT, wid * 16 + fr, 32 + fq * 8);
#pragma unroll
            for (int tt = 0; tt < 4; ++tt) {
                f32x4 acc = {0.f, 0.f, 0.f, 0.f};
                acc = __builtin_amdgcn_mfma_f32_16x16x32_bf16(v0, lds_frag(ATT, tt * 16 + fr, fq * 8), acc, 0, 0, 0);
                acc = __builtin_amdgcn_mfma_f32_16x16x32_bf16(v1, lds_frag(ATT, tt * 16 + fr, 32 + fq * 8), acc, 0, 0, 0);
#pragma unroll
                for (int dir = 0; dir < 2; ++dir)
#pragma unroll
                    for (int ks = 0; ks < 4; ++ks)
                        acc = __builtin_amdgcn_mfma_f32_16x16x32_bf16(lds_frag2(R2 + dir * 128 * LP2, wid * 16 + fr, ks * 32 + fq * 8),
                                                                      lds_frag2(QA + dir * 64 * LP2, tt * 16 + fr, ks * 32 + fq * 8), acc, 0, 0, 0);
                o4[tt] = acc;
            }
        }
#pragma unroll
        for (int tt = 0; tt < 4; ++tt) {
            float ss = o4[tt][0] * o4[tt][0] + o4[tt][1] * o4[tt][1] + o4[tt][2] * o4[tt][2] + o4[tt][3] * o4[tt][3];
            ss += __shfl_xor(ss, 16); ss += __shfl_xor(ss, 32);
            if (fq == 0) ssw[wid * 64 + tt * 16 + fr] = ss;
        }
        __syncthreads();
        const f32x4 nv = *(const f32x4*)(a.hg_norm + h * 128 + wid * 16 + fq * 4);
#pragma unroll
        for (int tt = 0; tt < 4; ++tt) {
            const int i = tt * 16 + fr;
            float tot = 0.f;
#pragma unroll
            for (int w = 0; w < 8; ++w) tot += ssw[w * 64 + i];
            const float rsn = rsqrtf(tot * (1.0f / 128.0f) + EPSF);
            const f32x4 gz = ldz4(a.z + (size_t)(row0 + i) * CD_IN + 2048 + h * 128 + wid * 16 + fq * 4);
            st_bf16x4(a.MG + (size_t)(row0 + i) * DM + h * 128 + wid * 16 + fq * 4,
                      o4[tt][0] * rsn * nv[0] * fsigmoid_(gz[0]), o4[tt][1] * rsn * nv[1] * fsigmoid_(gz[1]),
                      o4[tt][2] * rsn * nv[2] * fsigmoid_(gz[2]), o4[tt][3] * rsn * nv[3] * fsigmoid_(gz[3]));
        }
    }
}

__device__ __forceinline__ void ph_l1_wlr(const L1Args& a) {
    const int gt = blockIdx.x * NTHR + tid_fresh(), gs = gridDim.x * NTHR;
    for (int i = gt; i < 4 * 32768 + 65536; i += gs) {
        float v;
        if (i < 4 * 32768) { const int m = i >> 15, e = i & 32767, n = e >> 6, k = e & 63; v = (m < 2 ? a.w2 : a.a2)[((size_t)(m & 1) * 64 + k) * 512 + n]; }
        else { const int e = i - 4 * 32768, n = e >> 7, k = e & 127; v = a.g2[(size_t)k * 512 + n]; }
        a.WLR[i] = f2bf(v);
    }
}
#define FP 392
__device__ __forceinline__ void ph_l1_rwprep(const L1Args& a) {
    bf16_t* F = (bf16_t*)g_shm;
    float* SH = (float*)(F + 32 * FP);
    float* PT = SH + 3 * 1920;
    const int tid = tid_fresh(), wid = tid >> 6, lane = tid & 63, fr = lane & 15, fq = lane >> 4;
    const int tt = wid & 1, hg = wid >> 1;
    __syncthreads();
    for (int i = tid; i < 3 * 1920; i += NTHR) SH[i] = a.shift[i];
    for (int i = tid; i < 512; i += NTHR) { PT[i] = a.kk_scale[i]; PT[512 + i] = a.k_a[i]; PT[1024 + i] = a.r_k[i]; }
    for (int i = tid; i < 1024; i += NTHR) { PT[1536 + i] = a.w0[i]; PT[2560 + i] = a.a0[i]; }
    constexpr int NIT = NTOK / 32;
    const int G = gridDim.x, nfull = (NIT / G) * G, rem = NIT - nfull;
    const bool split = 2 * rem <= G;
    const int nmine = (int)blockIdx.x < nfull ? (nfull / G) : 0;
    const int extra = split ? ((int)blockIdx.x < 2 * rem ? 1 : 0) : ((int)blockIdx.x < rem ? 1 : 0);
    for (int q = 0; q < nmine + extra; ++q) {
        const bool tail = q >= nmine;
        const int it = !tail ? (int)blockIdx.x + q * G : nfull + (split ? ((int)blockIdx.x >> 1) : (int)blockIdx.x);
        const int i0 = (tail && split) ? ((int)blockIdx.x & 1) * 4 : 0, i1 = (tail && split) ? i0 + 4 : 8;
        const int row0 = it * 32;
        __syncthreads();
#pragma unroll 1
        for (int jb = 0; jb < 2; ++jb) {
            u32x2 zz[3][3];
#pragma unroll
            for (int j = 0; j < 3; ++j) {
                const int idx = tid + NTHR * (jb * 3 + j), tk = idx / 96, cg = idx - tk * 96;
                const int r = row0 + tk;
                const RowInfo ri = row_info(r);
                const bf16_t* zp = a.z + (size_t)r * CD_IN + 2560 + 1536 + cg * 4;
                zz[j][0] = *(const u32x2*)(zp - (ri.t > 0 ? CD_IN : 0));
                zz[j][1] = *(const u32x2*)zp;
                zz[j][2] = *(const u32x2*)(zp + (ri.t < ri.len - 1 ? CD_IN : 0));
            }
#pragma unroll
            for (int j = 0; j < 3; ++j) {
                const int idx = tid + NTHR * (jb * 3 + j), tk = idx / 96, cg = idx - tk * 96;
                const RowInfo ri = row_info(row0 + tk);
                const float mp = ri.t > 0 ? 1.0f : 0.0f, mn = ri.t < ri.len - 1 ? 1.0f : 0.0f;
                const int ch = 1536 + cg * 4;
                float o[4];
#pragma unroll
                for (int x = 0; x < 4; ++x) {
                    const unsigned wp_ = x < 2 ? zz[j][0].x : zz[j][0].y, wc_ = x < 2 ? zz[j][1].x : zz[j][1].y, wn_ = x < 2 ? zz[j][2].x : zz[j][2].y;
                    const float pv_ = __uint_as_float((x & 1) ? (wp_ & 0xffff0000u) : (wp_ << 16)), cv_ = __uint_as_float((x & 1) ? (wc_ & 0xffff0000u) : (wc_ << 16)),
                                nv_ = __uint_as_float((x & 1) ? (wn_ & 0xffff0000u) : (wn_ << 16));
                    const float cv = SH[ch + x] * pv_ * mp + SH[1920 + ch + x] * cv_ + SH[3840 + ch + x] * nv_ * mn;
                    const float sg = frcp_(1.0f + __expf(cg < 32 ? -2.0f * cv : -cv));
                    o[x] = (cg < 32) ? (2.0f * sg - 1.0f) : ((cg < 64) ? cv : sg);
                }
                st_bf16x4(F + tk * FP + cg * 4, o[0], o[1], o[2], o[3]);
            }
        }
        __syncthreads();
        const int r = row0 + tt * 16 + fr;
        const RowInfo ri = row_info(r);
        const float mp = ri.t > 0 ? 1.0f : 0.0f, mn = ri.t < ri.len - 1 ? 1.0f : 0.0f;
        const bf16_t* zc = a.z + (size_t)r * CD_IN + 2560;
        const bf16_t* zpv = zc - (ri.t > 0 ? CD_IN : 0);
        const bf16_t* znx = zc + (ri.t < ri.len - 1 ? CD_IN : 0);
        const bf16_t* fbp = F + (tt * 16 + fr) * FP + fq * 8;
        auto conv_from = [&](const u32x2 (&zr)[3], int ch) -> f32x4 {
            f32x4 o;
#pragma unroll
            for (int x = 0; x < 4; ++x) {
                const unsigned wp_ = x < 2 ? zr[0].x : zr[0].y, wc_ = x < 2 ? zr[1].x : zr[1].y, wn_ = x < 2 ? zr[2].x : zr[2].y;
                const float pv_ = __uint_as_float((x & 1) ? (wp_ & 0xffff0000u) : (wp_ << 16)), cv_ = __uint_as_float((x & 1) ? (wc_ & 0xffff0000u) : (wc_ << 16)),
                            nv_ = __uint_as_float((x & 1) ? (wn_ & 0xffff0000u) : (wn_ << 16));
                o[x] = SH[ch + x] * pv_ * mp + SH[1920 + ch + x] * cv_ + SH[3840 + ch + x] * nv_ * mn;
            }
            return o;
        };
        bf16x8 wa[12]; u32x2 zr[3][3];
        auto issue = [&](int idx) {
            const int h = hg + 4 * (idx >> 2), nt = idx & 3;
            const int n = h * 64 + (nt >> 1) * 32 + 8 * (fr >> 2) + 4 * (nt & 1) + (fr & 3), ch = h * 64 + (nt >> 1) * 32 + 8 * fq + 4 * (nt & 1);
#pragma unroll
            for (int m = 0; m < 4; ++m)
#pragma unroll
                for (int ks = 0; ks < 2; ++ks) wa[m * 2 + ks] = *(const bf16x8*)(a.WLR + (size_t)m * 32768 + n * 64 + ks * 32 + fq * 8);
#pragma unroll
            for (int ks = 0; ks < 4; ++ks) wa[8 + ks] = *(const bf16x8*)(a.WLR + 131072 + (size_t)n * 128 + ks * 32 + fq * 8);
#pragma unroll
            for (int arr = 0; arr < 3; ++arr) {
                zr[arr][0] = *(const u32x2*)(zpv + arr * 512 + ch); zr[arr][1] = *(const u32x2*)(zc + arr * 512 + ch); zr[arr][2] = *(const u32x2*)(znx + arr * 512 + ch);
            }
        };
        issue(i0);
        float rn = 0.f, br0 = 0.f, kr0 = 0.f, br1 = 0.f, kr1 = 0.f, bonus = 0.f;
        u32x2 sv_pv = {0u, 0u}, sv_kk = {0u, 0u}, sv_ab[2] = {{0u, 0u}, {0u, 0u}}, sv_ke[2] = {{0u, 0u}, {0u, 0u}}, sv_wr[2] = {{0u, 0u}, {0u, 0u}};
#pragma unroll 1
        for (int idx = i0; idx < i1; ++idx) {
            const int h = hg + 4 * (idx >> 2), nt = idx & 3;
            const bool odd = nt & 1;
            auto emit = [&](bf16_t* dst, u32x2& stash, float x0, float x1, float x2, float x3) {
                u32x2 w; w.x = cvt_pk_bf16(x0, x1); w.y = cvt_pk_bf16(x2, x3);
                if (odd) { u32x4 q; q.x = stash.x; q.y = stash.y; q.z = w.x; q.w = w.y; *(u32x4*)(dst - 4) = q; }
                else stash = w;
            };
            if (nt == 0) {
                u32x2 zk[4][3];
#pragma unroll
                for (int q = 0; q < 4; ++q) { const int ch = 512 + h * 64 + q * 16 + fq * 4; zk[q][0] = *(const u32x2*)(zpv + ch); zk[q][1] = *(const u32x2*)(zc + ch); zk[q][2] = *(const u32x2*)(znx + ch); }
                float ssk = 0.f;
#pragma unroll
                for (int q = 0; q < 4; ++q) {
                    const int chh = h * 64 + q * 16 + fq * 4;
                    const f32x4 kq4 = conv_from(zk[q], 512 + chh) * *(const f32x4*)(PT + chh);
                    ssk += kq4[0] * kq4[0] + kq4[1] * kq4[1] + kq4[2] * kq4[2] + kq4[3] * kq4[3];
                }
                ssk += __shfl_xor(ssk, 16); ssk += __shfl_xor(ssk, 32);
                rn = rsqrtf(ssk + EPSF);
                br0 = 0.f; kr0 = 0.f; br1 = 0.f; kr1 = 0.f; bonus = 0.f;
            }
            f32x4 acc[5];
#pragma unroll
            for (int m = 0; m < 5; ++m) acc[m] = (f32x4){0.f, 0.f, 0.f, 0.f};
#pragma unroll
            for (int m = 0; m < 4; ++m)
#pragma unroll
                for (int ks = 0; ks < 2; ++ks) acc[m] = __builtin_amdgcn_mfma_f32_16x16x32_bf16(wa[m * 2 + ks], *(const bf16x8*)(fbp + (m * 2 + ks) * 32), acc[m], 0, 0, 0);
#pragma unroll
            for (int ks = 0; ks < 4; ++ks) acc[4] = __builtin_amdgcn_mfma_f32_16x16x32_bf16(wa[8 + ks], *(const bf16x8*)(fbp + (8 + ks) * 32), acc[4], 0, 0, 0);
            const int ch = h * 64 + (nt >> 1) * 32 + 8 * fq + 4 * (nt & 1);
            const f32x4 rv = conv_from(zr[0], ch), kv = conv_from(zr[1], 512 + ch), vv = conv_from(zr[2], 1024 + ch);
            if (idx + 1 < i1) issue(idx + 1);
            const f32x4 kn = kv * *(const f32x4*)(PT + ch) * rn;
            const size_t o = (size_t)r * 512 + ch;
            emit(a.PV + o, sv_pv, vv[0], vv[1], vv[2], vv[3]);
            *(f32x4*)(a.PG + o) = acc[4];
            emit(a.PKK + o, sv_kk, kn[0], kn[1], kn[2], kn[3]);
            const f32x4 kav = *(const f32x4*)(PT + 512 + ch), rkv = *(const f32x4*)(PT + 1024 + ch);
#pragma unroll
            for (int d = 0; d < 2; ++d) {
                const size_t od = (size_t)d * NTOK * 512 + o;
                const f32x4 w0v = *(const f32x4*)(PT + 1536 + d * 512 + ch), a0v = *(const f32x4*)(PT + 2560 + d * 512 + ch);
                f32x4 wv; float ab[4], ke[4], wr[4];
                float brs = 0.f, krs = 0.f;
#pragma unroll
                for (int x = 0; x < 4; ++x) {
                    const float pw = acc[d][x] + w0v[x], pa = acc[2 + d][x] + a0v[x];
                    const float sp_ = fmaxf(-pw, 0.0f) + flog_(1.0f + fexp_(-fabsf(pw)));
                    const float w = fexp_(-fexp_(-sp_ - 0.5f));
                    const float av = fsigmoid_(pa);
                    wv[x] = w;
                    ke[x] = kv[x] * (1.0f + (av - 1.0f) * kav[x]);
                    ab[x] = kn[x] * av;
                    wr[x] = w * rv[x];
                    brs += ab[x] * rv[x]; krs += ke[x] * rv[x]; bonus += rv[x] * ke[x] * rkv[x];
                }
                if (d == 0) { br0 += brs; kr0 += krs; } else { br1 += brs; kr1 += krs; }
                *(f32x4*)(a.PW + od) = wv;
                emit(a.PAB + od, sv_ab[d], ab[0], ab[1], ab[2], ab[3]);
                emit(a.PKE + od, sv_ke[d], ke[0], ke[1], ke[2], ke[3]);
                emit(a.PWR + od, sv_wr[d], wr[0], wr[1], wr[2], wr[3]);
            }
            if (nt == 3) {
#pragma unroll
                for (int o2 = 16; o2 < 64; o2 <<= 1) { br0 += __shfl_xor(br0, o2); kr0 += __shfl_xor(kr0, o2); br1 += __shfl_xor(br1, o2); kr1 += __shfl_xor(kr1, o2); bonus += __shfl_xor(bonus, o2); }
                if (fq == 0) {
                    float* sc0 = a.PSC + ((size_t)r) * 16 + h * 2; sc0[0] = br0; sc0[1] = kr0;
                    float* sc1 = a.PSC + ((size_t)NTOK + r) * 16 + h * 2; sc1[0] = br1; sc1[1] = kr1;
                    a.PBON[(size_t)r * 8 + h] = bonus;
                }
            }
        }
    }
}

#define RW_NB 32
template <int CTRL> __device__ __forceinline__ float dppf(float v) { return __int_as_float(__builtin_amdgcn_update_dpp(0, __float_as_int(v), CTRL, 0xF, 0xF, true)); }
__device__ __forceinline__ int rw_row(int b, int dir, int s) {
    if (s < TC) return b * TC + (dir ? (TC - 1 - s) : s);
    const int s2 = s - TC; return NCTX + b * TL + (dir ? (TL - 1 - s2) : s2);
}
#define RW2_STR 400
__device__ __forceinline__ void ph_l1_rwkv2(const L1Args& a, int bi, int nblk) {
    float* OUT = (float*)g_shm;
    float* BUF = OUT + 2 * RW_NB * 32;
    const int tid = tid_fresh(), wid = tid >> 6, lane = tid & 63;
    constexpr int NBT = (TC + TL) / RW_NB;
    constexpr int NPC = 53;
    typedef float f32x2 __attribute__((ext_vector_type(2)));
    for (int u = bi; u < 128; u += nblk) {
        const int seq = u >> 1, half = u & 1;
        const int dir = seq & 1, h = (seq >> 1) & 7, b = seq >> 4;
        const size_t dof = (size_t)dir * NTOK * 512;
        const int lt = tid - 256, lw = lt >> 6, ll = lt & 63;
        const int sgn = dir ? -1 : 1;
        const char* gb0 = (const char*)a.PKK;
        const int p32 = lt & 31, qa = p32 >> 3, ca = p32 & 7, s0 = lt >> 5;
        const bf16_t* arrA = qa == 0 ? a.PKK : (qa == 1 ? a.PAB + dof : (qa == 2 ? a.PKE + dof : a.PWR + dof));
        const unsigned offA = (unsigned)(size_t)((const char*)(arrA + h * 64 + ca * 8) - gb0) + (unsigned)(sgn * s0) * 1024u;
        const int dA = s0 * RW2_STR + (qa == 0 ? 0 : 64 + qa * 64) + ca * 8;
        unsigned offX = 0u, offD = 0u; int dX = 0;
        if (lw < 2) { const int c = lt & 15, s1 = lt >> 4;
            offX = (unsigned)(size_t)((const char*)(a.PW + dof + h * 64 + c * 4) - gb0) + (unsigned)(sgn * s1) * 2048u; dX = s1 * RW2_STR + 64 + c * 4; }
        else if (lw == 2) { const int c = ll & 3, s3 = ll >> 2;
            offX = (unsigned)(size_t)((const char*)(a.PV + h * 64 + half * 32 + c * 8) - gb0) + (unsigned)(sgn * s3) * 1024u; dX = s3 * RW2_STR + 320 + c * 16;
            offD = (unsigned)(size_t)((const char*)(a.PSC + (size_t)dir * NTOK * 16 + h * 2) - gb0) + (unsigned)(sgn * ll) * 64u; }
        const unsigned offF = (unsigned)((dof + (size_t)h * 64 + half * 32 + (ll & 7) * 4) * 4) + (unsigned)(sgn * (ll >> 3)) * 2048u;
        u32x4 raw[8];
        auto issue = [&](int bt) {
            const unsigned rowb = (unsigned)rw_row(b, dir, bt * RW_NB);
            const unsigned oA = offA + rowb * 1024u, stA = (unsigned)(sgn * 8) * 1024u;
#pragma unroll
            for (int j = 0; j < 4; ++j) raw[j] = *(const u32x4*)(gb0 + (size_t)(oA + (unsigned)j * stA));
            if (lw < 2) {
                const unsigned oX = offX + rowb * 2048u, stX = (unsigned)(sgn * 8) * 2048u;
#pragma unroll
                for (int j = 0; j < 4; ++j) raw[4 + j] = *(const u32x4*)(gb0 + (size_t)(oX + (unsigned)j * stX));
            } else if (lw == 2) {
                const unsigned oX = offX + rowb * 1024u, stX = (unsigned)(sgn * 16) * 1024u;
#pragma unroll
                for (int j = 0; j < 2; ++j) raw[4 + j] = *(const u32x4*)(gb0 + (size_t)(oX + (unsigned)j * stX));
                if (ll < 32) { const u32x2 t2 = *(const u32x2*)(gb0 + (size_t)(offD + rowb * 64u)); raw[6].x = t2.x; raw[6].y = t2.y; }
            }
        };
        auto cvt8 = [&](const u32x4 w, f32x4& l4, f32x4& h4) {
            l4[0] = __uint_as_float(w.x << 16); l4[1] = __uint_as_float(w.x & 0xffff0000u); l4[2] = __uint_as_float(w.y << 16); l4[3] = __uint_as_float(w.y & 0xffff0000u);
            h4[0] = __uint_as_float(w.z << 16); h4[1] = __uint_as_float(w.z & 0xffff0000u); h4[2] = __uint_as_float(w.w << 16); h4[3] = __uint_as_float(w.w & 0xffff0000u);
        };
        auto commit = [&](int bt) {
            float* bb = BUF + (bt & 1) * RW_NB * RW2_STR;
#pragma unroll
            for (int j = 0; j < 4; ++j) {
                f32x4 l4, h4; cvt8(raw[j], l4, h4);
                float* d = bb + dA + 8 * j * RW2_STR;
                *(f32x4*)d = l4; *(f32x4*)(d + 4) = h4;
            }
            if (lw < 2) {
#pragma unroll
                for (int j = 0; j < 4; ++j) *(u32x4*)(bb + dX + 8 * j * RW2_STR) = raw[4 + j];
            } else if (lw == 2) {
#pragma unroll
                for (int j = 0; j < 2; ++j) {
                    f32x4 l4, h4; cvt8(raw[4 + j], l4, h4);
                    float* d = bb + dX + 16 * j * RW2_STR;
                    *(f32x4*)d = (f32x4){l4[0], l4[1], l4[1], l4[0]}; *(f32x4*)(d + 4) = (f32x4){l4[2], l4[3], l4[3], l4[2]};
                    *(f32x4*)(d + 8) = (f32x4){h4[0], h4[1], h4[1], h4[0]}; *(f32x4*)(d + 12) = (f32x4){h4[2], h4[3], h4[3], h4[2]};
                }
                if (ll < 32) { u32x2 t2; t2.x = raw[6].x; t2.y = raw[6].y; *(u32x2*)(bb + ll * RW2_STR + 384) = t2; }
            }
        };
        auto flush = [&](int bt) {
            if (lw == 3) {
                const unsigned rowb = (unsigned)rw_row(b, dir, bt * RW_NB);
                const unsigned oF = offF + rowb * 2048u, stF = (unsigned)(sgn * 8) * 2048u;
#pragma unroll
                for (int r = 0; r < 4; ++r) {
                    const f32x4 v4 = *(const f32x4*)(OUT + (bt & 1) * RW_NB * 32 + (ll + 64 * r) * 4);
                    *(f32x4*)((char*)a.RWO + (size_t)(oF + (unsigned)r * stF)) = v4;
                }
            }
        };
        __syncthreads();
        if (wid >= 4) { issue(0); commit(0); issue(1); }
        f32x2 S0 = {0.f, 0.f}, S1 = {0.f, 0.f}, S2 = {0.f, 0.f}, S3 = {0.f, 0.f};
        const int dr = lane >> 4, l16 = lane & 15, rp = (wid & 3) * 4 + dr, hi8 = l16 >> 3;
        const int vo = 320 + rp * 4 + hi8 * 2, oo = rp * 2 + hi8;
        for (int bt = 0; bt < NBT; ++bt) {
            asm volatile("s_waitcnt lgkmcnt(0)" ::: "memory");
            __builtin_amdgcn_s_barrier();
            asm volatile("" ::: "memory");
            if (wid >= 4) {
                if (bt + 1 < NBT) commit(bt + 1);
                if (bt + 2 < NBT) issue(bt + 2);
                if (bt > 0) flush(bt - 1);
            } else {
                const float* base = BUF + (bt & 1) * RW_NB * RW2_STR;
                float* outp = OUT + (bt & 1) * RW_NB * 32 + oo;
                const float* bs = base;
                f32x4 kk4 = *(const f32x4*)(bs + l16 * 4), w4 = *(const f32x4*)(bs + 64 + l16 * 4), ab4 = *(const f32x4*)(bs + 128 + l16 * 4),
                      ke4 = *(const f32x4*)(bs + 192 + l16 * 4), wr4 = *(const f32x4*)(bs + 256 + l16 * 4);
                f32x2 v2 = *(const f32x2*)(bs + vo), sc2 = *(const f32x2*)(bs + 384);
#pragma unroll
                for (int si = 0; si < RW_NB; ++si) {
                    const float* bn = base + (si + 1 < RW_NB ? si + 1 : si) * RW2_STR;
                    const f32x4 nkk4 = *(const f32x4*)(bn + l16 * 4), nw4 = *(const f32x4*)(bn + 64 + l16 * 4), nab4 = *(const f32x4*)(bn + 128 + l16 * 4),
                                nke4 = *(const f32x4*)(bn + 192 + l16 * 4), nwr4 = *(const f32x4*)(bn + 256 + l16 * 4);
                    const f32x2 nv2 = *(const f32x2*)(bn + vo), nsc2 = *(const f32x2*)(bn + 384);
                    float o;
                    asm volatile(
                        "v_pk_mul_f32 v[236:237], %[S0], %[kkl] op_sel_hi:[1,0]\n\t"
                        "v_pk_mul_f32 v[238:239], %[S0], %[wrl] op_sel_hi:[1,0]\n\t"
                        "v_pk_fma_f32 v[236:237], %[S1], %[kkl], v[236:237] op_sel:[0,1,0]\n\t"
                        "v_pk_fma_f32 v[238:239], %[S1], %[wrl], v[238:239] op_sel:[0,1,0]\n\t"
                        "v_pk_fma_f32 v[236:237], %[S2], %[kkh], v[236:237] op_sel_hi:[1,0,1]\n\t"
                        "v_pk_fma_f32 v[238:239], %[S2], %[wrh], v[238:239] op_sel_hi:[1,0,1]\n\t"
                        "v_pk_fma_f32 v[236:237], %[S3], %[kkh], v[236:237] op_sel:[0,1,0]\n\t"
                        "v_pk_fma_f32 v[238:239], %[S3], %[wrh], v[238:239] op_sel:[0,1,0]\n\t"
                        "v_pk_mul_f32 v[244:245], %[S0], %[wl] op_sel_hi:[1,0]\n\t"
                        "v_add_f32_dpp v240, v237, v236 row_ror:8 row_mask:0xf bank_mask:0xf bound_ctrl:1\n\t"
                        "v_add_f32_dpp v242, v239, v238 row_ror:8 row_mask:0xf bank_mask:0xf bound_ctrl:1\n\t"
                        "v_pk_mul_f32 v[246:247], %[S1], %[wl] op_sel:[0,1]\n\t"
                        "v_add_f32_dpp v240, v240, v240 quad_perm:[1,0,3,2] row_mask:0xf bank_mask:0xf bound_ctrl:1\n\t"
                        "v_add_f32_dpp v242, v242, v242 quad_perm:[1,0,3,2] row_mask:0xf bank_mask:0xf bound_ctrl:1\n\t"
                        "v_pk_mul_f32 v[248:249], %[S2], %[wh] op_sel_hi:[1,0]\n\t"
                        "v_add_f32_dpp v240, v240, v240 quad_perm:[2,3,0,1] row_mask:0xf bank_mask:0xf bound_ctrl:1\n\t"
                        "v_add_f32_dpp v242, v242, v242 quad_perm:[2,3,0,1] row_mask:0xf bank_mask:0xf bound_ctrl:1\n\t"
                        "v_pk_mul_f32 v[250:251], %[S3], %[wh] op_sel:[0,1]\n\t"
                        "v_add_f32_dpp v240, v240, v240 row_half_mirror row_mask:0xf bank_mask:0xf bound_ctrl:1\n\t"
                        "v_add_f32_dpp v242, v242, v242 row_half_mirror row_mask:0xf bank_mask:0xf bound_ctrl:1\n\t"
                        "v_pk_fma_f32 v[244:245], %[v2], %[kel], v[244:245] op_sel_hi:[1,0,1]\n\t"
                        "v_mov_b32_dpp v241, v240 row_ror:8 row_mask:0xf bank_mask:0xf bound_ctrl:1\n\t"
                        "v_pk_fma_f32 v[246:247], %[v2], %[kel], v[246:247] op_sel:[0,1,0]\n\t"
                        "v_pk_fma_f32 v[248:249], %[v2], %[keh], v[248:249] op_sel_hi:[1,0,1]\n\t"
                        "v_pk_fma_f32 %[S0], v[240:241], %[abl], v[244:245] op_sel_hi:[1,0,1] neg_lo:[1,0,0] neg_hi:[1,0,0]\n\t"
                        "v_pk_fma_f32 v[250:251], %[v2], %[keh], v[250:251] op_sel:[0,1,0]\n\t"
                        "v_pk_fma_f32 %[S1], v[240:241], %[abl], v[246:247] op_sel:[0,1,0] neg_lo:[1,0,0] neg_hi:[1,0,0]\n\t"
                        "v_fma_f32 v243, -v240, %[br], v242\n\t"
                        "v_pk_fma_f32 %[S2], v[240:241], %[abh], v[248:249] op_sel_hi:[1,0,1] neg_lo:[1,0,0] neg_hi:[1,0,0]\n\t"
                        "v_fma_f32 %[o], %[vx], %[kr], v243\n\t"
                        "v_pk_fma_f32 %[S3], v[240:241], %[abh], v[250:251] op_sel:[0,1,0] neg_lo:[1,0,0] neg_hi:[1,0,0]"
                        : [S0] "+v"(S0), [S1] "+v"(S1), [S2] "+v"(S2), [S3] "+v"(S3), [o] "=&v"(o)
                        : [kkl] "v"(__builtin_shufflevector(kk4, kk4, 0, 1)), [kkh] "v"(__builtin_shufflevector(kk4, kk4, 2, 3)),
                          [wrl] "v"(__builtin_shufflevector(wr4, wr4, 0, 1)), [wrh] "v"(__builtin_shufflevector(wr4, wr4, 2, 3)),
                          [wl] "v"(__builtin_shufflevector(w4, w4, 0, 1)), [wh] "v"(__builtin_shufflevector(w4, w4, 2, 3)),
                          [abl] "v"(__builtin_shufflevector(ab4, ab4, 0, 1)), [abh] "v"(__builtin_shufflevector(ab4, ab4, 2, 3)),
                          [kel] "v"(__builtin_shufflevector(ke4, ke4, 0, 1)), [keh] "v"(__builtin_shufflevector(ke4, ke4, 2, 3)),
                          [v2] "v"(v2), [vx] "v"(v2.x), [br] "v"(sc2.x), [kr] "v"(sc2.y)
                        : "v236", "v237", "v238", "v239", "v240", "v241", "v242", "v243", "v244", "v245", "v246", "v247", "v248", "v249", "v250", "v251");
                    outp[si * 32] = o;
                    kk4 = nkk4; w4 = nw4; ab4 = nab4; ke4 = nke4; wr4 = nwr4; v2 = nv2; sc2 = nsc2;
                }
            }
        }
        __syncthreads();
        if (wid >= 4) flush(NBT - 1);
    }
}
__device__ __forceinline__ void ph_l1_rwmerge(const L1Args& a) {
    const int tid = tid_fresh();
    const int sub = tid >> 7, c4 = (tid & 127) * 4, h = c4 >> 6;
    const f32x4 nw = *(const f32x4*)(a.rw_norm + c4);
    struct In { f32x4 yf, yb, g; u32x2 v; float bon; };
    auto load = [&](int r, In& x) {
        const size_t o = (size_t)r * 512 + c4;
        x.yf = *(const f32x4*)(a.RWO + o); x.yb = *(const f32x4*)(a.RWO + (size_t)NTOK * 512 + o);
        x.g = *(const f32x4*)(a.PG + o); x.v = *(const u32x2*)(a.PV + o); x.bon = a.PBON[(size_t)r * 8 + h];
    };
    const int stride = gridDim.x * 4;
    int r = NCTX + blockIdx.x * 4 + sub;
    In cur, nxt;
    if (r < NTOK) load(r, cur);
    for (; r < NTOK; r += stride) {
        if (r + stride < NTOK) load(r + stride, nxt);
        const f32x4 v = cur.yf + cur.yb;
        float ss = v[0] * v[0] + v[1] * v[1] + v[2] * v[2] + v[3] * v[3];
        ss += __shfl_xor(ss, 1); ss += __shfl_xor(ss, 2); ss += __shfl_xor(ss, 4); ss += __shfl_xor(ss, 8);
        const float rs = rsqrtf(ss * (1.0f / 64.0f) + EPSF);
        const float p0 = __uint_as_float(cur.v.x << 16), p1 = __uint_as_float(cur.v.x & 0xffff0000u), p2 = __uint_as_float(cur.v.y << 16), p3 = __uint_as_float(cur.v.y & 0xffff0000u);
        st_bf16x4(a.MG + (size_t)r * DM + 512 + c4, (v[0] * rs * nw[0] + cur.bon * p0) * cur.g[0], (v[1] * rs * nw[1] + cur.bon * p1) * cur.g[1],
                  (v[2] * rs * nw[2] + cur.bon * p2) * cur.g[2], (v[3] * rs * nw[3] + cur.bon * p3) * cur.g[3]);
        cur = nxt;
    }
}

struct ConvArgs { const float* ab_in; const float* ab_out; const float* cd_in; const float* cd_out; const float* wgu; const float* wdn;
                  bf16_t* ab_inT; bf16_t* ab_outT; bf16_t* cd_inT; bf16_t* cd_outT; bf16_t* wguT; bf16_t* wdnT; };


#define XB_TMO      128
#define XB_XCNT(j)  (256  + 64 * (j))
#define XB_XSUB(j)  (1280 + 64 * (j))
#define XB_XGEN(j)  (2304 + 64 * (j))
#define XB_TOP      3328
#define XB_TOPGEN   3392
#define XCD_BAR_WORDS 3456
#define XB_SPIN_CAP (1u << 18)
#define LAS __attribute__((address_space(3)))

__device__ __forceinline__ unsigned xb_ld(unsigned* p)              { return __hip_atomic_load(p, __ATOMIC_RELAXED, __HIP_MEMORY_SCOPE_AGENT); }
__device__ __forceinline__ unsigned xb_add(unsigned* p, unsigned v) { return __hip_atomic_fetch_add(p, v, __ATOMIC_RELAXED, __HIP_MEMORY_SCOPE_AGENT); }
__device__ __forceinline__ unsigned xb_xcc_id() { return (unsigned)__builtin_amdgcn_s_getreg((3 << 11) | 20) & 0xFu; }
#define XB_SPIN(cond, bar) do { unsigned _sp = 0; while (cond) { __builtin_amdgcn_s_sleep(1); \
    if ((++_sp & 255u) == 0u) { if (xb_ld(&(bar)[XB_TMO])) break; if (_sp > XB_SPIN_CAP) { atomicAdd(&(bar)[XB_TMO], 1u); break; } } } } while (0)

struct XcdBarrier {
    unsigned* bar; unsigned x;
    volatile LAS unsigned* st;
};

__device__ __forceinline__ XcdBarrier xcd_barrier_post(unsigned* bar, volatile LAS unsigned* st) {
    XcdBarrier b; b.bar = bar; b.x = xb_xcc_id(); b.st = st;
    if (threadIdx.x == 0) (void)xb_add(&bar[XB_XCNT(b.x)], 1u);
    return b;
}
__device__ __forceinline__ void xcd_barrier_complete(unsigned* bar, unsigned x, unsigned& nloc, unsigned& nx) {
    const unsigned G = gridDim.x * gridDim.y * gridDim.z;
    unsigned sum, cnt, mine, sp = 0u;
    for (;;) {
        sum = 0u; cnt = 0u; mine = 0u;
#pragma unroll
        for (unsigned j = 0; j < 16; ++j) { const unsigned c = xb_ld(&bar[XB_XCNT(j)]); sum += c; cnt += (c > 0u) ? 1u : 0u; mine = (j == x) ? c : mine; }
        if (sum == G) break;
        __builtin_amdgcn_s_sleep(1);
        if ((++sp & 255u) == 0u) { if (xb_ld(&bar[XB_TMO])) break; if (sp > XB_SPIN_CAP) { atomicAdd(&bar[XB_TMO], 1u); break; } }
    }
    nloc = mine > 0u ? mine : 1u; nx = cnt > 0u ? cnt : 1u;
}

__device__ __forceinline__ void xcd_barrier(const XcdBarrier& b) {
    asm volatile("s_waitcnt vmcnt(0)" ::: "memory");
    __syncthreads();
    if (threadIdx.x == 0) {
        unsigned* bar = b.bar;
        __builtin_amdgcn_s_waitcnt(0);
        unsigned nloc = b.st[0], nx = b.st[1];
        if (nloc == 0u) { xcd_barrier_complete(bar, b.x, nloc, nx); b.st[0] = nloc; b.st[1] = nx; }
        const unsigned old = xb_add(&bar[XB_XSUB(b.x)], 1u);
        const unsigned gen = old / nloc;
        if (old + 1u == (gen + 1u) * nloc) {
            __builtin_amdgcn_fence(__ATOMIC_RELEASE, "agent");
            asm volatile("s_waitcnt vmcnt(0)" ::: "memory");
            const unsigned og = xb_add(&bar[XB_TOP], 1u);
            const unsigned tg = og / nx;
            if (og + 1u == (tg + 1u) * nx) xb_add(&bar[XB_TOPGEN], 1u);
            else XB_SPIN(xb_ld(&bar[XB_TOPGEN]) == tg, bar);
            __builtin_amdgcn_fence(__ATOMIC_ACQUIRE, "agent");
            xb_add(&bar[XB_XGEN(b.x)], 1u);
            asm volatile("s_waitcnt vmcnt(0)" ::: "memory");
        } else {
            XB_SPIN(xb_ld(&bar[XB_XGEN(b.x)]) == gen, bar);
            __builtin_amdgcn_fence(__ATOMIC_ACQUIRE, "agent");
            asm volatile("s_waitcnt vmcnt(0)" ::: "memory");
        }
    }
    __syncthreads();
}


__device__ __forceinline__ void sub_barrier(unsigned* bar, int word, unsigned n) {
    asm volatile("s_waitcnt vmcnt(0)" ::: "memory");
    __syncthreads();
    if (threadIdx.x == 0) {
        __builtin_amdgcn_s_waitcnt(0);
        __builtin_amdgcn_fence(__ATOMIC_RELEASE, "agent");
        asm volatile("s_waitcnt vmcnt(0)" ::: "memory");
        (void)xb_add(&bar[word], 1u);
        XB_SPIN(xb_ld(&bar[word]) < n, bar);
        __builtin_amdgcn_fence(__ATOMIC_ACQUIRE, "agent");
        asm volatile("s_waitcnt vmcnt(0)" ::: "memory");
    }
    __syncthreads();
}

struct FwdParams {
    const float* x; const float* c; const float* ctx; const float* c_ctx; const float* mod_w; const float* mod_b;
    const float* norm_mix; const float* norm_ffn; const float* norm_final;
    const float* router_w; const float* router_b; const float* bgu; const float* bdn;
    float* out;
    unsigned* bar; int* meta;
    float* mvec; float* H; bf16_t* Ub; bf16_t* ZB; float* P; float* Y;
    int* top_e; float* top_w; int* slot_of; int* list;
    float* slot_w;
    bf16_t* ab_inT; bf16_t* ab_outT; bf16_t* cd_inT; bf16_t* cd_outT; bf16_t* wguT; bf16_t* wdnT;
    ConvArgs cv; L0Args l0; L1Args l1;
};
#define LIST_INTS (NTOK * 4 + NEXP * 256)

__device__ __forceinline__ void ph_mod(const FwdParams& p) {
    float* sc = (float*)g_shm;
    float* part = sc + 5 * 1024;
    const int tid = tid_fresh();
    __syncthreads();
    for (int i = tid; i < 5 * 1024; i += NTHR) { const int b = i >> 10, k = i & 1023; sc[i] = siluf_(b < 4 ? p.c[b * 1024 + k] : p.c_ctx[k]); }
    __syncthreads();
    for (int cg = blockIdx.x; cg < 256; cg += gridDim.x) {
        const int colidx0 = cg * 48, layer = colidx0 / 6144, col0 = colidx0 % 6144;
        if (tid < 384) {
            const int cl = tid % 48, kp = tid / 48;
            const float* W = p.mod_w + (size_t)layer * 1024 * 6144 + col0 + cl;
            float a0 = 0.f, a1 = 0.f, a2 = 0.f, a3 = 0.f, a4 = 0.f;
#pragma unroll 8
            for (int k = kp * 128; k < kp * 128 + 128; ++k) {
                const float w = W[(size_t)k * 6144];
                a0 += sc[k] * w; a1 += sc[1024 + k] * w; a2 += sc[2048 + k] * w; a3 += sc[3072 + k] * w; a4 += sc[4096 + k] * w;
            }
            float* pp = part + (kp * 48 + cl) * 5;
            pp[0] = a0; pp[1] = a1; pp[2] = a2; pp[3] = a3; pp[4] = a4;
        }
        __syncthreads();
        if (tid < 240) {
            const int cl = tid / 5, rr = tid % 5;
            float sum = p.mod_b[layer * 6144 + col0 + cl];
#pragma unroll
            for (int kp = 0; kp < 8; ++kp) sum += part[(kp * 48 + cl) * 5 + rr];
            p.mvec[((size_t)layer * 5 + rr) * 6144 + col0 + cl] = sum;
        }
        __syncthreads();
    }
}
__device__ __forceinline__ const float* row_src(const float* src_ctx, const float* src_lat, int r) { return r < NCTX ? src_ctx + (size_t)r * DM : src_lat + (size_t)(r - NCTX) * DM; }
__device__ __forceinline__ int row_mrow(int r) { return r < NCTX ? 4 : (r - NCTX) / TL; }
__device__ __forceinline__ void ph_normmod(const float* src_ctx, const float* src_lat, const float* gain, const float* mvl, int row0, int row1, bf16_t* out) {
    const int tfz = tid_fresh(); const int wid = tfz >> 6, lane = tfz & 63;
    const int stride = gridDim.x * 8;
    int r = row0 + blockIdx.x * 8 + wid;
    float4 x[4], xn[4];
    if (r < row1) { const float4* src = (const float4*)row_src(src_ctx, src_lat, r);
#pragma unroll
        for (int i = 0; i < 4; ++i) x[i] = src[lane + 64 * i]; }
    for (; r < row1; r += stride) {
        const int rn = r + stride;
        if (rn < row1) { const float4* src = (const float4*)row_src(src_ctx, src_lat, rn);
#pragma unroll
            for (int i = 0; i < 4; ++i) xn[i] = src[lane + 64 * i]; }
        const float* mv = mvl + (size_t)row_mrow(r) * 6144;
        float ss = 0.f;
#pragma unroll
        for (int i = 0; i < 4; ++i) ss += x[i].x * x[i].x + x[i].y * x[i].y + x[i].z * x[i].z + x[i].w * x[i].w;
        const float rs = rsqrtf(wave_sum(ss) * (1.0f / DM) + EPSF);
#pragma unroll
        for (int i = 0; i < 4; ++i) {
            const int c4 = lane + 64 * i;
            const float4 g = ((const float4*)gain)[c4], sh = ((const float4*)mv)[c4], sc = ((const float4*)(mv + 1024))[c4];
            st_bf16x4(out + (size_t)r * DM + c4 * 4, x[i].x * rs * g.x * (1.0f + sc.x) + sh.x, x[i].y * rs * g.y * (1.0f + sc.y) + sh.y,
                      x[i].z * rs * g.z * (1.0f + sc.z) + sh.z, x[i].w * rs * g.w * (1.0f + sc.w) + sh.w);
        }
#pragma unroll
        for (int i = 0; i < 4; ++i) x[i] = xn[i];
    }
}
__device__ __forceinline__ void ph_norm_router(const FwdParams& p, int layer, int row0, int row1) {
    float* RW = (float*)g_shm;
    float* lgs = RW + 1024 * 32;
    int* hist = (int*)(lgs + 8 * 32);
    const int tid = tid_fresh(), wid = tid >> 6, lane = tid & 63;
    const float* mvl = p.mvec + (size_t)layer * 5 * 6144;
    const float* gain = p.norm_ffn + layer * DM;
    const float* rw = p.router_w + (size_t)layer * 1024 * 32;
    const float* rb = p.router_b + layer * 32;
    int* meta = p.meta + layer * 128;
    __syncthreads();
    if (tid < 32) hist[tid] = 0;
    for (int i = tid; i < 1024 * 8; i += NTHR) {
        const int k = i >> 3, c8 = i & 7;
        const int i2 = k >> 5, kq = (k >> 2) & 7, c = k & 3;
        *(float4*)(RW + (32 * i2 + 8 * c + kq) * 32 + c8 * 4) = *(const float4*)(rw + k * 32 + c8 * 4);
    }
    __syncthreads();
    const int e4 = lane & 7, kq = lane >> 3;
    const int stride = gridDim.x * 8;
    int r = row0 + blockIdx.x * 8 + wid;
    float4 hn[4];
    if (r < row1) {
#pragma unroll
        for (int i = 0; i < 4; ++i) hn[i] = ((const float4*)(p.H + (size_t)r * DM))[lane + 64 * i]; }
    for (; r < row1; r += stride) {
        const float* mv = mvl + (size_t)row_mrow(r) * 6144;
        float4 hh[4]; float ss = 0.f;
#pragma unroll
        for (int i = 0; i < 4; ++i) {
            hh[i] = hn[i];
            ss += hh[i].x * hh[i].x + hh[i].y * hh[i].y + hh[i].z * hh[i].z + hh[i].w * hh[i].w;
        }
        if (r + stride < row1) {
#pragma unroll
            for (int i = 0; i < 4; ++i) hn[i] = ((const float4*)(p.H + (size_t)(r + stride) * DM))[lane + 64 * i]; }
        const float rs = rsqrtf(wave_sum(ss) * (1.0f / DM) + EPSF);
#pragma unroll
        for (int i = 0; i < 4; ++i) {
            const int c4 = lane + 64 * i;
            const float4 g = ((const float4*)gain)[c4], sh = ((const float4*)(mv + 3072))[c4], sc = ((const float4*)(mv + 4096))[c4];
            hh[i].x = hh[i].x * rs * g.x * (1.0f + sc.x) + sh.x; hh[i].y = hh[i].y * rs * g.y * (1.0f + sc.y) + sh.y;
            hh[i].z = hh[i].z * rs * g.z * (1.0f + sc.z) + sh.z; hh[i].w = hh[i].w * rs * g.w * (1.0f + sc.w) + sh.w;
            st_bf16x4(p.Ub + (size_t)r * DM + c4 * 4, hh[i].x, hh[i].y, hh[i].z, hh[i].w);
        }
        float l0 = 0.f, l1 = 0.f, l2 = 0.f, l3 = 0.f;
#pragma unroll
        for (int i2 = 0; i2 < 32; ++i2) {
            const int srcl = kq + 8 * (i2 & 7);
            const float4 hv = hh[i2 >> 3];
            const float x0 = __shfl(hv.x, srcl), x1 = __shfl(hv.y, srcl), x2 = __shfl(hv.z, srcl), x3 = __shfl(hv.w, srcl);
            const float* wp = RW + (32 * i2 + kq) * 32 + e4 * 4;
            const float4 w0 = *(const float4*)wp, w1 = *(const float4*)(wp + 8 * 32), w2 = *(const float4*)(wp + 16 * 32), w3 = *(const float4*)(wp + 24 * 32);
            l0 += x0 * w0.x + x1 * w1.x + x2 * w2.x + x3 * w3.x;
            l1 += x0 * w0.y + x1 * w1.y + x2 * w2.y + x3 * w3.y;
            l2 += x0 * w0.z + x1 * w1.z + x2 * w2.z + x3 * w3.z;
            l3 += x0 * w0.w + x1 * w1.w + x2 * w2.w + x3 * w3.w;
        }
#pragma unroll
        for (int o = 8; o < 64; o <<= 1) { l0 += __shfl_xor(l0, o); l1 += __shfl_xor(l1, o); l2 += __shfl_xor(l2, o); l3 += __shfl_xor(l3, o); }
        if (lane < 8) { float* lg = lgs + wid * 32 + e4 * 4; lg[0] = l0 + rb[e4 * 4]; lg[1] = l1 + rb[e4 * 4 + 1]; lg[2] = l2 + rb[e4 * 4 + 2]; lg[3] = l3 + rb[e4 * 4 + 3]; }
        float val = (lane < 32) ? lgs[wid * 32 + lane] : -INFINITY;
        float tv[4]; int ti[4];
#pragma unroll
        for (int k = 0; k < 4; ++k) {
            float bv = val; int bi = lane;
#pragma unroll
            for (int o = 1; o < 64; o <<= 1) {
                const float ov = __shfl_xor(bv, o); const int oi = __shfl_xor(bi, o);
                if (ov > bv || (ov == bv && oi < bi)) { bv = ov; bi = oi; }
            }
            tv[k] = bv; ti[k] = bi;
            if (lane == bi) val = -INFINITY;
        }
        const float w0 = 1.0f, w1 = expf(tv[1] - tv[0]), w2 = expf(tv[2] - tv[0]), w3 = expf(tv[3] - tv[0]);
        const float inv = 1.0f / (w0 + w1 + w2 + w3);
        if (lane == 0) {
            *(int4*)(p.top_e + (size_t)r * 4) = make_int4(ti[0], ti[1], ti[2], ti[3]);
            *(float4*)(p.top_w + (size_t)r * 4) = make_float4(w0 * inv, w1 * inv, w2 * inv, w3 * inv);
            atomicAdd(&hist[ti[0]], 1); atomicAdd(&hist[ti[1]], 1); atomicAdd(&hist[ti[2]], 1); atomicAdd(&hist[ti[3]], 1);
        }
    }
    __syncthreads();
    if (tid < 32 && hist[tid] != 0) atomicAdd(&meta[tid], hist[tid]);
}
__device__ __forceinline__ void ph_assign(const FwdParams& p, int layer, int row0, int row1) {
    int* hist = (int*)g_shm; int* base = hist + 32; int* lcur = base + 32;
    const int tid = tid_fresh();
    int* meta = p.meta + layer * 128;
    int* list = p.list + (size_t)layer * LIST_INTS;
    __syncthreads();
    if (tid < 32) { hist[tid] = 0; lcur[tid] = 0; }
    __syncthreads();
    const int npairs = (row1 - row0) * 4;
    for (int i = blockIdx.x * NTHR + tid; i < npairs; i += gridDim.x * NTHR) atomicAdd(&hist[p.top_e[(size_t)row0 * 4 + i]], 1);
    __syncthreads();
    if (tid < 32) {
        int off = 0;
        for (int e = 0; e < tid; ++e) off += (meta[e] + 255) & ~255;
        if (blockIdx.x == 0) meta[64 + tid] = off;
        base[tid] = off + (hist[tid] ? atomicAdd(&meta[32 + tid], hist[tid]) : 0);
    }
    __syncthreads();
    for (int i = blockIdx.x * NTHR + tid; i < npairs; i += gridDim.x * NTHR) {
        const int e = p.top_e[(size_t)row0 * 4 + i];
        const int slot = base[e] + atomicAdd(&lcur[e], 1);
        list[slot] = row0 + (i >> 2);
        p.slot_of[(size_t)row0 * 4 + i] = slot;
        p.slot_w[slot] = p.top_w[(size_t)row0 * 4 + i];
    }
}
template <bool FINAL>
__device__ __forceinline__ void ph_combine(const FwdParams& p, int layer, int row0, int row1) {
    const int tfz = tid_fresh(); const int wid = tfz >> 6, lane = tfz & 63;
    const float* mvl = p.mvec + (size_t)layer * 5 * 6144;
    const bf16_t* YS = (const bf16_t*)p.P;
    const int stride = gridDim.x * 8;
    int r = row0 + blockIdx.x * 8 + wid;
    int4 sl_n = make_int4(0, 0, 0, 0);
    u32x2 ya[4][4], yn[4][4]; float4 ha[4], hnx[4];
    auto load_rows = [&](int rr, const int4& sl, u32x2 (&y)[4][4], float4 (&h)[4]) {
#pragma unroll
        for (int i = 0; i < 4; ++i) {
            const int c4 = lane + 64 * i;
            y[0][i] = *(const u32x2*)(YS + (size_t)sl.x * DM + c4 * 4); y[1][i] = *(const u32x2*)(YS + (size_t)sl.y * DM + c4 * 4);
            y[2][i] = *(const u32x2*)(YS + (size_t)sl.z * DM + c4 * 4); y[3][i] = *(const u32x2*)(YS + (size_t)sl.w * DM + c4 * 4);
            h[i] = ((const float4*)(p.H + (size_t)rr * DM))[c4];
        }
    };
    if (r < row1) {
        const int4 sl0 = *(const int4*)(p.slot_of + (size_t)r * 4);
        load_rows(r, sl0, ya, ha);
        if (r + stride < row1) sl_n = *(const int4*)(p.slot_of + (size_t)(r + stride) * 4);
    }
    for (; r < row1; r += stride) {
        const int rn = r + stride;
        if (rn < row1) {
            load_rows(rn, sl_n, yn, hnx);
            if (rn + stride < row1) sl_n = *(const int4*)(p.slot_of + (size_t)(rn + stride) * 4);
        }
        const float* mv = mvl + (size_t)row_mrow(r) * 6144;
        float4 hh[4]; float ss = 0.f;
#pragma unroll
        for (int i = 0; i < 4; ++i) {
            const int c4 = lane + 64 * i;
            float ys4[4];
#pragma unroll
            for (int x = 0; x < 4; ++x) {
                float acc = 0.f;
#pragma unroll
                for (int k = 0; k < 4; ++k) { const unsigned w = x < 2 ? ya[k][i].x : ya[k][i].y; acc += __uint_as_float((x & 1) ? (w & 0xffff0000u) : (w << 16)); }
                ys4[x] = acc;
            }
            const float4 gt = ((const float4*)(mv + 5120))[c4];
            float4 h = ha[i];
            h.x += gt.x * ys4[0]; h.y += gt.y * ys4[1]; h.z += gt.z * ys4[2]; h.w += gt.w * ys4[3];
            hh[i] = h;
            if (!FINAL) ((float4*)(p.H + (size_t)r * DM))[c4] = h;
            ss += h.x * h.x + h.y * h.y + h.z * h.z + h.w * h.w;
        }
        const float rs = rsqrtf(wave_sum(ss) * (1.0f / DM) + EPSF);
        if (FINAL) {
#pragma unroll
            for (int i = 0; i < 4; ++i) {
                const int c4 = lane + 64 * i;
                const float4 g = ((const float4*)p.norm_final)[c4];
                ((float4*)(p.out + (size_t)(r - NCTX) * DM))[c4] = make_float4(hh[i].x * rs * g.x, hh[i].y * rs * g.y, hh[i].z * rs * g.z, hh[i].w * rs * g.w);
            }
        } else {
            const float* mv1 = p.mvec + (size_t)(layer + 1) * 5 * 6144 + (size_t)row_mrow(r) * 6144;
            const float* gain = p.norm_mix + (layer + 1) * DM;
#pragma unroll
            for (int i = 0; i < 4; ++i) {
                const int c4 = lane + 64 * i;
                const float4 g = ((const float4*)gain)[c4], sh = ((const float4*)mv1)[c4], sc = ((const float4*)(mv1 + 1024))[c4];
                st_bf16x4(p.Ub + (size_t)r * DM + c4 * 4, hh[i].x * rs * g.x * (1.0f + sc.x) + sh.x, hh[i].y * rs * g.y * (1.0f + sc.y) + sh.y,
                          hh[i].z * rs * g.z * (1.0f + sc.z) + sh.z, hh[i].w * rs * g.w * (1.0f + sc.w) + sh.w);
            }
        }
#pragma unroll
        for (int k = 0; k < 4; ++k)
#pragma unroll
            for (int i = 0; i < 4; ++i) ya[k][i] = yn[k][i];
#pragma unroll
        for (int i = 0; i < 4; ++i) ha[i] = hnx[i];
    }
}

__global__ void __launch_bounds__(NTHR, 2) k_fwd(FwdParams p) {
    volatile LAS unsigned* xbw = (volatile LAS unsigned*)(g_shm + LDS_BYTES - 16);
    if (threadIdx.x == 0) { xbw[0] = 0u; xbw[1] = 0u; xbw[2] = 0u; xbw[3] = 0u; }
    __syncthreads();
    XcdBarrier bar = xcd_barrier_post(p.bar, xbw);
    {
        int base = 0;
        const int bi = blockIdx.x, nb = gridDim.x;
        base = convert_matrix<2>(p.cv.ab_in, AB_IN, 3328, p.cv.ab_inT, base, bi, nb);
        base = convert_matrix<0>(p.cv.ab_out, 1024, 1024, p.cv.ab_outT, base, bi, nb);
        base = convert_matrix<2>(p.cv.cd_in, CD_IN, 4608, p.cv.cd_inT, base, bi, nb);
        base = convert_matrix<0>(p.cv.cd_out, 1024, 1024, p.cv.cd_outT, base, bi, nb);
        convert_experts(p.cv.wgu, p.cv.wdn, p.cv.wguT, p.cv.wdnT, 0, NEXP, bi, nb);
        ph_mod(p);
        ph_l1_wlr(p.l1);
    }
    xcd_barrier(bar);
    ph_normmod(p.ctx, p.x, p.norm_mix, p.mvec, 0, NTOK, p.Ub);
    xcd_barrier(bar);
    ph_gemm_bf16out(p.Ub, 0, NTOK, p.ab_inT, AB_IN, 3328, p.ZB, AB_IN);
    xcd_barrier(bar);
    ph_l0_prep(p.l0);
    xcd_barrier(bar);
    ph_l0_local(p.l0);
    xcd_barrier(bar);
    ph_l0_prop(p.l0);
    xcd_barrier(bar);
    ph_l0_out(p.l0);
    xcd_barrier(bar);
    ph_gemm_resid(p.Ub, 0, NTOK, p.ab_outT, p.ctx, p.x, p.mvec + 2048, p.H);
    xcd_barrier(bar);
    ph_norm_router(p, 0, 0, NTOK);
    xcd_barrier(bar);
    ph_assign(p, 0, 0, NTOK);
    xcd_barrier(bar);
    ph_moe_gu(p.Ub, p.meta, p.list, p.wguT, p.bgu, p.ZB);
    xcd_barrier(bar);
    ph_moe_dn(p.ZB, p.meta, p.wdnT, p.bdn, (bf16_t*)p.P, p.slot_w);
    xcd_barrier(bar);
    ph_combine<false>(p, 0, 0, NTOK);
    xcd_barrier(bar);
    ph_gemm_bf16out(p.Ub, 0, NTOK, p.cd_inT, CD_IN, 4608, p.ZB, CD_IN);
    xcd_barrier(bar);
    ph_l1_rwprep(p.l1);
    xcd_barrier(bar);
    {
        const int nrw = (int)gridDim.x >> 1;
        if ((int)blockIdx.x < nrw) ph_l1_rwkv2(p.l1, blockIdx.x, nrw);
        else {
            const int bi = (int)blockIdx.x - nrw, nb = (int)gridDim.x - nrw;
            ph_l1_local(p.l1, bi, nb);
            sub_barrier(p.bar, 0, (unsigned)nb);
            ph_l1_prop(p.l1, bi, nb);
            sub_barrier(p.bar, 64, (unsigned)nb);
            ph_l1_out(p.l1, bi, nb);
            convert_experts(p.cv.wgu, p.cv.wdn, p.cv.wguT, p.cv.wdnT, NEXP, 2 * NEXP, bi, nb);
        }
    }
    xcd_barrier(bar);
    ph_l1_rwmerge(p.l1);
    xcd_barrier(bar);
    ph_gemm_resid(p.Ub, NCTX, NLAT, p.cd_outT, p.H, p.H + (size_t)NCTX * DM, p.mvec + 5 * 6144 + 2048, p.H);
    xcd_barrier(bar);
    ph_norm_router(p, 1, NCTX, NTOK);
    xcd_barrier(bar);
    ph_assign(p, 1, NCTX, NTOK);
    xcd_barrier(bar);
    ph_moe_gu(p.Ub, p.meta + 128, p.list + LIST_INTS, p.wguT + (size_t)NEXP * 2048 * 1024, p.bgu + NEXP * 2048, p.ZB);
    xcd_barrier(bar);
    ph_moe_dn(p.ZB, p.meta + 128, p.wdnT + (size_t)NEXP * 1024 * 1024, p.bdn + NEXP * 1024, (bf16_t*)p.P, p.slot_w);
    xcd_barrier(bar);
    ph_combine<true>(p, 1, NCTX, NTOK);
}

extern "C" void kernel_launch(void* const* d_in, const int* in_sizes, int n_in, void* d_out, int out_size, void* d_ws, size_t ws_size,
                              hipStream_t stream) {
    const size_t NT1024 = (size_t)NTOK * 1024, NT512 = (size_t)NTOK * 512;
    char* wp = (char*)d_ws;
    auto carve = [&](size_t bytes) { char* q = wp; wp += (bytes + 255) & ~(size_t)255; return q; };
    const size_t CTL_BYTES = (size_t)XCD_BAR_WORDS * 4 + 256 * 4 + (size_t)2 * LIST_INTS * 4;
    char* ctl = carve(CTL_BYTES);
    unsigned* bar = (unsigned*)ctl;
    int* meta = (int*)(ctl + (size_t)XCD_BAR_WORDS * 4);
    int* list = (int*)(ctl + (size_t)XCD_BAR_WORDS * 4 + 256 * 4);
    FwdParams p{};
    p.x = (const float*)d_in[0]; p.c = (const float*)d_in[1]; p.ctx = (const float*)d_in[2]; p.c_ctx = (const float*)d_in[3];
    p.mod_w = (const float*)d_in[4]; p.mod_b = (const float*)d_in[5]; p.norm_mix = (const float*)d_in[6]; p.norm_ffn = (const float*)d_in[7];
    p.norm_final = (const float*)d_in[8];
    p.router_w = (const float*)d_in[30]; p.router_b = (const float*)d_in[31]; p.bgu = (const float*)d_in[33]; p.bdn = (const float*)d_in[35];
    p.out = (float*)d_out;
    p.bar = bar; p.meta = meta; p.list = list;
    p.mvec = (float*)carve((size_t)2 * 5 * 6144 * 4);
    p.ab_inT = (bf16_t*)carve((size_t)3328 * 1024 * 2);
    p.ab_outT = (bf16_t*)carve((size_t)1024 * 1024 * 2);
    p.cd_inT = (bf16_t*)carve((size_t)4608 * 1024 * 2);
    p.cd_outT = (bf16_t*)carve((size_t)1024 * 1024 * 2);
    p.wguT = (bf16_t*)carve((size_t)2 * NEXP * 2048 * 1024 * 2);
    p.wdnT = (bf16_t*)carve((size_t)2 * NEXP * 1024 * 1024 * 2);
    p.H = (float*)carve(NT1024 * 4);
    p.Ub = (bf16_t*)carve(NT1024 * 2);
    p.ZB = (bf16_t*)carve((size_t)NTOK * CD_IN * 2);
    const size_t P_BYTES = (size_t)805306368;
    p.P = (float*)carve(P_BYTES);
    float* O = (float*)carve(NT512 * 4 * 4);
    p.Y = O;
    p.top_e = (int*)carve((size_t)NTOK * 4 * 4);
    p.top_w = (float*)carve((size_t)NTOK * 4 * 4);
    p.slot_of = (int*)carve((size_t)NTOK * 4 * 4);
    bf16_t* WLR = (bf16_t*)carve((size_t)196608 * 2);
    p.slot_w = (float*)carve((size_t)LIST_INTS * 4);
    if ((size_t)(wp - (char*)d_ws) > ws_size) return;

    p.cv.ab_in = (const float*)d_in[9]; p.cv.ab_out = (const float*)d_in[10]; p.cv.cd_in = (const float*)d_in[16]; p.cv.cd_out = (const float*)d_in[17];
    p.cv.wgu = (const float*)d_in[32]; p.cv.wdn = (const float*)d_in[34];
    p.cv.ab_inT = p.ab_inT; p.cv.ab_outT = p.ab_outT; p.cv.cd_inT = p.cd_inT; p.cv.cd_outT = p.cd_outT; p.cv.wguT = p.wguT; p.cv.wdnT = p.wdnT;
    {
        char* pp = (char*)p.P;
        auto sub = [&](size_t bytes) { char* q = pp; pp += (bytes + 255) & ~(size_t)255; return q; };
        L0Args& a = p.l0;
        a.z = p.ZB; a.ml_conv = (const float*)d_in[13]; a.gate_b = (const float*)d_in[14]; a.ret_decay = (const float*)d_in[11];
        a.ret_norm = (const float*)d_in[12]; a.ml_norm = (const float*)d_in[15];
        a.RQ = (bf16_t*)sub((size_t)NTOK * 256 * 2); a.RK = (bf16_t*)sub((size_t)NTOK * 256 * 2);
        a.MQ = (bf16_t*)sub((size_t)NTOK * 256 * 2); a.MK = (bf16_t*)sub((size_t)NTOK * 256 * 2);
        a.LIF = (float*)sub((size_t)NTOK * 16 * 4);
        a.ST = (bf16_t*)sub((size_t)16 * NCHUNK * REC * 2);
        a.CM = (float*)sub((size_t)8 * NCHUNK * 2 * 4);
        a.MI = (float*)sub((size_t)8 * NCHUNK * 4);
        a.MG = p.Ub;
        if ((size_t)(pp - (char*)p.P) > P_BYTES) return;
    }
    {
        char* pp = (char*)p.P;
        auto sub = [&](size_t bytes) { char* q = pp; pp += (bytes + 255) & ~(size_t)255; return q; };
        L1Args& a = p.l1;
        a.z = p.ZB; a.hgrn_lb = (const float*)d_in[18]; a.hg_norm = (const float*)d_in[19];
        a.HST = (bf16_t*)sub((size_t)8 * NCHUNK * HREC * 2);
        a.HDEC = (float*)sub((size_t)8 * NCHUNK * 128 * 4);
        a.MG = p.Ub;
        a.shift = (const float*)d_in[20]; a.w0 = (const float*)d_in[21]; a.w2 = (const float*)d_in[22]; a.a0 = (const float*)d_in[23];
        a.a2 = (const float*)d_in[24]; a.g2 = (const float*)d_in[25]; a.kk_scale = (const float*)d_in[26]; a.k_a = (const float*)d_in[27];
        a.r_k = (const float*)d_in[28]; a.rw_norm = (const float*)d_in[29];
        a.PKK = (bf16_t*)sub(NT512 * 2); a.PV = (bf16_t*)sub(NT512 * 2);
        a.PG = (float*)sub(NT512 * 4);
        a.PW = (float*)sub(NT512 * 2 * 4);
        a.PAB = (bf16_t*)sub(NT512 * 2 * 2); a.PKE = (bf16_t*)sub(NT512 * 2 * 2); a.PWR = (bf16_t*)sub(NT512 * 2 * 2);
        a.PSC = (float*)sub((size_t)2 * NTOK * 16 * 4);
        a.PBON = (float*)sub((size_t)NTOK * 8 * 4);
        a.RWO = O; a.WLR = WLR;
        if ((size_t)(pp - (char*)p.P) > P_BYTES) return;
    }
    static int grid = 0;
    if (grid == 0) {
        int dev = 0, cus = 0;
        if (hipGetDevice(&dev) != hipSuccess || hipDeviceGetAttribute(&cus, hipDeviceAttributeMultiprocessorCount, dev) != hipSuccess) { grid = -1; return; }
        if (hipFuncSetAttribute((const void*)k_fwd, hipFuncAttributeMaxDynamicSharedMemorySize, LDS_BYTES) != hipSuccess) { grid = -1; return; }
        int per_cu = 0;
        if (hipOccupancyMaxActiveBlocksPerMultiprocessor(&per_cu, (const void*)k_fwd, NTHR, LDS_BYTES) != hipSuccess || per_cu < 1) { (void)hipGetLastError(); }
        grid = cus > 0 ? cus : 256;
    }
    if (grid < 0) return;
    (void)hipMemsetAsync(ctl, 0, CTL_BYTES, stream);
    k_fwd<<<grid, NTHR, LDS_BYTES, stream>>>(p);
}
```

```cpp
#include <hip/hip_runtime.h>
#include <stdint.h>
#include <stddef.h>

#define DM 1024
#define NB 4
#define TL 8192
#define TC 256
#define NCTX (NB * TC)
#define NLAT (NB * TL)
#define NTOK (NCTX + NLAT)
#define AB_IN 3088
#define CD_IN 4480
#define NEXP 32
#define EPSF 1e-6f

typedef unsigned short bf16_t;
typedef unsigned u32x2 __attribute__((ext_vector_type(2)));
typedef unsigned u32x4 __attribute__((ext_vector_type(4)));
__device__ __forceinline__ unsigned cvt_pk_bf16(float lo, float hi) { unsigned r; asm volatile("v_cvt_pk_bf16_f32 %0, %1, %2" : "=v"(r) : "v"(lo), "v"(hi)); return r; }
typedef __bf16 bf16x2_t __attribute__((ext_vector_type(2)));
typedef float f32x2_t __attribute__((ext_vector_type(2)));
__device__ __forceinline__ unsigned cvt_pk_bf16_nat(float lo, float hi) { const f32x2_t v = {lo, hi}; return __builtin_bit_cast(unsigned, __builtin_convertvector(v, bf16x2_t)); }
__device__ __forceinline__ void st_bf16x8(bf16_t* p, float a, float b, float c, float d, float e, float f, float g, float h) { u32x4 w; w.x = cvt_pk_bf16_nat(a, b); w.y = cvt_pk_bf16_nat(c, d); w.z = cvt_pk_bf16_nat(e, f); w.w = cvt_pk_bf16_nat(g, h); *(u32x4*)p = w; }
__device__ __forceinline__ void st_bf16x4(bf16_t* p, float a, float b, float c, float d) { u32x2 w; w.x = cvt_pk_bf16(a, b); w.y = cvt_pk_bf16(c, d); *(u32x2*)p = w; }
__device__ __forceinline__ float sigmoidf_(float x) { return 1.0f / (1.0f + expf(-x)); }
__device__ __forceinline__ float siluf_(float x) { return x / (1.0f + expf(-x)); }
__device__ __forceinline__ float logsigmoidf_(float x) { return fminf(x, 0.0f) - log1pf(expf(-fabsf(x))); }
__device__ __forceinline__ float softplusf_(float x) { return fmaxf(x, 0.0f) + log1pf(expf(-fabsf(x))); }

__device__ __forceinline__ float fexp_(float x) { return __expf(x); }
__device__ __forceinline__ float frcp_(float x) { return __builtin_amdgcn_rcpf(x); }
__device__ __forceinline__ float fsigmoid_(float x) { return frcp_(1.0f + __expf(-x)); }
__device__ __forceinline__ float flog_(float x) { return __logf(x); }
__device__ __forceinline__ float wave_sum(float v) {
#pragma unroll
    for (int o = 32; o > 0; o >>= 1) v += __shfl_xor(v, o);
    return v;
}
__device__ __forceinline__ float block_sum(float v, float* red) {
    v = wave_sum(v);
    const int w = threadIdx.x >> 6, nw = blockDim.x >> 6;
    __syncthreads();
    if ((threadIdx.x & 63) == 0) red[w] = v;
    __syncthreads();
    float s = 0.f;
    for (int i = 0; i < nw; ++i) s += red[i];
    return s;
}

struct RowInfo { int t, len, mrow; };
__device__ __forceinline__ RowInfo row_info(int r) {
    RowInfo ri;
    if (r < NCTX) { ri.t = r % TC; ri.len = TC; ri.mrow = 4; }
    else { const int rr = r - NCTX; ri.t = rr % TL; ri.len = TL; ri.mrow = rr / TL; }
    return ri;
}

typedef short bf16x8 __attribute__((ext_vector_type(8)));
typedef float f32x4 __attribute__((ext_vector_type(4)));
#define NTHR 512
__device__ __forceinline__ int tid_fresh() { int t = threadIdx.x; asm volatile("" : "+v"(t)); return t; }
#define LDS_BYTES 147456
#define LDS_TAB 131072
extern __shared__ __attribute__((aligned(16))) char g_shm[];

__device__ __forceinline__ float bf16_to_f32(bf16_t v) { return __uint_as_float(((unsigned)v) << 16); }
__device__ __forceinline__ float ldz(const bf16_t* p) { return bf16_to_f32(*p); }
__device__ __forceinline__ f32x4 ldz4(const bf16_t* p) { const u32x2 w = *(const u32x2*)p; f32x4 r; r[0] = __uint_as_float(w.x << 16); r[1] = __uint_as_float(w.x & 0xffff0000u); r[2] = __uint_as_float(w.y << 16); r[3] = __uint_as_float(w.y & 0xffff0000u); return r; }

template <int MODE>
__device__ __forceinline__ int src_col(int sn) {
    if (MODE == 2) { const int rho = sn & 31, nn = rho >> 4, ii = rho & 15; sn = (sn & ~31) + 8 * (ii >> 2) + 4 * nn + (ii & 3); }
    if (MODE == 1) {
        const int u = sn >> 8, within = sn & 255, bj = within >> 7, q = within & 127, rho = q & 31, nn = rho >> 4, ii = rho & 15;
        sn = (bj ? 1024 : 0) + u * 128 + (q & ~31) + 8 * (ii >> 2) + 4 * nn + (ii & 3);
    }
    return sn;
}
template <int MODE>
__device__ __forceinline__ void convert_tile(const float* __restrict__ W, int N, bf16_t* __restrict__ Wt, int n0, int k0) {
    float (*tile)[129] = (float (*)[129])g_shm;
    const int tid = tid_fresh();
    const int kr = tid >> 5, n4 = (tid & 31) * 4;
    const int sn = src_col<MODE>(n0 + n4);
    f32x4 v[4];
#pragma unroll
    for (int i = 0; i < 4; ++i) {
        v[i] = (f32x4){0.f, 0.f, 0.f, 0.f};
        if (sn < N) v[i] = *(const f32x4*)(W + (size_t)(k0 + kr + 16 * i) * N + sn);
    }
    __syncthreads();
#pragma unroll
    for (int i = 0; i < 4; ++i) { float* t = &tile[kr + 16 * i][n4]; t[0] = v[i][0]; t[1] = v[i][1]; t[2] = v[i][2]; t[3] = v[i][3]; }
    __syncthreads();
    const int n = tid >> 2, k16 = (tid & 3) * 16;
    u32x4 o0, o1;
    o0.x = cvt_pk_bf16(tile[k16 + 0][n], tile[k16 + 1][n]); o0.y = cvt_pk_bf16(tile[k16 + 2][n], tile[k16 + 3][n]);
    o0.z = cvt_pk_bf16(tile[k16 + 4][n], tile[k16 + 5][n]); o0.w = cvt_pk_bf16(tile[k16 + 6][n], tile[k16 + 7][n]);
    o1.x = cvt_pk_bf16(tile[k16 + 8][n], tile[k16 + 9][n]); o1.y = cvt_pk_bf16(tile[k16 + 10][n], tile[k16 + 11][n]);
    o1.z = cvt_pk_bf16(tile[k16 + 12][n], tile[k16 + 13][n]); o1.w = cvt_pk_bf16(tile[k16 + 14][n], tile[k16 + 15][n]);
    bf16_t* dst = Wt + (size_t)(n0 + n) * 1024 + k0 + k16;
    *(u32x4*)dst = o0; *(u32x4*)(dst + 8) = o1;
}
template <int MODE>
__device__ __forceinline__ int convert_matrix(const float* W, int N, int Npad, bf16_t* Wt, int base, int bi, int G) {
    const int ntiles = (Npad >> 7) * 16;
    for (int it = base + ((bi - base % G) + G) % G; it < base + ntiles; it += G) {
        const int l = it - base;
        convert_tile<MODE>(W, N, Wt, (l >> 4) * 128, (l & 15) * 64);
    }
    return base + ntiles;
}
__device__ __forceinline__ void lds_barrier() { asm volatile("s_waitcnt lgkmcnt(0)" ::: "memory"); __builtin_amdgcn_s_barrier(); asm volatile("" ::: "memory"); }
__device__ __forceinline__ void convert_experts(const float* __restrict__ wgu, const float* __restrict__ wdn, bf16_t* __restrict__ wguT, bf16_t* __restrict__ wdnT, int le0, int le1, int bi, int G) {
    float (*tile)[129] = (float (*)[129])g_shm;
    const int tid = tid_fresh();
    const int kr = tid >> 5, n4 = (tid & 31) * 4;
    const int n = tid >> 2, k16 = (tid & 3) * 16;
    const int total = (le1 - le0) * 384;
    f32x4 v[4];
    auto issue = [&](int item) {
        const int e = le0 + item / 384, t = item % 384;
        const bool gu = t < 256; const int l = gu ? t : t - 256;
        const int n0 = (l >> 4) * 128, k0 = (l & 15) * 64, N = gu ? 2048 : 1024;
        const float* W = gu ? wgu + (size_t)e * 1024 * 2048 : wdn + (size_t)e * 1024 * 1024;
        const int sn = gu ? src_col<1>(n0 + n4) : src_col<2>(n0 + n4);
#pragma unroll
        for (int i = 0; i < 4; ++i) v[i] = *(const f32x4*)(W + (size_t)(k0 + kr + 16 * i) * N + sn);
    };
    __syncthreads();
    int item = bi;
    if (item < total) issue(item);
    for (; item < total; item += G) {
        lds_barrier();
#pragma unroll
        for (int i = 0; i < 4; ++i) { float* t = &tile[kr + 16 * i][n4]; t[0] = v[i][0]; t[1] = v[i][1]; t[2] = v[i][2]; t[3] = v[i][3]; }
        const int e = le0 + item / 384, t = item % 384;
        const bool gu = t < 256; const int l = gu ? t : t - 256;
        bf16_t* dst = (gu ? wguT + (size_t)e * 2048 * 1024 : wdnT + (size_t)e * 1024 * 1024) + (size_t)((l >> 4) * 128 + n) * 1024 + (l & 15) * 64 + k16;
        if (item + G < total) issue(item + G);
        lds_barrier();
        u32x4 o0, o1;
        o0.x = cvt_pk_bf16(tile[k16 + 0][n], tile[k16 + 1][n]); o0.y = cvt_pk_bf16(tile[k16 + 2][n], tile[k16 + 3][n]);
        o0.z = cvt_pk_bf16(tile[k16 + 4][n], tile[k16 + 5][n]); o0.w = cvt_pk_bf16(tile[k16 + 6][n], tile[k16 + 7][n]);
        o1.x = cvt_pk_bf16(tile[k16 + 8][n], tile[k16 + 9][n]); o1.y = cvt_pk_bf16(tile[k16 + 10][n], tile[k16 + 11][n]);
        o1.z = cvt_pk_bf16(tile[k16 + 12][n], tile[k16 + 13][n]); o1.w = cvt_pk_bf16(tile[k16 + 14][n], tile[k16 + 15][n]);
        *(u32x4*)dst = o0; *(u32x4*)(dst + 8) = o1;
    }
    __syncthreads();
}

__device__ __forceinline__ int lds_byte(int r, int c) { const int st = (r >> 4) * 2 + (c >> 5), rr = r & 15, cc = c & 31, ob = rr * 64 + cc * 2; return st * 1024 + (ob ^ (((ob >> 9) & 1) << 5)); }
__device__ __forceinline__ void stage_rc(int b, int& R, int& C) { const int st = b / 1024, sb = b % 1024, swz = sb ^ (((sb >> 9) & 1) << 5); R = (st >> 1) * 16 + swz / 64; C = (st & 1) * 32 + (swz % 64) / 2; }

#define G_HT (128 * 64)
#define G_SA(b, h) (shm + ((b) * 2 + (h)) * G_HT)
#define G_SB(b, h) (shm + (4 + (b) * 2 + (h)) * G_HT)
#define G_GLDS(src, dst) __builtin_amdgcn_global_load_lds((const unsigned*)(src), (unsigned*)(dst), 16, 0, 0)
#define G_STAGE_A(P, h, kt) do { G_GLDS(Ab + (size_t)(unsigned)((h ? a10 : a00) + (unsigned)(kt) * 128u), (char*)(P) + tb); G_GLDS(Ab + (size_t)(unsigned)((h ? a11 : a01) + (unsigned)(kt) * 128u), (char*)(P) + tb + 8192); } while (0)
#define G_STAGE_B(P, h, kt) do { G_GLDS(Bb + (size_t)(unsigned)(bofs + (unsigned)((h) * (128 * 2048)) + (unsigned)(kt) * 128u), (char*)(P) + tb); G_GLDS(Bb + (size_t)(unsigned)(bofs + (unsigned)((h) * (128 * 2048) + 64 * 2048) + (unsigned)(kt) * 128u), (char*)(P) + tb + 8192); } while (0)
#define G_LDA(dst, b, h) for (int m = 0; m < 4; ++m) for (int k = 0; k < 2; ++k) dst[m][k] = *reinterpret_cast<const bf16x8*>((char*)G_SA(b, h) + lds_byte(wr * 64 + m * 16 + fr, k * 32 + fq * 8))
#define G_LDB(dst, b, h) for (int n = 0; n < 2; ++n) for (int k = 0; k < 2; ++k) dst[n][k] = *reinterpret_cast<const bf16x8*>((char*)G_SB(b, h) + lds_byte(wc * 32 + n * 16 + fr, k * 32 + fq * 8))
#define G_MMA(ai, bj, At_, Bt_) do { __builtin_amdgcn_s_setprio(1); \
    for (int m = 0; m < 4; ++m) for (int n = 0; n < 2; ++n) for (int k = 0; k < 2; ++k) \
        acc[ai][bj][m][n] = __builtin_amdgcn_mfma_f32_16x16x32_bf16(Bt_[n][k], At_[m][k], acc[ai][bj][m][n], 0, 0, 0); \
    __builtin_amdgcn_s_setprio(0); } while (0)
#define G_WAIT_V(n) asm volatile("s_waitcnt vmcnt(" #n ")" ::: "memory")
#define G_WAIT_L(n) asm volatile("s_waitcnt lgkmcnt(" #n ")" ::: "memory")
#define G_BAR __builtin_amdgcn_s_barrier()
#define G_SCHED __builtin_amdgcn_sched_barrier(0)

#define G_STAGE_AX(P, X0, X1, kt) do { G_GLDS(Ab + (size_t)(unsigned)((X0) + (unsigned)(kt) * 128u), (char*)(P) + tb); G_GLDS(Ab + (size_t)(unsigned)((X1) + (unsigned)(kt) * 128u), (char*)(P) + tb + 8192); } while (0)
#define G_STAGE_BX(P, XB, h, kt) do { G_GLDS(Bb + (size_t)(unsigned)((XB) + (unsigned)((h) * (128 * 2048)) + (unsigned)(kt) * 128u), (char*)(P) + tb); G_GLDS(Bb + (size_t)(unsigned)((XB) + (unsigned)((h) * (128 * 2048) + 64 * 2048) + (unsigned)(kt) * 128u), (char*)(P) + tb + 8192); } while (0)
template <class Sched>
__device__ __forceinline__ void gemm_stream(const bf16_t* __restrict__ A, const bf16_t* __restrict__ Bt, const Sched& S) {
    typename Sched::U cur, nxt;
    if (!S.get(0, cur)) return;
    bf16_t* shm = (bf16_t*)g_shm;
    const int tid = tid_fresh();
    const int tb = tid * 16;
    int R0, C0; stage_rc(tb, R0, C0);
    const char* Ab = (const char*)A; const char* Bb = (const char*)Bt;
    unsigned a00, a01, a10, a11, bofs;
    S.addrs(cur, R0, C0, a00, a01, a10, a11, bofs);
    const int wid = tid >> 6, lane = tid & 63, wr = wid >> 2, wc = wid & 3, fr = lane & 15, fq = lane >> 4;
    bf16x8 At[4][2], B0[2][2], B1[2][2];
    constexpr int nt = 16;
    G_STAGE_BX(G_SB(0, 0), bofs, 0, 0); G_STAGE_AX(G_SA(0, 0), a00, a01, 0);
    G_STAGE_BX(G_SB(0, 1), bofs, 1, 0); G_STAGE_AX(G_SA(0, 1), a10, a11, 0);
    if (wr == 1) G_BAR;
    G_WAIT_V(4); G_BAR;
    G_STAGE_BX(G_SB(1, 0), bofs, 0, 1); G_STAGE_AX(G_SA(1, 0), a00, a01, 1); G_STAGE_BX(G_SB(1, 1), bofs, 1, 1);
    G_WAIT_V(6); G_BAR;
    bool more = true;
    for (int ui = 0; more; ++ui) {
        more = S.get(ui + 1, nxt);
        unsigned n00 = a00, n01 = a01, n10 = a10, n11 = a11, nb = bofs;
        if (more) S.addrs(nxt, R0, C0, n00, n01, n10, n11, nb);
        f32x4 acc[2][2][4][2] = {};
        for (int t = 0; t < nt; t += 2) {
            const bool last = (t == nt - 2);
            const unsigned s00 = last ? n00 : a00, s01 = last ? n01 : a01, s10 = last ? n10 : a10, s11 = last ? n11 : a11, sb = last ? nb : bofs;
            const int k2 = last ? 0 : t + 2, k3 = last ? 1 : t + 3;
            G_LDB(B0, 0, 0); G_SCHED; G_LDA(At, 0, 0); G_STAGE_AX(G_SA(1, 1), a10, a11, t + 1);
            G_WAIT_L(8); G_BAR; G_WAIT_L(0); G_MMA(0, 0, At, B0); G_BAR; G_SCHED;
            G_LDB(B1, 0, 1); G_STAGE_BX(G_SB(0, 0), sb, 0, k2);
            G_BAR; G_WAIT_L(0); G_MMA(0, 1, At, B1); G_BAR;
            G_LDA(At, 0, 1); G_STAGE_AX(G_SA(0, 0), s00, s01, k2);
            G_BAR; G_WAIT_L(0); G_MMA(1, 0, At, B0); G_BAR; G_SCHED;
            G_STAGE_BX(G_SB(0, 1), sb, 1, k2);
            G_WAIT_V(6); G_BAR; G_MMA(1, 1, At, B1); G_BAR;
            G_LDB(B0, 1, 0); G_SCHED; G_LDA(At, 1, 0); G_STAGE_AX(G_SA(0, 1), s10, s11, k2);
            G_WAIT_L(8); G_BAR; G_WAIT_L(0); G_MMA(0, 0, At, B0); G_BAR; G_SCHED;
            G_LDB(B1, 1, 1); G_STAGE_BX(G_SB(1, 0), sb, 0, k3);
            G_BAR; G_WAIT_L(0); G_MMA(0, 1, At, B1); G_BAR;
            G_LDA(At, 1, 1); G_STAGE_AX(G_SA(1, 0), s00, s01, k3);
            G_BAR; G_WAIT_L(0); G_MMA(1, 0, At, B0); G_BAR; G_SCHED;
            G_STAGE_BX(G_SB(1, 1), sb, 1, k3);
            G_WAIT_V(6); G_BAR; G_MMA(1, 1, At, B1); G_BAR;
        }
        S.epi(cur, acc, wr, wc, fr, fq);
        cur = nxt; a00 = n00; a01 = n01; a10 = n10; a11 = n11; bofs = nb;
    }
    G_WAIT_V(0);
    if (wr == 0) G_BAR;
}

__device__ __forceinline__ bool dense_unit(int i, int nM, int nN, int& pm, int& pn) {
    const int G = gridDim.x, c = blockIdx.x;
    const int v = (G % 8 == 0) ? ((c % 8) * (G / 8) + c / 8) : c;
    const long L = (long)i * G + v;
    const int nwg = nM * nN;
    if (L >= nwg) return false;
    const int wgid = (int)L;
    const int nig = 16 * nN, gid = wgid / nig, fm = gid * 16, gsz = (nM - fm) < 16 ? (nM - fm) : 16;
    pm = fm + ((wgid % nig) % gsz); pn = (wgid % nig) / gsz;
    return true;
}
struct UDense { int pm, pn; };
template <class Derived> struct DenseBase {
    typedef UDense U;
    int nM, nN, row_base;
    __device__ __forceinline__ bool get(int i, U& u) const { return dense_unit(i, nM, nN, u.pm, u.pn); }
    __device__ __forceinline__ void addrs(const U& u, int R0, int C0, unsigned& a00, unsigned& a01, unsigned& a10, unsigned& a11, unsigned& bofs) const {
        const unsigned r = (unsigned)(row_base + u.pm * 256 + R0);
        a00 = (r * 1024u + C0) * 2u; a01 = a00 + 64u * 2048u; a10 = a00 + 128u * 2048u; a11 = a00 + 192u * 2048u;
        bofs = ((unsigned)(u.pn * 256 + R0) * 1024u + C0) * 2u;
    }
};
struct SchedBf16 : DenseBase<SchedBf16> {
    bf16_t* C; int ldc, N;
    __device__ __forceinline__ void epi(const UDense& u, const f32x4 (&acc)[2][2][4][2], int wr, int wc, int fr, int fq) const {
        const int row0 = row_base + u.pm * 256, col0 = u.pn * 256;
#pragma unroll
        for (int ai = 0; ai < 2; ++ai)
#pragma unroll
            for (int m = 0; m < 4; ++m) {
                bf16_t* rowp = C + (size_t)(row0 + ai * 128 + wr * 64 + m * 16 + fr) * ldc;
#pragma unroll
                for (int bj = 0; bj < 2; ++bj) {
                    const int c = col0 + bj * 128 + wc * 32 + fq * 8;
                    const f32x4 x = acc[ai][bj][m][0], y = acc[ai][bj][m][1];
                    if (c < N) st_bf16x8(rowp + c, x[0], x[1], x[2], x[3], y[0], y[1], y[2], y[3]);
                }
            }
    }
};
struct SchedResid : DenseBase<SchedResid> {
    const float* src_ctx; const float* src_lat; const float* gate; float* H;
    __device__ __forceinline__ void epi(const UDense& u, const f32x4 (&acc)[2][2][4][2], int wr, int wc, int fr, int fq) const {
        const int row0 = row_base + u.pm * 256, col0 = u.pn * 256;
#pragma unroll
        for (int ai = 0; ai < 2; ++ai)
#pragma unroll
            for (int m = 0; m < 4; ++m) {
                const int r = row0 + ai * 128 + wr * 64 + m * 16 + fr;
                const float* sp = r < NCTX ? src_ctx + (size_t)r * DM : src_lat + (size_t)(r - NCTX) * DM;
                const float* gp = gate + (size_t)(r < NCTX ? 4 : (r - NCTX) / TL) * 6144;
                float* hp = H + (size_t)r * DM;
#pragma unroll
                for (int bj = 0; bj < 2; ++bj)
#pragma unroll
                    for (int n = 0; n < 2; ++n) {
                        const int c = col0 + bj * 128 + wc * 32 + n * 16 + fq * 4;
                        const f32x4 x = *(const f32x4*)(sp + c), g = *(const f32x4*)(gp + c);
                        *(f32x4*)(hp + c) = x + g * acc[ai][bj][m][n];
                    }
            }
    }
};
__device__ __forceinline__ void gemm_stagger(int nwg, bool always) {
    const int G = gridDim.x, c = blockIdx.x, v = (G % 8 == 0) ? ((c % 8) * (G / 8) + c / 8) : c, rem = nwg % G;
    bool d = false;
    if (rem >= G / 4 && rem <= 3 * G / 4) d = v >= rem;
    else if (always) d = (c >> 3) & 1;
    if (d) { for (int z = 0; z < 5; ++z) __builtin_amdgcn_s_sleep(127); }
}
__device__ __forceinline__ void ph_gemm_bf16out(const bf16_t* A, int row_base, int M, const bf16_t* Bt, int N, int Npad, bf16_t* C, int ldc) {
    gemm_stagger((M / 256) * (Npad / 256), false);
    SchedBf16 S; S.nM = M / 256; S.nN = Npad / 256; S.row_base = row_base; S.C = C; S.ldc = ldc; S.N = N;
    gemm_stream(A, Bt, S);
}
__device__ __forceinline__ void ph_gemm_resid(const bf16_t* A, int row_base, int M, const bf16_t* Bt, const float* src_ctx, const float* src_lat, const float* gate, float* H) {
    SchedResid S; S.nM = M / 256; S.nN = 4; S.row_base = row_base; S.src_ctx = src_ctx; S.src_lat = src_lat; S.gate = gate; S.H = H;
    gemm_stream(A, Bt, S);
}

struct UMoe { int e, pm, pn, off; };
__device__ __forceinline__ void moe_table(const int* __restrict__ meta, int nN) {
    int* TAB = (int*)(g_shm + LDS_TAB);
    __syncthreads();
    if (threadIdx.x == 0) {
        int us = 0;
        for (int x = 0; x < NEXP; ++x) { const int nrt = (meta[x] + 255) >> 8; TAB[x] = us; TAB[32 + x] = nrt; TAB[64 + x] = meta[64 + x]; us += nrt * nN; }
        TAB[96] = us;
    }
    __syncthreads();
}
__device__ __forceinline__ bool moe_unit(int i, int nN, UMoe& u) {
    const int* TAB = (const int*)(g_shm + LDS_TAB);
    const int G = gridDim.x, c = blockIdx.x;
    const int v = (G % 8 == 0) ? ((c % 8) * (G / 8) + c / 8) : c;
    const int L = i * G + v;
    if (L >= TAB[96]) return false;
    int x = 0;
#pragma unroll
    for (int st = 16; st > 0; st >>= 1) if (TAB[x + st] <= L) x += st;
    const int wgid = L - TAB[x], nrt = TAB[32 + x];
    const int nig = 8 * nN, gid = wgid / nig, fm = gid * 8, gsz = (nrt - fm) < 8 ? (nrt - fm) : 8;
    u.e = x; u.off = TAB[64 + x]; u.pm = fm + ((wgid % nig) % gsz); u.pn = (wgid % nig) / gsz;
    return true;
}
struct SchedGU {
    typedef UMoe U;
    const int* meta; const int* list; const float* bgu; bf16_t* act;
    __device__ __forceinline__ bool get(int i, U& u) const { return moe_unit(i, 8, u); }
    __device__ __forceinline__ void addrs(const U& u, int R0, int C0, unsigned& a00, unsigned& a01, unsigned& a10, unsigned& a11, unsigned& bofs) const {
        const int* lp = list + u.off + u.pm * 256 + R0;
        a00 = ((unsigned)lp[0] * 1024u + C0) * 2u; a01 = ((unsigned)lp[64] * 1024u + C0) * 2u; a10 = ((unsigned)lp[128] * 1024u + C0) * 2u; a11 = ((unsigned)lp[192] * 1024u + C0) * 2u;
        bofs = ((unsigned)(u.e * 2048 + u.pn * 256 + R0) * 1024u + C0) * 2u;
    }
    __device__ __forceinline__ void epi(const U& u, const f32x4 (&acc)[2][2][4][2], int wr, int wc, int fr, int fq) const {
        const int s0 = u.off + u.pm * 256;
        const float* bg_ = bgu + (size_t)u.e * 2048;
        const int ch = u.pn * 128 + wc * 32 + fq * 8;
        const f32x4 bg0 = *(const f32x4*)(bg_ + ch), bg1 = *(const f32x4*)(bg_ + ch + 4), bl0 = *(const f32x4*)(bg_ + 1024 + ch), bl1 = *(const f32x4*)(bg_ + 1024 + ch + 4);
#pragma unroll
        for (int ai = 0; ai < 2; ++ai)
#pragma unroll
            for (int m = 0; m < 4; ++m) {
                const int slot = s0 + ai * 128 + wr * 64 + m * 16 + fr;
                float o[8];
#pragma unroll
                for (int n = 0; n < 2; ++n)
#pragma unroll
                    for (int j = 0; j < 4; ++j) {
                        float g = acc[ai][0][m][n][j] + (n ? bg1[j] : bg0[j]), l = acc[ai][1][m][n][j] + (n ? bl1[j] : bl0[j]);
                        g = fminf(g, 7.0f); l = fminf(fmaxf(l, -7.0f), 7.0f);
                        o[n * 4 + j] = g * frcp_(1.0f + __expf(-1.702f * g)) * (l + 1.0f);
                    }
                st_bf16x8(act + (size_t)slot * 1024 + ch, o[0], o[1], o[2], o[3], o[4], o[5], o[6], o[7]);
            }
    }
};
struct SchedDN {
    typedef UMoe U;
    const int* meta; const float* bdn; bf16_t* ys; const float* slot_w;
    __device__ __forceinline__ bool get(int i, U& u) const { return moe_unit(i, 4, u); }
    __device__ __forceinline__ void addrs(const U& u, int R0, int C0, unsigned& a00, unsigned& a01, unsigned& a10, unsigned& a11, unsigned& bofs) const {
        const unsigned r = (unsigned)(u.off + u.pm * 256 + R0);
        a00 = (r * 1024u + C0) * 2u; a01 = a00 + 64u * 2048u; a10 = a00 + 128u * 2048u; a11 = a00 + 192u * 2048u;
        bofs = ((unsigned)(u.e * 1024 + u.pn * 256 + R0) * 1024u + C0) * 2u;
    }
    __device__ __forceinline__ void epi(const U& u, const f32x4 (&acc)[2][2][4][2], int wr, int wc, int fr, int fq) const {
        const int s0 = u.off + u.pm * 256, col0 = u.pn * 256;
        const float* bd_ = bdn + (size_t)u.e * 1024;
#pragma unroll
        for (int bj = 0; bj < 2; ++bj) {
            const int c = col0 + bj * 128 + wc * 32 + fq * 8;
            const f32x4 b0 = *(const f32x4*)(bd_ + c), b1 = *(const f32x4*)(bd_ + c + 4);
#pragma unroll
            for (int ai = 0; ai < 2; ++ai)
#pragma unroll
                for (int m = 0; m < 4; ++m) {
                    const int slot = s0 + ai * 128 + wr * 64 + m * 16 + fr;
                    const f32x4 x = acc[ai][bj][m][0] + b0, y = acc[ai][bj][m][1] + b1;
                    st_bf16x8(ys + (size_t)slot * 1024 + c, x[0], x[1], x[2], x[3], y[0], y[1], y[2], y[3]);
                }
        }
    }
};
__device__ __forceinline__ void ph_moe_gu(const bf16_t* V, const int* meta, const int* list, const bf16_t* WguT, const float* bgu, bf16_t* act) {
    SchedGU S; S.meta = meta; S.list = list; S.bgu = bgu; S.act = act;
    moe_table(meta, 8);
    gemm_stagger(((const int*)(g_shm + LDS_TAB))[96], false);
    gemm_stream(V, WguT, S);
}
__device__ __forceinline__ void ph_moe_dn(const bf16_t* act, const int* meta, const bf16_t* WdnT, const float* bdn, bf16_t* ys, const float* slot_w) {
    SchedDN S; S.meta = meta; S.bdn = bdn; S.ys = ys; S.slot_w = slot_w;
    moe_table(meta, 4);
    gemm_stagger(((const int*)(g_shm + LDS_TAB))[96], true);
    gemm_stream(act, WdnT, S);
}

#define NCHUNK 528
#define REC 8320
#define LP 72
__device__ __forceinline__ size_t rec_off(int type, int dir, int h, int g) { return ((size_t)(((type * 2 + dir) * 4 + h) * NCHUNK + g)) * REC; }
__device__ __forceinline__ int chunk_g(int b, int dir, int s) {
    if (s < 4) return b * 4 + (dir ? 3 - s : s);
    const int s2 = s - 4; return 16 + b * 128 + (dir ? 127 - s2 : s2);
}
__device__ __forceinline__ float wave_incl_prefix(float v, int lane) {
#pragma unroll
    for (int o = 1; o < 64; o <<= 1) { const float t = __shfl_up(v, o); if (lane >= o) v += t; }
    return v;
}
__device__ __forceinline__ float wave_incl_suffix(float v, int lane) {
#pragma unroll
    for (int o = 1; o < 64; o <<= 1) { const float t = __shfl_down(v, o); if (lane + o < 64) v += t; }
    return v;
}
__device__ __forceinline__ float wave_prefix_max(float v, int lane) {
#pragma unroll
    for (int o = 1; o < 64; o <<= 1) { const float t = __shfl_up(v, o); if (lane >= o) v = fmaxf(v, t); }
    return v;
}
__device__ __forceinline__ float wave_suffix_max(float v, int lane) {
#pragma unroll
    for (int o = 1; o < 64; o <<= 1) { const float t = __shfl_down(v, o); if (lane + o < 64) v = fmaxf(v, t); }
    return v;
}
__device__ __forceinline__ float wave_max(float v) {
#pragma unroll
    for (int o = 32; o > 0; o >>= 1) v = fmaxf(v, __shfl_xor(v, o));
    return v;
}
__device__ __forceinline__ bf16x8 lds_frag(const bf16_t* base, int row, int kofs) { return *(const bf16x8*)(base + row * LP + kofs); }
__device__ __forceinline__ bf16_t f2bf(float x) { return (bf16_t)(cvt_pk_bf16(x, 0.f) & 0xffffu); }

struct L0Args {
    const bf16_t* z;
    const float* ml_conv; const float* gate_b; const float* ret_decay; const float* ret_norm; const float* ml_norm;
    bf16_t* RQ; bf16_t* RK; bf16_t* MQ; bf16_t* MK;
    float* LIF;
    bf16_t* ST;
    float* CM;
    float* MI;
    bf16_t* MG;
};

__device__ __forceinline__ void ph_l0_prep(const L0Args& a) {
    const int tfz = tid_fresh(); const int wid = tfz >> 6, lane = tfz & 63;
    for (int r = blockIdx.x * 8 + wid; r < NTOK; r += gridDim.x * 8) {
        const RowInfo ri = row_info(r);
        const bf16_t* zc = a.z + (size_t)r * AB_IN;
        {
            const int h = lane >> 4, hf = (lane >> 3) & 1, j0 = (lane & 7) * 4;
            const f32x4 q1 = ldz4(zc + h * 64 + j0), q2 = ldz4(zc + h * 64 + 32 + j0);
            const f32x4 k1 = ldz4(zc + 256 + h * 64 + j0), k2 = ldz4(zc + 256 + h * 64 + 32 + j0);
            f32x4 qo, ko;
            if (r >= NCTX) {
#pragma unroll
                for (int x = 0; x < 4; ++x) {
                    const int j = j0 + x;
                    const float pos = (j < 16) ? (float)(ri.t >> 6) : (float)(ri.t & 63);
                    const float inv = exp2f(-(float)(j & 15) * 0.83048202372184059f);
                    const float ang = pos * inv;
                    const float cs = __cosf(ang), sn = __sinf(ang);
                    qo[x] = hf ? (q1[x] * sn + q2[x] * cs) : (q1[x] * cs - q2[x] * sn);
                    ko[x] = hf ? (k1[x] * sn + k2[x] * cs) : (k1[x] * cs - k2[x] * sn);
                }
            } else { qo = hf ? q2 : q1; ko = hf ? k2 : k1; }
            const int d0 = h * 64 + hf * 32 + j0;
            st_bf16x4(a.RQ + (size_t)r * 256 + d0, qo[0], qo[1], qo[2], qo[3]);
            st_bf16x4(a.RK + (size_t)r * 256 + d0, ko[0] * 0.125f, ko[1] * 0.125f, ko[2] * 0.125f, ko[3] * 0.125f);
        }
#pragma unroll
        for (int rep = 0; rep < 2; ++rep) {
            const int ch = rep * 256 + lane * 4;
            f32x4 cv = ldz4(zc + 1536 + ch) * *(const f32x4*)(a.ml_conv + 512 + ch);
            if (ri.t > 0) cv += ldz4(zc + 1536 + ch - AB_IN) * *(const f32x4*)(a.ml_conv + ch);
            if (ri.t < ri.len - 1) cv += ldz4(zc + 1536 + ch + AB_IN) * *(const f32x4*)(a.ml_conv + 1024 + ch);
            float o[4];
#pragma unroll
            for (int x = 0; x < 4; ++x) o[x] = cv[x] * frcp_(1.0f + __expf(-cv[x])) * (rep == 0 ? 0.125f : 1.0f);
            st_bf16x4((rep == 0 ? a.MQ : a.MK) + (size_t)r * 256 + lane * 4, o[0], o[1], o[2], o[3]);
        }
        if (lane < 16) {
            const float val = ldz(zc + 3072 + lane) + a.gate_b[lane];
            const int d = lane >> 3, gi = (lane >> 2) & 1, h = lane & 3;
            a.LIF[(size_t)r * 16 + gi * 8 + d * 4 + h] = gi ? logsigmoidf_(val) : val;
        }
    }
}

__device__ __forceinline__ void ph_l0_local(const L0Args& a) {
    bf16_t* KT = (bf16_t*)g_shm;
    bf16_t* VT = (bf16_t*)(g_shm + 4 * 64 * LP * 2);
    float* SC = (float*)(g_shm + 4 * 64 * LP * 2 + 2 * 128 * LP * 2);
    const int tid = tid_fresh(), wid = tid >> 6, lane = tid & 63, fr = lane & 15, fq = lane >> 4;
    const int kd = tid & 63, jg = tid >> 6, dv = tid & 127, vg = tid >> 7;
    bf16_t pk[2][8], pv[2][16]; float pli = 0.f, plf = 0.f;
    auto prefetch = [&](int it) {
        const int g = it >> 2, h = it & 3, row0 = g * 64;
#pragma unroll
        for (int ty = 0; ty < 2; ++ty) {
            const bf16_t* src = (ty ? a.MK : a.RK) + (size_t)(row0 + jg * 8) * 256 + h * 64 + kd;
#pragma unroll
            for (int x = 0; x < 8; ++x) pk[ty][x] = src[(size_t)x * 256];
            const bf16_t* sv = a.z + (size_t)(row0 + vg * 16) * AB_IN + (ty ? 2048 : 512) + h * 128 + dv;
#pragma unroll
            for (int x = 0; x < 16; ++x) pv[ty][x] = sv[(size_t)x * AB_IN];
        }
        if (wid == 1 || wid == 2) { const int dir = wid - 1; pli = a.LIF[(size_t)(row0 + lane) * 16 + dir * 4 + h]; plf = a.LIF[(size_t)(row0 + lane) * 16 + 8 + dir * 4 + h]; }
    };
    if ((int)blockIdx.x < NCHUNK * 4) prefetch(blockIdx.x);
    for (int it = blockIdx.x; it < NCHUNK * 4; it += gridDim.x) {
        const int g = it >> 2, h = it & 3;
        __syncthreads();
        if (wid == 0) {
            const float l2f = log2f(1.0f - expf(a.ret_decay[h])), l2b = log2f(1.0f - expf(a.ret_decay[4 + h]));
            SC[lane] = exp2f((float)(63 - lane) * l2f);
            SC[64 + lane] = exp2f((float)lane * l2b);
        } else if (wid == 1 || wid == 2) {
            const int dir = wid - 1;
            const float bc = dir ? wave_incl_suffix(plf, lane) : wave_incl_prefix(plf, lane);
            const float btot = __shfl(bc, dir ? 0 : 63);
            const float lw = btot - bc + pli;
            const float mloc = wave_max(lw);
            SC[(2 + dir) * 64 + lane] = fexp_(lw - mloc);
            if (lane == 0) { float* cm = a.CM + ((size_t)(dir * 4 + h) * NCHUNK + g) * 2; cm[0] = btot; cm[1] = mloc; }
        }
        __syncthreads();
#pragma unroll
        for (int ty = 0; ty < 2; ++ty) {
#pragma unroll
            for (int dir = 0; dir < 2; ++dir) {
                const float* sc = SC + (ty * 2 + dir) * 64 + jg * 8;
                u32x4 o;
                o.x = cvt_pk_bf16(bf16_to_f32(pk[ty][0]) * sc[0], bf16_to_f32(pk[ty][1]) * sc[1]); o.y = cvt_pk_bf16(bf16_to_f32(pk[ty][2]) * sc[2], bf16_to_f32(pk[ty][3]) * sc[3]);
                o.z = cvt_pk_bf16(bf16_to_f32(pk[ty][4]) * sc[4], bf16_to_f32(pk[ty][5]) * sc[5]); o.w = cvt_pk_bf16(bf16_to_f32(pk[ty][6]) * sc[6], bf16_to_f32(pk[ty][7]) * sc[7]);
                *(u32x4*)(KT + (ty * 2 + dir) * 64 * LP + (((kd >> 2) & 3) * 16 + (kd >> 4) * 4 + (kd & 3)) * LP + jg * 8) = o;
            }
            u32x4 o0, o1;
            o0.x = (unsigned)pv[ty][0] | ((unsigned)pv[ty][1] << 16); o0.y = (unsigned)pv[ty][2] | ((unsigned)pv[ty][3] << 16);
            o0.z = (unsigned)pv[ty][4] | ((unsigned)pv[ty][5] << 16); o0.w = (unsigned)pv[ty][6] | ((unsigned)pv[ty][7] << 16);
            o1.x = (unsigned)pv[ty][8] | ((unsigned)pv[ty][9] << 16); o1.y = (unsigned)pv[ty][10] | ((unsigned)pv[ty][11] << 16);
            o1.z = (unsigned)pv[ty][12] | ((unsigned)pv[ty][13] << 16); o1.w = (unsigned)pv[ty][14] | ((unsigned)pv[ty][15] << 16);
            *(u32x4*)(VT + ty * 128 * LP + dv * LP + vg * 16) = o0;
            *(u32x4*)(VT + ty * 128 * LP + dv * LP + vg * 16 + 8) = o1;
        }
        if (it + (int)gridDim.x < NCHUNK * 4) prefetch(it + gridDim.x);
        __syncthreads();
#pragma unroll
        for (int ty = 0; ty < 2; ++ty) {
            const bf16x8 v0 = lds_frag(VT + ty * 128 * LP, wid * 16 + fr, fq * 8), v1 = lds_frag(VT + ty * 128 * LP, wid * 16 + fr, 32 + fq * 8);
#pragma unroll
            for (int dir = 0; dir < 2; ++dir) {
                const bf16_t* kt = KT + (ty * 2 + dir) * 64 * LP;
                bf16_t* st = a.ST + rec_off(ty, dir, h, g) + (size_t)(wid * 16 + fr) * 64 + fq * 16;
#pragma unroll
                for (int dp = 0; dp < 2; ++dp) {
                    f32x4 acc0 = {0.f, 0.f, 0.f, 0.f}, acc1 = {0.f, 0.f, 0.f, 0.f};
                    acc0 = __builtin_amdgcn_mfma_f32_16x16x32_bf16(lds_frag(kt, (2 * dp) * 16 + fr, fq * 8), v0, acc0, 0, 0, 0);
                    acc0 = __builtin_amdgcn_mfma_f32_16x16x32_bf16(lds_frag(kt, (2 * dp) * 16 + fr, 32 + fq * 8), v1, acc0, 0, 0, 0);
                    acc1 = __builtin_amdgcn_mfma_f32_16x16x32_bf16(lds_frag(kt, (2 * dp + 1) * 16 + fr, fq * 8), v0, acc1, 0, 0, 0);
                    acc1 = __builtin_amdgcn_mfma_f32_16x16x32_bf16(lds_frag(kt, (2 * dp + 1) * 16 + fr, 32 + fq * 8), v1, acc1, 0, 0, 0);
                    st_bf16x8(st + dp * 8, acc0[0], acc0[1], acc0[2], acc0[3], acc1[0], acc1[1], acc1[2], acc1[3]);
                }
            }
        }
        if (tid < 128) {
            const int dir = tid >> 6, d = tid & 63;
            const bf16_t* kt = KT + (2 + dir) * 64 * LP + (((d >> 2) & 3) * 16 + (d >> 4) * 4 + (d & 3)) * LP;
            float sum = 0.f;
#pragma unroll 16
            for (int j = 0; j < 64; ++j) sum += bf16_to_f32(kt[j]);
            ((float*)(a.ST + rec_off(1, dir, h, g) + 8192))[d] = sum;
        }
    }
}

__device__ __forceinline__ void ph_l0_prop(const L0Args& a) {
    for (int idx = blockIdx.x * NTHR + tid_fresh(); idx < 64 * 2048; idx += gridDim.x * NTHR) {
        const int seq = idx >> 11, e4 = idx & 2047;
        const int ty = seq >> 5, dir = (seq >> 4) & 1, h = (seq >> 2) & 3, b = seq & 3;
        const bool hasn = ty == 1 && e4 < 16;
        f32x4 S = {0.f, 0.f, 0.f, 0.f}, Sn = {0.f, 0.f, 0.f, 0.f};
        float m = 0.f;
        const float g64 = exp2f(64.0f * log2f(1.0f - expf(a.ret_decay[dir * 4 + h])));
        for (int s0 = 0; s0 < 132; s0 += 12) {
            f32x4 loc[12], locn[12]; float bt[12], ml[12];
#pragma unroll
            for (int i = 0; i < 12; ++i) {
                const int g = chunk_g(b, dir, s0 + i);
                bf16_t* rp = a.ST + rec_off(ty, dir, h, g);
                loc[i] = ldz4(rp + (size_t)e4 * 4);
                locn[i] = (f32x4){0.f, 0.f, 0.f, 0.f};
                if (hasn) locn[i] = *(const f32x4*)((const float*)(rp + 8192) + e4 * 4);
                if (ty == 1) { const float* cm = a.CM + ((size_t)(dir * 4 + h) * NCHUNK + g) * 2; bt[i] = cm[0]; ml[i] = cm[1]; } else { bt[i] = 0.f; ml[i] = 0.f; }
            }
#pragma unroll
            for (int i = 0; i < 12; ++i) {
                const int g = chunk_g(b, dir, s0 + i);
                float dec, wl;
                if (ty == 0) { dec = g64; wl = 1.0f; }
                else {
                    const float mn = fmaxf(bt[i] + m, ml[i]);
                    dec = expf(bt[i] + m - mn); wl = expf(ml[i] - mn);
                    if (e4 == 0) a.MI[(size_t)(dir * 4 + h) * NCHUNK + g] = m;
                    m = mn;
                }
                bf16_t* rp = a.ST + rec_off(ty, dir, h, g);
                st_bf16x4(rp + (size_t)e4 * 4, S[0], S[1], S[2], S[3]);
                if (hasn) *(f32x4*)((float*)(rp + 8192) + e4 * 4) = Sn;
                S = S * dec + loc[i] * wl;
                Sn = Sn * dec + locn[i] * wl;
            }
        }
    }
}

__device__ __forceinline__ void ph_l0_out(const L0Args& a) {
    bf16_t* Qs = (bf16_t*)g_shm;
    bf16_t* Ks = Qs + 64 * LP;
    bf16_t* ATT = Ks + 64 * LP;
    bf16_t* VT = ATT + 64 * LP;
    bf16_t* SF = VT + 128 * LP;
    bf16_t* SB = SF + 144 * LP;
    float* FV = (float*)(SB + 144 * LP);
    const int tid = tid_fresh(), wid = tid >> 6, lane = tid & 63, fr = lane & 15, fq = lane >> 4;
    u32x4 pq, pkk; bf16_t pv[16]; float pli = 0.f, plf = 0.f, pmi = 0.f;
    auto prefetch = [&](int it) {
        const int ty = it & 1, h = (it >> 1) & 3, g = it >> 3, row0 = g * 64;
        const int tp = tid_fresh();
        const int i = tp >> 3, c8 = tp & 7;
        const size_t go = (size_t)(row0 + i) * 256 + h * 64 + c8 * 8;
        pq = *(const u32x4*)((ty ? a.MQ : a.RQ) + go);
        pkk = *(const u32x4*)((ty ? a.MK : a.RK) + go);
        const int dv = tp & 127, vg = tp >> 7;
        const bf16_t* src = a.z + (size_t)(row0 + vg * 16) * AB_IN + (ty ? 2048 : 512) + h * 128 + dv;
#pragma unroll
        for (int x = 0; x < 16; ++x) pv[x] = src[(size_t)x * AB_IN];
        if (ty == 1 && tp < 128) {
            const int w2 = tp >> 6, l2 = tp & 63;
            pli = a.LIF[(size_t)(row0 + l2) * 16 + w2 * 4 + h]; plf = a.LIF[(size_t)(row0 + l2) * 16 + 8 + w2 * 4 + h];
            pmi = a.MI[(size_t)(w2 * 4 + h) * NCHUNK + g];
        }
    };
    if ((int)blockIdx.x < NCHUNK * 8) prefetch(blockIdx.x);
    for (int it = blockIdx.x; it < NCHUNK * 8; it += gridDim.x) {
        const int ty = it & 1, h = (it >> 1) & 3, g = it >> 3, row0 = g * 64;
        __syncthreads();
        {
            const int ts = tid_fresh();
            const int i = ts >> 3, c8 = ts & 7;
            *(u32x4*)(Qs + i * LP + c8 * 8) = pq;
            *(u32x4*)(Ks + i * LP + c8 * 8) = pkk;
            const int dv = ts & 127, vg = ts >> 7;
            u32x4 o0, o1;
            o0.x = (unsigned)pv[0] | ((unsigned)pv[1] << 16); o0.y = (unsigned)pv[2] | ((unsigned)pv[3] << 16); o0.z = (unsigned)pv[4] | ((unsigned)pv[5] << 16); o0.w = (unsigned)pv[6] | ((unsigned)pv[7] << 16);
            o1.x = (unsigned)pv[8] | ((unsigned)pv[9] << 16); o1.y = (unsigned)pv[10] | ((unsigned)pv[11] << 16); o1.z = (unsigned)pv[12] | ((unsigned)pv[13] << 16); o1.w = (unsigned)pv[14] | ((unsigned)pv[15] << 16);
            *(u32x4*)(VT + dv * LP + vg * 16) = o0;
            *(u32x4*)(VT + dv * LP + vg * 16 + 8) = o1;
            if (ts < 2 * 16 * 8) {
                const int dir = ts >> 7, rr = (ts >> 3) & 15, c = ts & 7;
                u32x4 o = {0u, 0u, 0u, 0u};
                if (ty == 1 && rr == 0) {
                    const float* np = (const float*)(a.ST + rec_off(1, dir, h, g) + 8192) + c * 8;
                    o.x = cvt_pk_bf16(np[0], np[1]); o.y = cvt_pk_bf16(np[2], np[3]); o.z = cvt_pk_bf16(np[4], np[5]); o.w = cvt_pk_bf16(np[6], np[7]);
                }
                *(u32x4*)((dir ? SB : SF) + (128 + rr) * LP + c * 8) = o;
            }
            if (ty == 1 && wid < 2) {
                const int dir = wid;
                const float bc = dir ? wave_incl_suffix(plf, lane) : wave_incl_prefix(plf, lane);
                const float aj = pli - bc;
                const float pm = dir ? wave_suffix_max(aj, lane) : wave_prefix_max(aj, lane);
                const float M = fmaxf(pmi, pm);
                float* fv = FV + dir * 256;
                fv[lane] = M; fv[64 + lane] = aj; fv[128 + lane] = fexp_(pmi - M); fv[192 + lane] = fexp_(-(bc + M));
            }
        }
        u32x4 ps[2][2];
        {
            const int tq = tid_fresh();
            const int sdv = tq >> 2, sd = (tq & 3) * 16;
#pragma unroll
            for (int dir = 0; dir < 2; ++dir) {
                const bf16_t* sp = a.ST + rec_off(ty, dir, h, g) + (size_t)sdv * 64 + sd;
                ps[dir][0] = *(const u32x4*)sp; ps[dir][1] = *(const u32x4*)(sp + 8);
            }
        }
        __syncthreads();
        const float l2f = (ty == 0) ? log2f(1.0f - expf(a.ret_decay[h])) : 0.f;
        const float l2b = (ty == 0) ? log2f(1.0f - expf(a.ret_decay[4 + h])) : 0.f;
        f32x4 otot[4];
#pragma unroll
        for (int x = 0; x < 4; ++x) otot[x] = (f32x4){0.f, 0.f, 0.f, 0.f};
        const int ndir = (ty == 0) ? 1 : 2;
        for (int pass = 0; pass < ndir; ++pass) {
            {
                const int itl = wid >> 1;
                const bf16x8 q0 = lds_frag(Qs, itl * 16 + fr, fq * 8), q1 = lds_frag(Qs, itl * 16 + fr, 32 + fq * 8);
                float rs = 0.f;
                const int i = itl * 16 + fr;
#pragma unroll
                for (int jj = 0; jj < 2; ++jj) {
                    const int jt = (wid & 1) * 2 + jj;
                    f32x4 acc = {0.f, 0.f, 0.f, 0.f};
                    acc = __builtin_amdgcn_mfma_f32_16x16x32_bf16(lds_frag(Ks, jt * 16 + fr, fq * 8), q0, acc, 0, 0, 0);
                    acc = __builtin_amdgcn_mfma_f32_16x16x32_bf16(lds_frag(Ks, jt * 16 + fr, 32 + fq * 8), q1, acc, 0, 0, 0);
                    float sv[4];
#pragma unroll
                    for (int r = 0; r < 4; ++r) {
                        const int j = jt * 16 + fq * 4 + r;
                        float dcy;
                        if (ty == 0) {
                            dcy = ((j <= i) ? exp2f((float)(i - j) * l2f) : 0.f) + ((j >= i) ? exp2f((float)(j - i) * l2b) : 0.f);
                        } else {
                            const float* fv = FV + pass * 256;
                            const bool ok = pass ? (j >= i) : (j <= i);
                            dcy = ok ? fexp_(fv[64 + j] - fv[i]) : 0.f;
                        }
                        sv[r] = acc[r] * dcy;
                        rs += sv[r];
                    }
                    u32x2 w; w.x = cvt_pk_bf16(sv[0], sv[1]); w.y = cvt_pk_bf16(sv[2], sv[3]);
                    *(u32x2*)(ATT + i * LP + jt * 16 + fq * 4) = w;
                }
                if (ty == 1) {
                    rs += __shfl_xor(rs, 16); rs += __shfl_xor(rs, 32);
                    if (fq == 0) FV[512 + (pass * 2 + (wid & 1)) * 64 + i] = rs;
                }
            }
            if (pass == 0) {
                const int tq = tid_fresh();
                const int sdv = tq >> 2, sd = (tq & 3) * 16;
#pragma unroll
                for (int dir = 0; dir < 2; ++dir) {
                    bf16_t* dst = (dir ? SB : SF) + sdv * LP + sd;
                    *(u32x4*)dst = ps[dir][0]; *(u32x4*)(dst + 8) = ps[dir][1];
                }
                if (it + (int)gridDim.x < NCHUNK * 8) prefetch(it + gridDim.x);
            }
            __syncthreads();
            {
                const bf16x8 v0 = lds_frag(VT, wid * 16 + fr, fq * 8), v1 = lds_frag(VT, wid * 16 + fr, 32 + fq * 8);
                const bf16_t* S1 = (ty == 0) ? SF : (pass ? SB : SF);
                const bf16x8 sf0 = lds_frag(S1, wid * 16 + fr, fq * 8), sf1 = lds_frag(S1, wid * 16 + fr, 32 + fq * 8);
                bf16x8 sb0 = sf0, sb1 = sf1;
                if (ty == 0) { sb0 = lds_frag(SB, wid * 16 + fr, fq * 8); sb1 = lds_frag(SB, wid * 16 + fr, 32 + fq * 8); }
                if (ty == 1 && wid == 0) {
                    const bf16x8 n0 = lds_frag(S1, 128 + fr, fq * 8), n1 = lds_frag(S1, 128 + fr, 32 + fq * 8);
#pragma unroll
                    for (int tt = 0; tt < 4; ++tt) {
                        f32x4 an = {0.f, 0.f, 0.f, 0.f};
                        an = __builtin_amdgcn_mfma_f32_16x16x32_bf16(n0, lds_frag(Qs, tt * 16 + fr, fq * 8), an, 0, 0, 0);
                        an = __builtin_amdgcn_mfma_f32_16x16x32_bf16(n1, lds_frag(Qs, tt * 16 + fr, 32 + fq * 8), an, 0, 0, 0);
                        if (fq == 0) FV[768 + pass * 64 + tt * 16 + fr] = an[0];
                    }
                }
                if (ty == 1) __syncthreads();
#pragma unroll
                for (int tt = 0; tt < 4; ++tt) {
                    const bf16x8 a0 = lds_frag(ATT, tt * 16 + fr, fq * 8), a1 = lds_frag(ATT, tt * 16 + fr, 32 + fq * 8);
                    const bf16x8 qq0 = lds_frag(Qs, tt * 16 + fr, fq * 8), qq1 = lds_frag(Qs, tt * 16 + fr, 32 + fq * 8);
                    f32x4 ao = {0.f, 0.f, 0.f, 0.f}, af = {0.f, 0.f, 0.f, 0.f}, ab = {0.f, 0.f, 0.f, 0.f};
                    ao = __builtin_amdgcn_mfma_f32_16x16x32_bf16(v0, a0, ao, 0, 0, 0);
                    ao = __builtin_amdgcn_mfma_f32_16x16x32_bf16(v1, a1, ao, 0, 0, 0);
                    af = __builtin_amdgcn_mfma_f32_16x16x32_bf16(sf0, qq0, af, 0, 0, 0);
                    af = __builtin_amdgcn_mfma_f32_16x16x32_bf16(sf1, qq1, af, 0, 0, 0);
                    const int i = tt * 16 + fr;
                    if (ty == 0) {
                        ab = __builtin_amdgcn_mfma_f32_16x16x32_bf16(sb0, qq0, ab, 0, 0, 0);
                        ab = __builtin_amdgcn_mfma_f32_16x16x32_bf16(sb1, qq1, ab, 0, 0, 0);
                        const float wf = exp2f((float)(i + 1) * l2f), wb = exp2f((float)(64 - i) * l2b);
                        otot[tt] += ao + af * wf + ab * wb;
                    } else {
                        const float* fv = FV + pass * 256;
                        const float wint = fv[128 + i], eden = fv[192 + i];
                        const float den = wint * FV[768 + pass * 64 + i] + FV[512 + (pass * 2) * 64 + i] + FV[512 + (pass * 2 + 1) * 64 + i];
                        const float inv = frcp_(fmaxf(fabsf(den), eden));
                        otot[tt] += (ao + af * wint) * inv;
                    }
                }
            }
            if (ty == 1) __syncthreads();
        }
        {
            float* ssw = FV + 896;
#pragma unroll
            for (int tt = 0; tt < 4; ++tt) {
                float ss = otot[tt][0] * otot[tt][0] + otot[tt][1] * otot[tt][1] + otot[tt][2] * otot[tt][2] + otot[tt][3] * otot[tt][3];
                ss += __shfl_xor(ss, 16); ss += __shfl_xor(ss, 32);
                if (fq == 0) ssw[wid * 64 + tt * 16 + fr] = ss;
            }
            __syncthreads();
            const float* nw = (ty ? a.ml_norm : a.ret_norm) + h * 128 + wid * 16 + fq * 4;
            const f32x4 nv = *(const f32x4*)nw;
#pragma unroll
            for (int tt = 0; tt < 4; ++tt) {
                const int i = tt * 16 + fr;
                float tot = 0.f;
#pragma unroll
                for (int w = 0; w < 8; ++w) tot += ssw[w * 64 + i];
                const float rsn = rsqrtf(tot * (1.0f / 128.0f) + EPSF);
                const f32x4 gz = ldz4(a.z + (size_t)(row0 + i) * AB_IN + (ty ? 2560 : 1024) + h * 128 + wid * 16 + fq * 4);
                float o[4];
#pragma unroll
                for (int r = 0; r < 4; ++r) {
                    const float gate = ty ? fsigmoid_(gz[r]) : gz[r] * fsigmoid_(gz[r]);
                    o[r] = otot[tt][r] * rsn * nv[r] * gate;
                }
                st_bf16x4(a.MG + (size_t)(row0 + i) * DM + ty * 512 + h * 128 + wid * 16 + fq * 4, o[0], o[1], o[2], o[3]);
            }
        }
    }
}


#define LP2 136
#define HREC 16384
struct L1Args {
    const bf16_t* z;
    const float* hgrn_lb; const float* hg_norm;
    bf16_t* HST;
    float* HDEC;
    bf16_t* MG;
    const float* shift; const float* w0; const float* w2; const float* a0; const float* a2; const float* g2;
    const float* kk_scale; const float* k_a; const float* r_k; const float* rw_norm;
    bf16_t* PKK; bf16_t* PV;
    float* PG;
    float* PW;
    bf16_t* PAB; bf16_t* PKE; bf16_t* PWR;
    float* PSC;
    float* PBON;
    float* RWO;
    bf16_t* WLR;
};
__device__ __forceinline__ size_t hrec_off(int dir, int h, int g) { return ((size_t)((dir * 4 + h) * NCHUNK + g)) * HREC; }
__device__ __forceinline__ bf16x8 lds_frag2(const bf16_t* base, int row, int kofs) { return *(const bf16x8*)(base + row * LP2 + kofs); }

__device__ __forceinline__ void ph_l1_local(const L1Args& a, int bi, int nb) {
    bf16_t* KD = (bf16_t*)g_shm;
    bf16_t* VT = KD + 2 * 128 * LP;
    bf16_t* RAW = VT + 128 * LP;
    const int tid = tid_fresh(), wid = tid >> 6, lane = tid & 63, fr = lane & 15, fq = lane >> 4;
    u32x4 praw[4]; bf16_t pv[16];
    auto prefetch = [&](int it) {
        const int g = it >> 2, h = it & 3, row0 = g * 64;
        const int tp = tid_fresh();
#pragma unroll
        for (int c = 0; c < 4; ++c) {
            const int idx = tp + NTHR * c, dir = idx >> 10, j = (idx >> 4) & 63, c8 = idx & 15;
            praw[c] = *(const u32x4*)(a.z + (size_t)(row0 + j) * CD_IN + 512 + dir * 512 + h * 128 + c8 * 8);
        }
        const int dv = tp & 127, vg = tp >> 7;
        const bf16_t* src = a.z + (size_t)(row0 + vg * 16) * CD_IN + 1536 + h * 128 + dv;
#pragma unroll
        for (int x = 0; x < 16; ++x) pv[x] = src[(size_t)x * CD_IN];
    };
    if (bi < NCHUNK * 4) prefetch(bi);
    for (int it = bi; it < NCHUNK * 4; it += nb) {
        const int g = it >> 2, h = it & 3;
        __syncthreads();
        {
            const int ts = tid_fresh();
#pragma unroll
            for (int c = 0; c < 4; ++c) {
                const int idx = ts + NTHR * c, dir = idx >> 10, j = (idx >> 4) & 63, c8 = idx & 15;
                *(u32x4*)(RAW + (dir * 64 + j) * 128 + c8 * 8) = praw[c];
            }
            const int dv = ts & 127, vg = ts >> 7;
            u32x4 o0, o1;
            o0.x = (unsigned)pv[0] | ((unsigned)pv[1] << 16); o0.y = (unsigned)pv[2] | ((unsigned)pv[3] << 16); o0.z = (unsigned)pv[4] | ((unsigned)pv[5] << 16); o0.w = (unsigned)pv[6] | ((unsigned)pv[7] << 16);
            o1.x = (unsigned)pv[8] | ((unsigned)pv[9] << 16); o1.y = (unsigned)pv[10] | ((unsigned)pv[11] << 16); o1.z = (unsigned)pv[12] | ((unsigned)pv[13] << 16); o1.w = (unsigned)pv[14] | ((unsigned)pv[15] << 16);
            *(u32x4*)(VT + dv * LP + vg * 16) = o0;
            *(u32x4*)(VT + dv * LP + vg * 16 + 8) = o1;
        }
        if (it + nb < NCHUNK * 4) prefetch(it + nb);
        __syncthreads();
        if (tid < 256) {
            const int dir = tid >> 7, d = tid & 127;
            const float p0 = a.hgrn_lb[h * 128 + d], p1 = a.hgrn_lb[512 + h * 128 + d];
            const float lb = 1.0f / (1.0f + expf(p0 - p1));
            const bf16_t* raw = RAW + dir * 64 * 128 + d;
            float E = 0.f;
            bf16_t* kd = KD + (dir * 128 + (((d >> 2) & 7) * 16 + (d >> 5) * 4 + (d & 3))) * LP;
#pragma unroll 8
            for (int s2 = 0; s2 < 64; ++s2) {
                const int j = dir ? s2 : 63 - s2;
                const float f = lb + (1.0f - lb) * fsigmoid_(bf16_to_f32(raw[j * 128]));
                kd[j] = f2bf((1.0f - f) * fexp_(E));
                E += flog_(f);
            }
            a.HDEC[((size_t)(dir * 4 + h) * NCHUNK + g) * 128 + d] = expf(E);
        }
        __syncthreads();
        const bf16x8 v0 = lds_frag(VT, wid * 16 + fr, fq * 8), v1 = lds_frag(VT, wid * 16 + fr, 32 + fq * 8);
#pragma unroll
        for (int dir = 0; dir < 2; ++dir) {
            bf16_t* st = a.HST + hrec_off(dir, h, g) + (size_t)(wid * 16 + fr) * 128 + fq * 32;
#pragma unroll
            for (int dp = 0; dp < 4; ++dp) {
                f32x4 acc0 = {0.f, 0.f, 0.f, 0.f}, acc1 = {0.f, 0.f, 0.f, 0.f};
                acc0 = __builtin_amdgcn_mfma_f32_16x16x32_bf16(lds_frag(KD + dir * 128 * LP, (2 * dp) * 16 + fr, fq * 8), v0, acc0, 0, 0, 0);
                acc0 = __builtin_amdgcn_mfma_f32_16x16x32_bf16(lds_frag(KD + dir * 128 * LP, (2 * dp) * 16 + fr, 32 + fq * 8), v1, acc0, 0, 0, 0);
                acc1 = __builtin_amdgcn_mfma_f32_16x16x32_bf16(lds_frag(KD + dir * 128 * LP, (2 * dp + 1) * 16 + fr, fq * 8), v0, acc1, 0, 0, 0);
                acc1 = __builtin_amdgcn_mfma_f32_16x16x32_bf16(lds_frag(KD + dir * 128 * LP, (2 * dp + 1) * 16 + fr, 32 + fq * 8), v1, acc1, 0, 0, 0);
                st_bf16x8(st + dp * 8, acc0[0], acc0[1], acc0[2], acc0[3], acc1[0], acc1[1], acc1[2], acc1[3]);
            }
        }
    }
}
__device__ __forceinline__ void ph_l1_prop(const L1Args& a, int bi, int nb) {
    for (int idx = bi * NTHR + tid_fresh(); idx < 32 * (HREC / 4); idx += nb * NTHR) {
        const int seq = idx / (HREC / 4), e4 = idx % (HREC / 4);
        const int dir = seq >> 4, h = (seq >> 2) & 3, b = seq & 3;
        const int d4 = (e4 & 31) * 4;
        f32x4 S = {0.f, 0.f, 0.f, 0.f};
        for (int s0 = 0; s0 < 132; s0 += 12) {
            f32x4 loc[12], dec[12];
#pragma unroll
            for (int i = 0; i < 12; ++i) {
                const int g = chunk_g(b, dir, s0 + i);
                loc[i] = ldz4(a.HST + hrec_off(dir, h, g) + (size_t)e4 * 4);
                dec[i] = *(const f32x4*)(a.HDEC + ((size_t)(dir * 4 + h) * NCHUNK + g) * 128 + d4);
            }
#pragma unroll
            for (int i = 0; i < 12; ++i) {
                const int g = chunk_g(b, dir, s0 + i);
                st_bf16x4(a.HST + hrec_off(dir, h, g) + (size_t)e4 * 4, S[0], S[1], S[2], S[3]);
                S = S * dec[i] + loc[i];
            }
        }
    }
}
__device__ __forceinline__ void ph_l1_out(const L1Args& a, int bi, int nb) {
    bf16_t* QA = (bf16_t*)g_shm;
    bf16_t* R2 = QA + 2 * 64 * LP2;
    bf16_t* ATT = R2 + 2 * 128 * LP2;
    bf16_t* VT = ATT + 64 * LP;
    float* ssw = (float*)(VT + 128 * LP);
    bf16_t* RAWF = R2 + 128 * LP2;
    bf16_t* RAWQ = ATT;
    const int tid = tid_fresh(), wid = tid >> 6, lane = tid & 63, fr = lane & 15, fq = lane >> 4;
    u32x4 praw[6]; bf16_t pv[16];
    auto prefetch = [&](int it) {
        const int g = it >> 2, h = it & 3, row0 = g * 64;
        const int tp = tid_fresh();
#pragma unroll
        for (int c = 0; c < 6; ++c) {
            const int idx = tp + NTHR * c, arr = idx >> 10, j = (idx >> 4) & 63, c8 = idx & 15;
            praw[c] = *(const u32x4*)(a.z + (size_t)(row0 + j) * CD_IN + (arr < 2 ? 512 + arr * 512 : 0) + h * 128 + c8 * 8);
        }
        const int dv = tp & 127, vg = tp >> 7;
        const bf16_t* src = a.z + (size_t)(row0 + vg * 16) * CD_IN + 1536 + h * 128 + dv;
#pragma unroll
        for (int x = 0; x < 16; ++x) pv[x] = src[(size_t)x * CD_IN];
    };
    if (bi < NCHUNK * 4) prefetch(bi);
    for (int it = bi; it < NCHUNK * 4; it += nb) {
        const int g = it >> 2, h = it & 3, row0 = g * 64;
        __syncthreads();
        {
            const int ts = tid_fresh();
#pragma unroll
            for (int c = 0; c < 6; ++c) {
                const int idx = ts + NTHR * c, arr = idx >> 10, j = (idx >> 4) & 63, c8 = idx & 15;
                bf16_t* dst = (arr < 2 ? RAWF + (arr * 64 + j) * 128 : RAWQ + j * 128) + c8 * 8;
                *(u32x4*)dst = praw[c];
            }
        }
        u32x4 ps[2][4];
        {
            const int tq = tid_fresh();
#pragma unroll
            for (int dir = 0; dir < 2; ++dir) {
                const bf16_t* sp = a.HST + hrec_off(dir, h, g);
#pragma unroll
                for (int c = 0; c < 4; ++c) { const int e = (c * NTHR + tq) * 8; ps[dir][c] = *(const u32x4*)(sp + e); }
            }
        }
        __syncthreads();
        if (tid < 256) {
            const int dir = tid >> 7, d = tid & 127;
            const float p0 = a.hgrn_lb[h * 128 + d], p1 = a.hgrn_lb[512 + h * 128 + d];
            const float lb = 1.0f / (1.0f + expf(p0 - p1));
            const bf16_t* rf = RAWF + dir * 64 * 128 + d;
            const bf16_t* rq = RAWQ + d;
            float B = 0.f;
#pragma unroll 8
            for (int s2 = 0; s2 < 64; ++s2) {
                const int j = dir ? 63 - s2 : s2;
                const float f = lb + (1.0f - lb) * fsigmoid_(bf16_to_f32(rf[j * 128]));
                B += flog_(f);
                QA[(dir * 64 + j) * LP2 + d] = f2bf(bf16_to_f32(rq[j * 128]) * fexp_(B));
                R2[(dir * 64 + j) * LP2 + d] = f2bf((1.0f - f) * fexp_(fminf(-B, 80.0f)));
            }
        }
        __syncthreads();
        {
            const int ts = tid_fresh();
            const int dv = ts & 127, vg = ts >> 7;
            u32x4 o0, o1;
            o0.x = (unsigned)pv[0] | ((unsigned)pv[1] << 16); o0.y = (unsigned)pv[2] | ((unsigned)pv[3] << 16); o0.z = (unsigned)pv[4] | ((unsigned)pv[5] << 16); o0.w = (unsigned)pv[6] | ((unsigned)pv[7] << 16);
            o1.x = (unsigned)pv[8] | ((unsigned)pv[9] << 16); o1.y = (unsigned)pv[10] | ((unsigned)pv[11] << 16); o1.z = (unsigned)pv[12] | ((unsigned)pv[13] << 16); o1.w = (unsigned)pv[14] | ((unsigned)pv[15] << 16);
            *(u32x4*)(VT + dv * LP + vg * 16) = o0;
            *(u32x4*)(VT + dv * LP + vg * 16 + 8) = o1;
        }
        {
            const int itl = wid >> 1, i = itl * 16 + fr;
#pragma unroll
            for (int jj = 0; jj < 2; ++jj) {
                const int jt = (wid & 1) * 2 + jj;
                f32x4 af = {0.f, 0.f, 0.f, 0.f}, ab = {0.f, 0.f, 0.f, 0.f};
#pragma unroll
                for (int ks = 0; ks < 4; ++ks) {
                    af = __builtin_amdgcn_mfma_f32_16x16x32_bf16(lds_frag2(R2, jt * 16 + fr, ks * 32 + fq * 8), lds_frag2(QA, itl * 16 + fr, ks * 32 + fq * 8), af, 0, 0, 0);
                    ab = __builtin_amdgcn_mfma_f32_16x16x32_bf16(lds_frag2(R2 + 64 * LP2, jt * 16 + fr, ks * 32 + fq * 8), lds_frag2(QA + 64 * LP2, itl * 16 + fr, ks * 32 + fq * 8), ab, 0, 0, 0);
                }
                float sv[4];
#pragma unroll
                for (int r = 0; r < 4; ++r) {
                    const int j = jt * 16 + fq * 4 + r;
                    sv[r] = ((j <= i) ? af[r] : 0.f) + ((j >= i) ? ab[r] : 0.f);
                }
                u32x2 w; w.x = cvt_pk_bf16(sv[0], sv[1]); w.y = cvt_pk_bf16(sv[2], sv[3]);
                *(u32x2*)(ATT + i * LP + jt * 16 + fq * 4) = w;
            }
        }
        __syncthreads();
        {
            const int tq = tid_fresh();
#pragma unroll
            for (int dir = 0; dir < 2; ++dir) {
#pragma unroll
                for (int c = 0; c < 4; ++c) {
                    const int e = (c * NTHR + tq) * 8;
                    const int dv = e >> 7, d = e & 127;
                    *(u32x4*)(R2 + (dir * 128 + dv) * LP2 + d) = ps[dir][c];
                }
            }
            if (it + nb < NCHUNK * 4) prefetch(it + nb);
        }
        __syncthreads();
        f32x4 o4[4];
        {
            const bf16x8 v0 = lds_frag(VT, wid * 16 + fr, fq * 8), v1 = lds_frag(VT, wid * 16 + fr, 32 + fq * 8);
#pragma unroll
            for (int tt = 0; tt < 4; ++tt) {
                f32x4 acc = {0.f, 0.f, 0.f, 0.f};
                acc = __builtin_amdgcn_mfma_f32_16x16x32_bf16(v0, lds_frag(ATT, tt * 16 + fr, fq * 8), acc, 0, 0, 0);
                acc = __builtin_amdgcn_mfma_f32_16x16x32_bf16(v1, lds_frag(ATT, tt * 16 + fr, 32 + fq * 8), acc, 0, 0, 0);
#pragma unroll
                for (int dir = 0; dir < 2; ++dir)
#pragma unroll
                    for (int ks = 0; ks < 4; ++ks)
                        acc = __builtin_amdgcn_mfma_f32_16x16x32_bf16(lds_frag2(R2 + dir * 128 * LP2, wid * 16 + fr, ks * 32 + fq * 8),
                                                                      lds_frag2(QA + dir * 64 * LP2, tt * 16 + fr, ks * 32 + fq * 8), acc, 0, 0, 0);
                o4[tt] = acc;
            }
        }
#pragma unroll
        for (int tt = 0; tt < 4; ++tt) {
            float ss = o4[tt][0] * o4[tt][0] + o4[tt][1] * o4[tt][1] + o4[tt][2] * o4[tt][2] + o4[tt][3] * o4[tt][3];
            ss += __shfl_xor(ss, 16); ss += __shfl_xor(ss, 32);
            if (fq == 0) ssw[wid * 64 + tt * 16 + fr] = ss;
        }
        __syncthreads();
        const f32x4 nv = *(const f32x4*)(a.hg_norm + h * 128 + wid * 16 + fq * 4);
#pragma unroll
        for (int tt = 0; tt < 4; ++tt) {
            const int i = tt * 16 + fr;
            float tot = 0.f;
#pragma unroll
            for (int w = 0; w < 8; ++w) tot += ssw[w * 64 + i];
            const float rsn = rsqrtf(tot * (1.0f / 128.0f) + EPSF);
            const f32x4 gz = ldz4(a.z + (size_t)(row0 + i) * CD_IN + 2048 + h * 128 + wid * 16 + fq * 4);
            st_bf16x4(a.MG + (size_t)(row0 + i) * DM + h * 128 + wid * 16 + fq * 4,
                      o4[tt][0] * rsn * nv[0] * fsigmoid_(gz[0]), o4[tt][1] * rsn * nv[1] * fsigmoid_(gz[1]),
                      o4[tt][2] * rsn * nv[2] * fsigmoid_(gz[2]), o4[tt][3] * rsn * nv[3] * fsigmoid_(gz[3]));
        }
    }
}

__device__ __forceinline__ void ph_l1_wlr(const L1Args& a) {
    const int gt = blockIdx.x * NTHR + tid_fresh(), gs = gridDim.x * NTHR;
    for (int i = gt; i < 4 * 32768 + 65536; i += gs) {
        float v;
        if (i < 4 * 32768) { const int m = i >> 15, e = i & 32767, n = e >> 6, k = e & 63; v = (m < 2 ? a.w2 : a.a2)[((size_t)(m & 1) * 64 + k) * 512 + n]; }
        else { const int e = i - 4 * 32768, n = e >> 7, k = e & 127; v = a.g2[(size_t)k * 512 + n]; }
        a.WLR[i] = f2bf(v);
    }
}
#define FP 392
__device__ __forceinline__ void ph_l1_rwprep(const L1Args& a) {
    bf16_t* F = (bf16_t*)g_shm;
    float* SH = (float*)(F + 32 * FP);
    float* PT = SH + 3 * 1920;
    const int tid = tid_fresh(), wid = tid >> 6, lane = tid & 63, fr = lane & 15, fq = lane >> 4;
    const int tt = wid & 1, hg = wid >> 1;
    __syncthreads();
    for (int i = tid; i < 3 * 1920; i += NTHR) SH[i] = a.shift[i];
    for (int i = tid; i < 512; i += NTHR) { PT[i] = a.kk_scale[i]; PT[512 + i] = a.k_a[i]; PT[1024 + i] = a.r_k[i]; }
    for (int i = tid; i < 1024; i += NTHR) { PT[1536 + i] = a.w0[i]; PT[2560 + i] = a.a0[i]; }
    constexpr int NIT = NTOK / 32;
    const int G = gridDim.x, nfull = (NIT / G) * G, rem = NIT - nfull;
    const bool split = 2 * rem <= G;
    const int nmine = (int)blockIdx.x < nfull ? (nfull / G) : 0;
    const int extra = split ? ((int)blockIdx.x < 2 * rem ? 1 : 0) : ((int)blockIdx.x < rem ? 1 : 0);
    for (int q = 0; q < nmine + extra; ++q) {
        const bool tail = q >= nmine;
        const int it = !tail ? (int)blockIdx.x + q * G : nfull + (split ? ((int)blockIdx.x >> 1) : (int)blockIdx.x);
        const int i0 = (tail && split) ? ((int)blockIdx.x & 1) * 4 : 0, i1 = (tail && split) ? i0 + 4 : 8;
        const int row0 = it * 32;
        __syncthreads();
#pragma unroll 1
        for (int jb = 0; jb < 2; ++jb) {
            u32x2 zz[3][3];
#pragma unroll
            for (int j = 0; j < 3; ++j) {
                const int idx = tid + NTHR * (jb * 3 + j), tk = idx / 96, cg = idx - tk * 96;
                const int r = row0 + tk;
                const RowInfo ri = row_info(r);
                const bf16_t* zp = a.z + (size_t)r * CD_IN + 2560 + 1536 + cg * 4;
                zz[j][0] = *(const u32x2*)(zp - (ri.t > 0 ? CD_IN : 0));
                zz[j][1] = *(const u32x2*)zp;
                zz[j][2] = *(const u32x2*)(zp + (ri.t < ri.len - 1 ? CD_IN : 0));
            }
#pragma unroll
            for (int j = 0; j < 3; ++j) {
                const int idx = tid + NTHR * (jb * 3 + j), tk = idx / 96, cg = idx - tk * 96;
                const RowInfo ri = row_info(row0 + tk);
                const float mp = ri.t > 0 ? 1.0f : 0.0f, mn = ri.t < ri.len - 1 ? 1.0f : 0.0f;
                const int ch = 1536 + cg * 4;
                float o[4];
#pragma unroll
                for (int x = 0; x < 4; ++x) {
                    const unsigned wp_ = x < 2 ? zz[j][0].x : zz[j][0].y, wc_ = x < 2 ? zz[j][1].x : zz[j][1].y, wn_ = x < 2 ? zz[j][2].x : zz[j][2].y;
                    const float pv_ = __uint_as_float((x & 1) ? (wp_ & 0xffff0000u) : (wp_ << 16)), cv_ = __uint_as_float((x & 1) ? (wc_ & 0xffff0000u) : (wc_ << 16)),
                                nv_ = __uint_as_float((x & 1) ? (wn_ & 0xffff0000u) : (wn_ << 16));
                    const float cv = SH[ch + x] * pv_ * mp + SH[1920 + ch + x] * cv_ + SH[3840 + ch + x] * nv_ * mn;
                    const float sg = frcp_(1.0f + __expf(cg < 32 ? -2.0f * cv : -cv));
                    o[x] = (cg < 32) ? (2.0f * sg - 1.0f) : ((cg < 64) ? cv : sg);
                }
                st_bf16x4(F + tk * FP + cg * 4, o[0], o[1], o[2], o[3]);
            }
        }
        __syncthreads();
        const int r = row0 + tt * 16 + fr;
        const RowInfo ri = row_info(r);
        const float mp = ri.t > 0 ? 1.0f : 0.0f, mn = ri.t < ri.len - 1 ? 1.0f : 0.0f;
        const bf16_t* zc = a.z + (size_t)r * CD_IN + 2560;
        const bf16_t* zpv = zc - (ri.t > 0 ? CD_IN : 0);
        const bf16_t* znx = zc + (ri.t < ri.len - 1 ? CD_IN : 0);
        const bf16_t* fbp = F + (tt * 16 + fr) * FP + fq * 8;
        auto conv_from = [&](const u32x2 (&zr)[3], int ch) -> f32x4 {
            f32x4 o;
#pragma unroll
            for (int x = 0; x < 4; ++x) {
                const unsigned wp_ = x < 2 ? zr[0].x : zr[0].y, wc_ = x < 2 ? zr[1].x : zr[1].y, wn_ = x < 2 ? zr[2].x : zr[2].y;
                const float pv_ = __uint_as_float((x & 1) ? (wp_ & 0xffff0000u) : (wp_ << 16)), cv_ = __uint_as_float((x & 1) ? (wc_ & 0xffff0000u) : (wc_ << 16)),
                            nv_ = __uint_as_float((x & 1) ? (wn_ & 0xffff0000u) : (wn_ << 16));
                o[x] = SH[ch + x] * pv_ * mp + SH[1920 + ch + x] * cv_ + SH[3840 + ch + x] * nv_ * mn;
            }
            return o;
        };
        bf16x8 wa[8]; u32x2 zr[3][3];
        auto issue = [&](int idx) {
            const int h = hg + 4 * (idx >> 2), nt = idx & 3;
            const int n = h * 64 + (nt >> 1) * 32 + 8 * (fr >> 2) + 4 * (nt & 1) + (fr & 3), ch = h * 64 + (nt >> 1) * 32 + 8 * fq + 4 * (nt & 1);
#pragma unroll
            for (int m = 0; m < 4; ++m)
#pragma unroll
                for (int ks = 0; ks < 2; ++ks) wa[m * 2 + ks] = *(const bf16x8*)(a.WLR + (size_t)m * 32768 + n * 64 + ks * 32 + fq * 8);
#pragma unroll
            for (int arr = 0; arr < 3; ++arr) {
                zr[arr][0] = *(const u32x2*)(zpv + arr * 512 + ch); zr[arr][1] = *(const u32x2*)(zc + arr * 512 + ch); zr[arr][2] = *(const u32x2*)(znx + arr * 512 + ch);
            }
        };
        issue(i0);
        float rn = 0.f, br0 = 0.f, kr0 = 0.f, br1 = 0.f, kr1 = 0.f, bonus = 0.f;
        u32x2 sv_pv = {0u, 0u}, sv_kk = {0u, 0u}, sv_ab[2] = {{0u, 0u}, {0u, 0u}}, sv_ke[2] = {{0u, 0u}, {0u, 0u}}, sv_wr[2] = {{0u, 0u}, {0u, 0u}};
#pragma unroll 1
        for (int idx = i0; idx < i1; ++idx) {
            const int h = hg + 4 * (idx >> 2), nt = idx & 3;
            const bool odd = nt & 1;
            auto emit = [&](bf16_t* dst, u32x2& stash, float x0, float x1, float x2, float x3) {
                u32x2 w; w.x = cvt_pk_bf16(x0, x1); w.y = cvt_pk_bf16(x2, x3);
                if (odd) { u32x4 q; q.x = stash.x; q.y = stash.y; q.z = w.x; q.w = w.y; *(u32x4*)(dst - 4) = q; }
                else stash = w;
            };
            if (nt == 0) {
                u32x2 zk[4][3];
#pragma unroll
                for (int q = 0; q < 4; ++q) { const int ch = 512 + h * 64 + q * 16 + fq * 4; zk[q][0] = *(const u32x2*)(zpv + ch); zk[q][1] = *(const u32x2*)(zc + ch); zk[q][2] = *(const u32x2*)(znx + ch); }
                float ssk = 0.f;
#pragma unroll
                for (int q = 0; q < 4; ++q) {
                    const int chh = h * 64 + q * 16 + fq * 4;
                    const f32x4 kq4 = conv_from(zk[q], 512 + chh) * *(const f32x4*)(PT + chh);
                    ssk += kq4[0] * kq4[0] + kq4[1] * kq4[1] + kq4[2] * kq4[2] + kq4[3] * kq4[3];
                }
                ssk += __shfl_xor(ssk, 16); ssk += __shfl_xor(ssk, 32);
                rn = rsqrtf(ssk + EPSF);
                br0 = 0.f; kr0 = 0.f; br1 = 0.f; kr1 = 0.f; bonus = 0.f;
            }
            f32x4 acc[4];
#pragma unroll
            for (int m = 0; m < 4; ++m) acc[m] = (f32x4){0.f, 0.f, 0.f, 0.f};
#pragma unroll
            for (int m = 0; m < 4; ++m)
#pragma unroll
                for (int ks = 0; ks < 2; ++ks) acc[m] = __builtin_amdgcn_mfma_f32_16x16x32_bf16(wa[m * 2 + ks], *(const bf16x8*)(fbp + (m * 2 + ks) * 32), acc[m], 0, 0, 0);
            const int ch = h * 64 + (nt >> 1) * 32 + 8 * fq + 4 * (nt & 1);
            const f32x4 rv = conv_from(zr[0], ch), kv = conv_from(zr[1], 512 + ch), vv = conv_from(zr[2], 1024 + ch);
            if (idx + 1 < i1) issue(idx + 1);
            const f32x4 kn = kv * *(const f32x4*)(PT + ch) * rn;
            const size_t o = (size_t)r * 512 + ch;
            emit(a.PV + o, sv_pv, vv[0], vv[1], vv[2], vv[3]);
            emit(a.PKK + o, sv_kk, kn[0], kn[1], kn[2], kn[3]);
            const f32x4 kav = *(const f32x4*)(PT + 512 + ch), rkv = *(const f32x4*)(PT + 1024 + ch);
#pragma unroll
            for (int d = 0; d < 2; ++d) {
                const size_t od = (size_t)d * NTOK * 512 + o;
                const f32x4 w0v = *(const f32x4*)(PT + 1536 + d * 512 + ch), a0v = *(const f32x4*)(PT + 2560 + d * 512 + ch);
                f32x4 wv; float ab[4], ke[4], wr[4];
                float brs = 0.f, krs = 0.f;
#pragma unroll
                for (int x = 0; x < 4; ++x) {
                    const float pw = acc[d][x] + w0v[x], pa = acc[2 + d][x] + a0v[x];
                    const float sp_ = fmaxf(-pw, 0.0f) + flog_(1.0f + fexp_(-fabsf(pw)));
                    const float w = fexp_(-fexp_(-sp_ - 0.5f));
                    const float av = fsigmoid_(pa);
                    wv[x] = w;
                    ke[x] = kv[x] * (1.0f + (av - 1.0f) * kav[x]);
                    ab[x] = kn[x] * av;
                    wr[x] = w * rv[x];
                    brs += ab[x] * rv[x]; krs += ke[x] * rv[x]; bonus += rv[x] * ke[x] * rkv[x];
                }
                if (d == 0) { br0 += brs; kr0 += krs; } else { br1 += brs; kr1 += krs; }
                *(f32x4*)(a.PW + od) = wv;
                emit(a.PAB + od, sv_ab[d], ab[0], ab[1], ab[2], ab[3]);
                emit(a.PKE + od, sv_ke[d], ke[0], ke[1], ke[2], ke[3]);
                emit(a.PWR + od, sv_wr[d], wr[0], wr[1], wr[2], wr[3]);
            }
            if (nt == 3) {
#pragma unroll
                for (int o2 = 16; o2 < 64; o2 <<= 1) { br0 += __shfl_xor(br0, o2); kr0 += __shfl_xor(kr0, o2); br1 += __shfl_xor(br1, o2); kr1 += __shfl_xor(kr1, o2); bonus += __shfl_xor(bonus, o2); }
                if (fq == 0) {
                    float* sc0 = a.PSC + ((size_t)r) * 16 + h * 2; sc0[0] = br0; sc0[1] = kr0;
                    float* sc1 = a.PSC + ((size_t)NTOK + r) * 16 + h * 2; sc1[0] = br1; sc1[1] = kr1;
                    a.PBON[(size_t)r * 8 + h] = bonus;
                }
            }
        }
    }
}

__device__ __forceinline__ void ph_l1_gate(const L1Args& a, int bi, int nb) {
    bf16_t* FG = (bf16_t*)g_shm;
    float* SG = (float*)(FG + 32 * 136);
    const int tid = tid_fresh(), wid = tid >> 6, lane = tid & 63, fr = lane & 15, fq = lane >> 4;
    const int tt = wid & 1, ng = wid >> 1;
    __syncthreads();
    if (tid < 384) SG[tid] = a.shift[(tid >> 7) * 1920 + 1792 + (tid & 127)];
    bf16x8 wg[8][4];
#pragma unroll
    for (int t = 0; t < 8; ++t)
#pragma unroll
        for (int ks = 0; ks < 4; ++ks) wg[t][ks] = *(const bf16x8*)(a.WLR + 131072 + (size_t)(ng * 128 + t * 16 + fr) * 128 + ks * 32 + fq * 8);
    for (int it = bi; it < NTOK / 32; it += nb) {
        const int row0 = it * 32;
        __syncthreads();
        {
            const int ts = tid_fresh(), tk = ts >> 4, c8 = ts & 15, r = row0 + tk;
            const RowInfo ri = row_info(r);
            const float mp = ri.t > 0 ? 1.0f : 0.0f, mn = ri.t < ri.len - 1 ? 1.0f : 0.0f;
            const bf16_t* zp = a.z + (size_t)r * CD_IN + 2560 + 1536 + 256 + c8 * 8;
            const u32x4 zp_ = *(const u32x4*)(zp - (ri.t > 0 ? CD_IN : 0)), zc_ = *(const u32x4*)zp, zn_ = *(const u32x4*)(zp + (ri.t < ri.len - 1 ? CD_IN : 0));
            const unsigned wp[4] = {zp_.x, zp_.y, zp_.z, zp_.w}, wc[4] = {zc_.x, zc_.y, zc_.z, zc_.w}, wn[4] = {zn_.x, zn_.y, zn_.z, zn_.w};
            float o[8];
#pragma unroll
            for (int x = 0; x < 8; ++x) {
                const unsigned p_ = wp[x >> 1], c_ = wc[x >> 1], n_ = wn[x >> 1];
                const float pv_ = __uint_as_float((x & 1) ? (p_ & 0xffff0000u) : (p_ << 16)), cv_ = __uint_as_float((x & 1) ? (c_ & 0xffff0000u) : (c_ << 16)),
                            nv_ = __uint_as_float((x & 1) ? (n_ & 0xffff0000u) : (n_ << 16));
                const int ch = c8 * 8 + x;
                const float cv = SG[ch] * pv_ * mp + SG[128 + ch] * cv_ + SG[256 + ch] * nv_ * mn;
                o[x] = frcp_(1.0f + __expf(-cv));
            }
            u32x4 w; w.x = cvt_pk_bf16(o[0], o[1]); w.y = cvt_pk_bf16(o[2], o[3]); w.z = cvt_pk_bf16(o[4], o[5]); w.w = cvt_pk_bf16(o[6], o[7]);
            *(u32x4*)(FG + tk * 136 + c8 * 8) = w;
        }
        __syncthreads();
        bf16x8 fb[4];
#pragma unroll
        for (int ks = 0; ks < 4; ++ks) fb[ks] = *(const bf16x8*)(FG + (tt * 16 + fr) * 136 + ks * 32 + fq * 8);
        float* dst = a.PG + (size_t)(row0 + tt * 16 + fr) * 512 + ng * 128 + fq * 4;
#pragma unroll
        for (int t = 0; t < 8; ++t) {
            f32x4 acc = {0.f, 0.f, 0.f, 0.f};
#pragma unroll
            for (int ks = 0; ks < 4; ++ks) acc = __builtin_amdgcn_mfma_f32_16x16x32_bf16(wg[t][ks], fb[ks], acc, 0, 0, 0);
            *(f32x4*)(dst + t * 16) = acc;
        }
    }
}
#define RW_NB 32
template <int CTRL> __device__ __forceinline__ float dppf(float v) { return __int_as_float(__builtin_amdgcn_update_dpp(0, __float_as_int(v), CTRL, 0xF, 0xF, true)); }
__device__ __forceinline__ int rw_row(int b, int dir, int s) {
    if (s < TC) return b * TC + (dir ? (TC - 1 - s) : s);
    const int s2 = s - TC; return NCTX + b * TL + (dir ? (TL - 1 - s2) : s2);
}
#define RW2_STR 400
__device__ __forceinline__ void ph_l1_rwkv2(const L1Args& a, int bi, int nblk) {
    float* OUT = (float*)g_shm;
    float* BUF = OUT + 2 * RW_NB * 32;
    const int tid = tid_fresh(), wid = tid >> 6, lane = tid & 63;
    constexpr int NBT = (TC + TL) / RW_NB;
    constexpr int NPC = 53;
    typedef float f32x2 __attribute__((ext_vector_type(2)));
    for (int u = bi; u < 128; u += nblk) {
        const int seq = u >> 1, half = u & 1;
        const int dir = seq & 1, h = (seq >> 1) & 7, b = seq >> 4;
        const size_t dof = (size_t)dir * NTOK * 512;
        const int lt = tid - 256, lw = lt >> 6, ll = lt & 63;
        const int sgn = dir ? -1 : 1;
        const char* gb0 = (const char*)a.PKK;
        const int p32 = lt & 31, qa = p32 >> 3, ca = p32 & 7, s0 = lt >> 5;
        const bf16_t* arrA = qa == 0 ? a.PKK : (qa == 1 ? a.PAB + dof : (qa == 2 ? a.PKE + dof : a.PWR + dof));
        const unsigned offA = (unsigned)(size_t)((const char*)(arrA + h * 64 + ca * 8) - gb0) + (unsigned)(sgn * s0) * 1024u;
        const int dA = s0 * RW2_STR + (qa == 0 ? 0 : 64 + qa * 64) + ca * 8;
        unsigned offX = 0u, offD = 0u; int dX = 0;
        if (lw < 2) { const int c = lt & 15, s1 = lt >> 4;
            offX = (unsigned)(size_t)((const char*)(a.PW + dof + h * 64 + c * 4) - gb0) + (unsigned)(sgn * s1) * 2048u; dX = s1 * RW2_STR + 64 + c * 4; }
        else if (lw == 2) { const int c = ll & 3, s3 = ll >> 2;
            offX = (unsigned)(size_t)((const char*)(a.PV + h * 64 + half * 32 + c * 8) - gb0) + (unsigned)(sgn * s3) * 1024u; dX = s3 * RW2_STR + 320 + c * 16;
            offD = (unsigned)(size_t)((const char*)(a.PSC + (size_t)dir * NTOK * 16 + h * 2) - gb0) + (unsigned)(sgn * ll) * 64u; }
        const unsigned offF = (unsigned)((dof + (size_t)h * 64 + half * 32 + (ll & 7) * 4) * 4) + (unsigned)(sgn * (ll >> 3)) * 2048u;
        u32x4 raw[8];
        auto issue = [&](int bt) {
            const unsigned rowb = (unsigned)rw_row(b, dir, bt * RW_NB);
            const unsigned oA = offA + rowb * 1024u, stA = (unsigned)(sgn * 8) * 1024u;
#pragma unroll
            for (int j = 0; j < 4; ++j) raw[j] = *(const u32x4*)(gb0 + (size_t)(oA + (unsigned)j * stA));
            if (lw < 2) {
                const unsigned oX = offX + rowb * 2048u, stX = (unsigned)(sgn * 8) * 2048u;
#pragma unroll
                for (int j = 0; j < 4; ++j) raw[4 + j] = *(const u32x4*)(gb0 + (size_t)(oX + (unsigned)j * stX));
            } else if (lw == 2) {
                const unsigned oX = offX + rowb * 1024u, stX = (unsigned)(sgn * 16) * 1024u;
#pragma unroll
                for (int j = 0; j < 2; ++j) raw[4 + j] = *(const u32x4*)(gb0 + (size_t)(oX + (unsigned)j * stX));
                if (ll < 32) { const u32x2 t2 = *(const u32x2*)(gb0 + (size_t)(offD + rowb * 64u)); raw[6].x = t2.x; raw[6].y = t2.y; }
            }
        };
        auto cvt8 = [&](const u32x4 w, f32x4& l4, f32x4& h4) {
            l4[0] = __uint_as_float(w.x << 16); l4[1] = __uint_as_float(w.x & 0xffff0000u); l4[2] = __uint_as_float(w.y << 16); l4[3] = __uint_as_float(w.y & 0xffff0000u);
            h4[0] = __uint_as_float(w.z << 16); h4[1] = __uint_as_float(w.z & 0xffff0000u); h4[2] = __uint_as_float(w.w << 16); h4[3] = __uint_as_float(w.w & 0xffff0000u);
        };
        auto commit = [&](int bt) {
            float* bb = BUF + (bt & 1) * RW_NB * RW2_STR;
#pragma unroll
            for (int j = 0; j < 4; ++j) {
                f32x4 l4, h4; cvt8(raw[j], l4, h4);
                float* d = bb + dA + 8 * j * RW2_STR;
                *(f32x4*)d = l4; *(f32x4*)(d + 4) = h4;
            }
            if (lw < 2) {
#pragma unroll
                for (int j = 0; j < 4; ++j) *(u32x4*)(bb + dX + 8 * j * RW2_STR) = raw[4 + j];
            } else if (lw == 2) {
#pragma unroll
                for (int j = 0; j < 2; ++j) {
                    f32x4 l4, h4; cvt8(raw[4 + j], l4, h4);
                    float* d = bb + dX + 16 * j * RW2_STR;
                    *(f32x4*)d = (f32x4){l4[0], l4[1], l4[1], l4[0]}; *(f32x4*)(d + 4) = (f32x4){l4[2], l4[3], l4[3], l4[2]};
                    *(f32x4*)(d + 8) = (f32x4){h4[0], h4[1], h4[1], h4[0]}; *(f32x4*)(d + 12) = (f32x4){h4[2], h4[3], h4[3], h4[2]};
                }
                if (ll < 32) { u32x2 t2; t2.x = raw[6].x; t2.y = raw[6].y; *(u32x2*)(bb + ll * RW2_STR + 384) = t2; }
            }
        };
        auto flush = [&](int bt) {
            if (lw == 3) {
                const unsigned rowb = (unsigned)rw_row(b, dir, bt * RW_NB);
                const unsigned oF = offF + rowb * 2048u, stF = (unsigned)(sgn * 8) * 2048u;
#pragma unroll
                for (int r = 0; r < 4; ++r) {
                    const f32x4 v4 = *(const f32x4*)(OUT + (bt & 1) * RW_NB * 32 + (ll + 64 * r) * 4);
                    *(f32x4*)((char*)a.RWO + (size_t)(oF + (unsigned)r * stF)) = v4;
                }
            }
        };
        __syncthreads();
        if (wid >= 4) { issue(0); commit(0); issue(1); }
        f32x2 S0 = {0.f, 0.f}, S1 = {0.f, 0.f}, S2 = {0.f, 0.f}, S3 = {0.f, 0.f};
        const int dr = lane >> 4, l16 = lane & 15, rp = (wid & 3) * 4 + dr, hi8 = l16 >> 3;
        const int vo = 320 + rp * 4 + hi8 * 2, oo = rp * 2 + hi8;
        for (int bt = 0; bt < NBT; ++bt) {
            asm volatile("s_waitcnt lgkmcnt(0)" ::: "memory");
            __builtin_amdgcn_s_barrier();
            asm volatile("" ::: "memory");
            if (wid >= 4) {
                if (bt + 1 < NBT) commit(bt + 1);
                if (bt + 2 < NBT) issue(bt + 2);
                if (bt > 0) flush(bt - 1);
            } else {
                const float* base = BUF + (bt & 1) * RW_NB * RW2_STR;
                float* outp = OUT + (bt & 1) * RW_NB * 32 + oo;
                const float* bs = base;
                f32x4 kk4 = *(const f32x4*)(bs + l16 * 4), w4 = *(const f32x4*)(bs + 64 + l16 * 4), ab4 = *(const f32x4*)(bs + 128 + l16 * 4),
                      ke4 = *(const f32x4*)(bs + 192 + l16 * 4), wr4 = *(const f32x4*)(bs + 256 + l16 * 4);
                f32x2 v2 = *(const f32x2*)(bs + vo), sc2 = *(const f32x2*)(bs + 384);
#pragma unroll
                for (int si = 0; si < RW_NB; ++si) {
                    const float* bn = base + (si + 1 < RW_NB ? si + 1 : si) * RW2_STR;
                    const f32x4 nkk4 = *(const f32x4*)(bn + l16 * 4), nw4 = *(const f32x4*)(bn + 64 + l16 * 4), nab4 = *(const f32x4*)(bn + 128 + l16 * 4),
                                nke4 = *(const f32x4*)(bn + 192 + l16 * 4), nwr4 = *(const f32x4*)(bn + 256 + l16 * 4);
                    const f32x2 nv2 = *(const f32x2*)(bn + vo), nsc2 = *(const f32x2*)(bn + 384);
                    float o;
                    asm volatile(
                        "v_pk_mul_f32 v[236:237], %[S0], %[kkl] op_sel_hi:[1,0]\n\t"
                        "v_pk_mul_f32 v[238:239], %[S0], %[wrl] op_sel_hi:[1,0]\n\t"
                        "v_pk_fma_f32 v[236:237], %[S1], %[kkl], v[236:237] op_sel:[0,1,0]\n\t"
                        "v_pk_fma_f32 v[238:239], %[S1], %[wrl], v[238:239] op_sel:[0,1,0]\n\t"
                        "v_pk_fma_f32 v[236:237], %[S2], %[kkh], v[236:237] op_sel_hi:[1,0,1]\n\t"
                        "v_pk_fma_f32 v[238:239], %[S2], %[wrh], v[238:239] op_sel_hi:[1,0,1]\n\t"
                        "v_pk_fma_f32 v[236:237], %[S3], %[kkh], v[236:237] op_sel:[0,1,0]\n\t"
                        "v_pk_fma_f32 v[238:239], %[S3], %[wrh], v[238:239] op_sel:[0,1,0]\n\t"
                        "v_pk_mul_f32 v[244:245], %[S0], %[wl] op_sel_hi:[1,0]\n\t"
                        "v_add_f32_dpp v240, v237, v236 row_ror:8 row_mask:0xf bank_mask:0xf bound_ctrl:1\n\t"
                        "v_add_f32_dpp v242, v239, v238 row_ror:8 row_mask:0xf bank_mask:0xf bound_ctrl:1\n\t"
                        "v_pk_mul_f32 v[246:247], %[S1], %[wl] op_sel:[0,1]\n\t"
                        "v_add_f32_dpp v240, v240, v240 quad_perm:[1,0,3,2] row_mask:0xf bank_mask:0xf bound_ctrl:1\n\t"
                        "v_add_f32_dpp v242, v242, v242 quad_perm:[1,0,3,2] row_mask:0xf bank_mask:0xf bound_ctrl:1\n\t"
                        "v_pk_mul_f32 v[248:249], %[S2], %[wh] op_sel_hi:[1,0]\n\t"
                        "v_add_f32_dpp v240, v240, v240 quad_perm:[2,3,0,1] row_mask:0xf bank_mask:0xf bound_ctrl:1\n\t"
                        "v_add_f32_dpp v242, v242, v242 quad_perm:[2,3,0,1] row_mask:0xf bank_mask:0xf bound_ctrl:1\n\t"
                        "v_pk_mul_f32 v[250:251], %[S3], %[wh] op_sel:[0,1]\n\t"
                        "v_add_f32_dpp v240, v240, v240 row_half_mirror row_mask:0xf bank_mask:0xf bound_ctrl:1\n\t"
                        "v_add_f32_dpp v242, v242, v242 row_half_mirror row_mask:0xf bank_mask:0xf bound_ctrl:1\n\t"
                        "v_pk_fma_f32 v[244:245], %[v2], %[kel], v[244:245] op_sel_hi:[1,0,1]\n\t"
                        "v_mov_b32_dpp v241, v240 row_ror:8 row_mask:0xf bank_mask:0xf bound_ctrl:1\n\t"
                        "v_pk_fma_f32 v[246:247], %[v2], %[kel], v[246:247] op_sel:[0,1,0]\n\t"
                        "v_pk_fma_f32 v[248:249], %[v2], %[keh], v[248:249] op_sel_hi:[1,0,1]\n\t"
                        "v_pk_fma_f32 %[S0], v[240:241], %[abl], v[244:245] op_sel_hi:[1,0,1] neg_lo:[1,0,0] neg_hi:[1,0,0]\n\t"
                        "v_pk_fma_f32 v[250:251], %[v2], %[keh], v[250:251] op_sel:[0,1,0]\n\t"
                        "v_pk_fma_f32 %[S1], v[240:241], %[abl], v[246:247] op_sel:[0,1,0] neg_lo:[1,0,0] neg_hi:[1,0,0]\n\t"
                        "v_fma_f32 v243, -v240, %[br], v242\n\t"
                        "v_pk_fma_f32 %[S2], v[240:241], %[abh], v[248:249] op_sel_hi:[1,0,1] neg_lo:[1,0,0] neg_hi:[1,0,0]\n\t"
                        "v_fma_f32 %[o], %[vx], %[kr], v243\n\t"
                        "v_pk_fma_f32 %[S3], v[240:241], %[abh], v[250:251] op_sel:[0,1,0] neg_lo:[1,0,0] neg_hi:[1,0,0]"
                        : [S0] "+v"(S0), [S1] "+v"(S1), [S2] "+v"(S2), [S3] "+v"(S3), [o] "=&v"(o)
                        : [kkl] "v"(__builtin_shufflevector(kk4, kk4, 0, 1)), [kkh] "v"(__builtin_shufflevector(kk4, kk4, 2, 3)),
                          [wrl] "v"(__builtin_shufflevector(wr4, wr4, 0, 1)), [wrh] "v"(__builtin_shufflevector(wr4, wr4, 2, 3)),
                          [wl] "v"(__builtin_shufflevector(w4, w4, 0, 1)), [wh] "v"(__builtin_shufflevector(w4, w4, 2, 3)),
                          [abl] "v"(__builtin_shufflevector(ab4, ab4, 0, 1)), [abh] "v"(__builtin_shufflevector(ab4, ab4, 2, 3)),
                          [kel] "v"(__builtin_shufflevector(ke4, ke4, 0, 1)), [keh] "v"(__builtin_shufflevector(ke4, ke4, 2, 3)),
                          [v2] "v"(v2), [vx] "v"(v2.x), [br] "v"(sc2.x), [kr] "v"(sc2.y)
                        : "v236", "v237", "v238", "v239", "v240", "v241", "v242", "v243", "v244", "v245", "v246", "v247", "v248", "v249", "v250", "v251");
                    outp[si * 32] = o;
                    kk4 = nkk4; w4 = nw4; ab4 = nab4; ke4 = nke4; wr4 = nwr4; v2 = nv2; sc2 = nsc2;
                }
            }
        }
        __syncthreads();
        if (wid >= 4) flush(NBT - 1);
    }
}
__device__ __forceinline__ void ph_l1_rwmerge(const L1Args& a) {
    const int tid = tid_fresh();
    const int sub = tid >> 7, c4 = (tid & 127) * 4, h = c4 >> 6;
    const f32x4 nw = *(const f32x4*)(a.rw_norm + c4);
    struct In { f32x4 yf, yb, g; u32x2 v; float bon; };
    auto load = [&](int r, In& x) {
        const size_t o = (size_t)r * 512 + c4;
        x.yf = *(const f32x4*)(a.RWO + o); x.yb = *(const f32x4*)(a.RWO + (size_t)NTOK * 512 + o);
        x.g = *(const f32x4*)(a.PG + o); x.v = *(const u32x2*)(a.PV + o); x.bon = a.PBON[(size_t)r * 8 + h];
    };
    const int stride = gridDim.x * 4;
    int r = NCTX + blockIdx.x * 4 + sub;
    In cur, nxt;
    if (r < NTOK) load(r, cur);
    for (; r < NTOK; r += stride) {
        if (r + stride < NTOK) load(r + stride, nxt);
        const f32x4 v = cur.yf + cur.yb;
        float ss = v[0] * v[0] + v[1] * v[1] + v[2] * v[2] + v[3] * v[3];
        ss += __shfl_xor(ss, 1); ss += __shfl_xor(ss, 2); ss += __shfl_xor(ss, 4); ss += __shfl_xor(ss, 8);
        const float rs = rsqrtf(ss * (1.0f / 64.0f) + EPSF);
        const float p0 = __uint_as_float(cur.v.x << 16), p1 = __uint_as_float(cur.v.x & 0xffff0000u), p2 = __uint_as_float(cur.v.y << 16), p3 = __uint_as_float(cur.v.y & 0xffff0000u);
        st_bf16x4(a.MG + (size_t)r * DM + 512 + c4, (v[0] * rs * nw[0] + cur.bon * p0) * cur.g[0], (v[1] * rs * nw[1] + cur.bon * p1) * cur.g[1],
                  (v[2] * rs * nw[2] + cur.bon * p2) * cur.g[2], (v[3] * rs * nw[3] + cur.bon * p3) * cur.g[3]);
        cur = nxt;
    }
}

struct ConvArgs { const float* ab_in; const float* ab_out; const float* cd_in; const float* cd_out; const float* wgu; const float* wdn;
                  bf16_t* ab_inT; bf16_t* ab_outT; bf16_t* cd_inT; bf16_t* cd_outT; bf16_t* wguT; bf16_t* wdnT; };


#define XB_TMO      128
#define XB_XCNT(j)  (256  + 64 * (j))
#define XB_XSUB(j)  (1280 + 64 * (j))
#define XB_XGEN(j)  (2304 + 64 * (j))
#define XB_TOP      3328
#define XB_TOPGEN   3392
#define XCD_BAR_WORDS 3456
#define XB_SPIN_CAP (1u << 18)
#define LAS __attribute__((address_space(3)))

__device__ __forceinline__ unsigned xb_ld(unsigned* p)              { return __hip_atomic_load(p, __ATOMIC_RELAXED, __HIP_MEMORY_SCOPE_AGENT); }
__device__ __forceinline__ unsigned xb_add(unsigned* p, unsigned v) { return __hip_atomic_fetch_add(p, v, __ATOMIC_RELAXED, __HIP_MEMORY_SCOPE_AGENT); }
__device__ __forceinline__ unsigned xb_xcc_id() { return (unsigned)__builtin_amdgcn_s_getreg((3 << 11) | 20) & 0xFu; }
#define XB_SPIN(cond, bar) do { unsigned _sp = 0; while (cond) { __builtin_amdgcn_s_sleep(1); \
    if ((++_sp & 255u) == 0u) { if (xb_ld(&(bar)[XB_TMO])) break; if (_sp > XB_SPIN_CAP) { atomicAdd(&(bar)[XB_TMO], 1u); break; } } } } while (0)

struct XcdBarrier {
    unsigned* bar; unsigned x;
    volatile LAS unsigned* st;
};

__device__ __forceinline__ XcdBarrier xcd_barrier_post(unsigned* bar, volatile LAS unsigned* st) {
    XcdBarrier b; b.bar = bar; b.x = xb_xcc_id(); b.st = st;
    if (threadIdx.x == 0) (void)xb_add(&bar[XB_XCNT(b.x)], 1u);
    return b;
}
__device__ __forceinline__ void xcd_barrier_complete(unsigned* bar, unsigned x, unsigned& nloc, unsigned& nx) {
    const unsigned G = gridDim.x * gridDim.y * gridDim.z;
    unsigned sum, cnt, mine, sp = 0u;
    for (;;) {
        sum = 0u; cnt = 0u; mine = 0u;
#pragma unroll
        for (unsigned j = 0; j < 16; ++j) { const unsigned c = xb_ld(&bar[XB_XCNT(j)]); sum += c; cnt += (c > 0u) ? 1u : 0u; mine = (j == x) ? c : mine; }
        if (sum == G) break;
        __builtin_amdgcn_s_sleep(1);
        if ((++sp & 255u) == 0u) { if (xb_ld(&bar[XB_TMO])) break; if (sp > XB_SPIN_CAP) { atomicAdd(&bar[XB_TMO], 1u); break; } }
    }
    nloc = mine > 0u ? mine : 1u; nx = cnt > 0u ? cnt : 1u;
}

__device__ __forceinline__ void xcd_barrier(const XcdBarrier& b) {
    asm volatile("s_waitcnt vmcnt(0)" ::: "memory");
    __syncthreads();
    if (threadIdx.x == 0) {
        unsigned* bar = b.bar;
        __builtin_amdgcn_s_waitcnt(0);
        unsigned nloc = b.st[0], nx = b.st[1];
        if (nloc == 0u) { xcd_barrier_complete(bar, b.x, nloc, nx); b.st[0] = nloc; b.st[1] = nx; }
        const unsigned old = xb_add(&bar[XB_XSUB(b.x)], 1u);
        const unsigned gen = old / nloc;
        if (old + 1u == (gen + 1u) * nloc) {
            __builtin_amdgcn_fence(__ATOMIC_RELEASE, "agent");
            asm volatile("s_waitcnt vmcnt(0)" ::: "memory");
            const unsigned og = xb_add(&bar[XB_TOP], 1u);
            const unsigned tg = og / nx;
            if (og + 1u == (tg + 1u) * nx) xb_add(&bar[XB_TOPGEN], 1u);
            else XB_SPIN(xb_ld(&bar[XB_TOPGEN]) == tg, bar);
            __builtin_amdgcn_fence(__ATOMIC_ACQUIRE, "agent");
            xb_add(&bar[XB_XGEN(b.x)], 1u);
            asm volatile("s_waitcnt vmcnt(0)" ::: "memory");
        } else {
            XB_SPIN(xb_ld(&bar[XB_XGEN(b.x)]) == gen, bar);
            __builtin_amdgcn_fence(__ATOMIC_ACQUIRE, "agent");
            asm volatile("s_waitcnt vmcnt(0)" ::: "memory");
        }
    }
    __syncthreads();
}


__device__ __forceinline__ void sub_barrier(unsigned* bar, int word, unsigned n) {
    asm volatile("s_waitcnt vmcnt(0)" ::: "memory");
    __syncthreads();
    if (threadIdx.x == 0) {
        __builtin_amdgcn_s_waitcnt(0);
        __builtin_amdgcn_fence(__ATOMIC_RELEASE, "agent");
        asm volatile("s_waitcnt vmcnt(0)" ::: "memory");
        (void)xb_add(&bar[word], 1u);
        XB_SPIN(xb_ld(&bar[word]) < n, bar);
        __builtin_amdgcn_fence(__ATOMIC_ACQUIRE, "agent");
        asm volatile("s_waitcnt vmcnt(0)" ::: "memory");
    }
    __syncthreads();
}

struct FwdParams {
    const float* x; const float* c; const float* ctx; const float* c_ctx; const float* mod_w; const float* mod_b;
    const float* norm_mix; const float* norm_ffn; const float* norm_final;
    const float* router_w; const float* router_b; const float* bgu; const float* bdn;
    float* out;
    unsigned* bar; int* meta;
    float* mvec; float* H; bf16_t* Ub; bf16_t* ZB; float* P; float* Y;
    int* top_e; float* top_w; int* slot_of; int* list;
    float* slot_w;
    bf16_t* ab_inT; bf16_t* ab_outT; bf16_t* cd_inT; bf16_t* cd_outT; bf16_t* wguT; bf16_t* wdnT;
    ConvArgs cv; L0Args l0; L1Args l1;
};
#define LIST_INTS (NTOK * 4 + NEXP * 256)

__device__ __forceinline__ void ph_mod(const FwdParams& p) {
    float* sc = (float*)g_shm;
    float* part = sc + 5 * 1024;
    const int tid = tid_fresh();
    __syncthreads();
    for (int i = tid; i < 5 * 1024; i += NTHR) { const int b = i >> 10, k = i & 1023; sc[i] = siluf_(b < 4 ? p.c[b * 1024 + k] : p.c_ctx[k]); }
    __syncthreads();
    for (int cg = blockIdx.x; cg < 256; cg += gridDim.x) {
        const int colidx0 = cg * 48, layer = colidx0 / 6144, col0 = colidx0 % 6144;
        if (tid < 384) {
            const int cl = tid % 48, kp = tid / 48;
            const float* W = p.mod_w + (size_t)layer * 1024 * 6144 + col0 + cl;
            float a0 = 0.f, a1 = 0.f, a2 = 0.f, a3 = 0.f, a4 = 0.f;
#pragma unroll 8
            for (int k = kp * 128; k < kp * 128 + 128; ++k) {
                const float w = W[(size_t)k * 6144];
                a0 += sc[k] * w; a1 += sc[1024 + k] * w; a2 += sc[2048 + k] * w; a3 += sc[3072 + k] * w; a4 += sc[4096 + k] * w;
            }
            float* pp = part + (kp * 48 + cl) * 5;
            pp[0] = a0; pp[1] = a1; pp[2] = a2; pp[3] = a3; pp[4] = a4;
        }
        __syncthreads();
        if (tid < 240) {
            const int cl = tid / 5, rr = tid % 5;
            float sum = p.mod_b[layer * 6144 + col0 + cl];
#pragma unroll
            for (int kp = 0; kp < 8; ++kp) sum += part[(kp * 48 + cl) * 5 + rr];
            p.mvec[((size_t)layer * 5 + rr) * 6144 + col0 + cl] = sum;
        }
        __syncthreads();
    }
}
__device__ __forceinline__ const float* row_src(const float* src_ctx, const float* src_lat, int r) { return r < NCTX ? src_ctx + (size_t)r * DM : src_lat + (size_t)(r - NCTX) * DM; }
__device__ __forceinline__ int row_mrow(int r) { return r < NCTX ? 4 : (r - NCTX) / TL; }
__device__ __forceinline__ void ph_normmod(const float* src_ctx, const float* src_lat, const float* gain, const float* mvl, int row0, int row1, bf16_t* out) {
    const int tfz = tid_fresh(); const int wid = tfz >> 6, lane = tfz & 63;
    const int stride = gridDim.x * 8;
    int r = row0 + blockIdx.x * 8 + wid;
    float4 x[4], xn[4];
    if (r < row1) { const float4* src = (const float4*)row_src(src_ctx, src_lat, r);
#pragma unroll
        for (int i = 0; i < 4; ++i) x[i] = src[lane + 64 * i]; }
    for (; r < row1; r += stride) {
        const int rn = r + stride;
        if (rn < row1) { const float4* src = (const float4*)row_src(src_ctx, src_lat, rn);
#pragma unroll
            for (int i = 0; i < 4; ++i) xn[i] = src[lane + 64 * i]; }
        const float* mv = mvl + (size_t)row_mrow(r) * 6144;
        float ss = 0.f;
#pragma unroll
        for (int i = 0; i < 4; ++i) ss += x[i].x * x[i].x + x[i].y * x[i].y + x[i].z * x[i].z + x[i].w * x[i].w;
        const float rs = rsqrtf(wave_sum(ss) * (1.0f / DM) + EPSF);
#pragma unroll
        for (int i = 0; i < 4; ++i) {
            const int c4 = lane + 64 * i;
            const float4 g = ((const float4*)gain)[c4], sh = ((const float4*)mv)[c4], sc = ((const float4*)(mv + 1024))[c4];
            st_bf16x4(out + (size_t)r * DM + c4 * 4, x[i].x * rs * g.x * (1.0f + sc.x) + sh.x, x[i].y * rs * g.y * (1.0f + sc.y) + sh.y,
                      x[i].z * rs * g.z * (1.0f + sc.z) + sh.z, x[i].w * rs * g.w * (1.0f + sc.w) + sh.w);
        }
#pragma unroll
        for (int i = 0; i < 4; ++i) x[i] = xn[i];
    }
}
__device__ __forceinline__ void ph_norm_router(const FwdParams& p, int layer, int row0, int row1) {
    float* RW = (float*)g_shm;
    float* lgs = RW + 1024 * 32;
    int* hist = (int*)(lgs + 8 * 32);
    const int tid = tid_fresh(), wid = tid >> 6, lane = tid & 63;
    const float* mvl = p.mvec + (size_t)layer * 5 * 6144;
    const float* gain = p.norm_ffn + layer * DM;
    const float* rw = p.router_w + (size_t)layer * 1024 * 32;
    const float* rb = p.router_b + layer * 32;
    int* meta = p.meta + layer * 128;
    __syncthreads();
    if (tid < 32) hist[tid] = 0;
    for (int i = tid; i < 1024 * 8; i += NTHR) {
        const int k = i >> 3, c8 = i & 7;
        const int i2 = k >> 5, kq = (k >> 2) & 7, c = k & 3;
        *(float4*)(RW + (32 * i2 + 8 * c + kq) * 32 + c8 * 4) = *(const float4*)(rw + k * 32 + c8 * 4);
    }
    __syncthreads();
    const int e4 = lane & 7, kq = lane >> 3;
    const int stride = gridDim.x * 8;
    int r = row0 + blockIdx.x * 8 + wid;
    float4 hn[4];
    if (r < row1) {
#pragma unroll
        for (int i = 0; i < 4; ++i) hn[i] = ((const float4*)(p.H + (size_t)r * DM))[lane + 64 * i]; }
    for (; r < row1; r += stride) {
        const float* mv = mvl + (size_t)row_mrow(r) * 6144;
        float4 hh[4]; float ss = 0.f;
#pragma unroll
        for (int i = 0; i < 4; ++i) {
            hh[i] = hn[i];
            ss += hh[i].x * hh[i].x + hh[i].y * hh[i].y + hh[i].z * hh[i].z + hh[i].w * hh[i].w;
        }
        if (r + stride < row1) {
#pragma unroll
            for (int i = 0; i < 4; ++i) hn[i] = ((const float4*)(p.H + (size_t)(r + stride) * DM))[lane + 64 * i]; }
        const float rs = rsqrtf(wave_sum(ss) * (1.0f / DM) + EPSF);
#pragma unroll
        for (int i = 0; i < 4; ++i) {
            const int c4 = lane + 64 * i;
            const float4 g = ((const float4*)gain)[c4], sh = ((const float4*)(mv + 3072))[c4], sc = ((const float4*)(mv + 4096))[c4];
            hh[i].x = hh[i].x * rs * g.x * (1.0f + sc.x) + sh.x; hh[i].y = hh[i].y * rs * g.y * (1.0f + sc.y) + sh.y;
            hh[i].z = hh[i].z * rs * g.z * (1.0f + sc.z) + sh.z; hh[i].w = hh[i].w * rs * g.w * (1.0f + sc.w) + sh.w;
            st_bf16x4(p.Ub + (size_t)r * DM + c4 * 4, hh[i].x, hh[i].y, hh[i].z, hh[i].w);
        }
        float l0 = 0.f, l1 = 0.f, l2 = 0.f, l3 = 0.f;
#pragma unroll
        for (int i2 = 0; i2 < 32; ++i2) {
            const int srcl = kq + 8 * (i2 & 7);
            const float4 hv = hh[i2 >> 3];
            const float x0 = __shfl(hv.x, srcl), x1 = __shfl(hv.y, srcl), x2 = __shfl(hv.z, srcl), x3 = __shfl(hv.w, srcl);
            const float* wp = RW + (32 * i2 + kq) * 32 + e4 * 4;
            const float4 w0 = *(const float4*)wp, w1 = *(const float4*)(wp + 8 * 32), w2 = *(const float4*)(wp + 16 * 32), w3 = *(const float4*)(wp + 24 * 32);
            l0 += x0 * w0.x + x1 * w1.x + x2 * w2.x + x3 * w3.x;
            l1 += x0 * w0.y + x1 * w1.y + x2 * w2.y + x3 * w3.y;
            l2 += x0 * w0.z + x1 * w1.z + x2 * w2.z + x3 * w3.z;
            l3 += x0 * w0.w + x1 * w1.w + x2 * w2.w + x3 * w3.w;
        }
#pragma unroll
        for (int o = 8; o < 64; o <<= 1) { l0 += __shfl_xor(l0, o); l1 += __shfl_xor(l1, o); l2 += __shfl_xor(l2, o); l3 += __shfl_xor(l3, o); }
        if (lane < 8) { float* lg = lgs + wid * 32 + e4 * 4; lg[0] = l0 + rb[e4 * 4]; lg[1] = l1 + rb[e4 * 4 + 1]; lg[2] = l2 + rb[e4 * 4 + 2]; lg[3] = l3 + rb[e4 * 4 + 3]; }
        float val = (lane < 32) ? lgs[wid * 32 + lane] : -INFINITY;
        float tv[4]; int ti[4];
#pragma unroll
        for (int k = 0; k < 4; ++k) {
            float bv = val; int bi = lane;
#pragma unroll
            for (int o = 1; o < 64; o <<= 1) {
                const float ov = __shfl_xor(bv, o); const int oi = __shfl_xor(bi, o);
                if (ov > bv || (ov == bv && oi < bi)) { bv = ov; bi = oi; }
            }
            tv[k] = bv; ti[k] = bi;
            if (lane == bi) val = -INFINITY;
        }
        const float w0 = 1.0f, w1 = expf(tv[1] - tv[0]), w2 = expf(tv[2] - tv[0]), w3 = expf(tv[3] - tv[0]);
        const float inv = 1.0f / (w0 + w1 + w2 + w3);
        if (lane == 0) {
            *(int4*)(p.top_e + (size_t)r * 4) = make_int4(ti[0], ti[1], ti[2], ti[3]);
            *(float4*)(p.top_w + (size_t)r * 4) = make_float4(w0 * inv, w1 * inv, w2 * inv, w3 * inv);
            atomicAdd(&hist[ti[0]], 1); atomicAdd(&hist[ti[1]], 1); atomicAdd(&hist[ti[2]], 1); atomicAdd(&hist[ti[3]], 1);
        }
    }
    __syncthreads();
    if (tid < 32 && hist[tid] != 0) atomicAdd(&meta[tid], hist[tid]);
}
__device__ __forceinline__ void ph_assign(const FwdParams& p, int layer, int row0, int row1) {
    int* hist = (int*)g_shm; int* base = hist + 32; int* lcur = base + 32;
    const int tid = tid_fresh();
    int* meta = p.meta + layer * 128;
    int* list = p.list + (size_t)layer * LIST_INTS;
    __syncthreads();
    if (tid < 32) { hist[tid] = 0; lcur[tid] = 0; }
    __syncthreads();
    const int npairs = (row1 - row0) * 4;
    for (int i = blockIdx.x * NTHR + tid; i < npairs; i += gridDim.x * NTHR) atomicAdd(&hist[p.top_e[(size_t)row0 * 4 + i]], 1);
    __syncthreads();
    if (tid < 32) {
        int off = 0;
        for (int e = 0; e < tid; ++e) off += (meta[e] + 255) & ~255;
        if (blockIdx.x == 0) meta[64 + tid] = off;
        base[tid] = off + (hist[tid] ? atomicAdd(&meta[32 + tid], hist[tid]) : 0);
    }
    __syncthreads();
    for (int i = blockIdx.x * NTHR + tid; i < npairs; i += gridDim.x * NTHR) {
        const int e = p.top_e[(size_t)row0 * 4 + i];
        const int slot = base[e] + atomicAdd(&lcur[e], 1);
        list[slot] = row0 + (i >> 2);
        p.slot_of[(size_t)row0 * 4 + i] = slot;
        p.slot_w[slot] = p.top_w[(size_t)row0 * 4 + i];
    }
}
template <bool FINAL>
__device__ __forceinline__ void ph_combine(const FwdParams& p, int layer, int row0, int row1) {
    const int tfz = tid_fresh(); const int wid = tfz >> 6, lane = tfz & 63;
    const float* mvl = p.mvec + (size_t)layer * 5 * 6144;
    const bf16_t* YS = (const bf16_t*)p.P;
    const int stride = gridDim.x * 8;
    int r = row0 + blockIdx.x * 8 + wid;
    int4 sl_n = make_int4(0, 0, 0, 0);
    u32x2 ya[4][4], yn[4][4]; float4 ha[4], hnx[4]; float4 twa = make_float4(0.f, 0.f, 0.f, 0.f), twn = twa;
    auto load_rows = [&](int rr, const int4& sl, u32x2 (&y)[4][4], float4 (&h)[4], float4& tw) {
        tw = *(const float4*)(p.top_w + (size_t)rr * 4);
#pragma unroll
        for (int i = 0; i < 4; ++i) {
            const int c4 = lane + 64 * i;
            y[0][i] = *(const u32x2*)(YS + (size_t)sl.x * DM + c4 * 4); y[1][i] = *(const u32x2*)(YS + (size_t)sl.y * DM + c4 * 4);
            y[2][i] = *(const u32x2*)(YS + (size_t)sl.z * DM + c4 * 4); y[3][i] = *(const u32x2*)(YS + (size_t)sl.w * DM + c4 * 4);
            h[i] = ((const float4*)(p.H + (size_t)rr * DM))[c4];
        }
    };
    if (r < row1) {
        const int4 sl0 = *(const int4*)(p.slot_of + (size_t)r * 4);
        load_rows(r, sl0, ya, ha, twa);
        if (r + stride < row1) sl_n = *(const int4*)(p.slot_of + (size_t)(r + stride) * 4);
    }
    for (; r < row1; r += stride) {
        const int rn = r + stride;
        if (rn < row1) {
            load_rows(rn, sl_n, yn, hnx, twn);
            if (rn + stride < row1) sl_n = *(const int4*)(p.slot_of + (size_t)(rn + stride) * 4);
        }
        const float* mv = mvl + (size_t)row_mrow(r) * 6144;
        float4 hh[4]; float ss = 0.f;
#pragma unroll
        for (int i = 0; i < 4; ++i) {
            const int c4 = lane + 64 * i;
            float ys4[4];
#pragma unroll
            for (int x = 0; x < 4; ++x) {
                float acc = 0.f;
                const float tw4[4] = {twa.x, twa.y, twa.z, twa.w};
#pragma unroll
                for (int k = 0; k < 4; ++k) { const unsigned w = x < 2 ? ya[k][i].x : ya[k][i].y; acc += tw4[k] * __uint_as_float((x & 1) ? (w & 0xffff0000u) : (w << 16)); }
                ys4[x] = acc;
            }
            const float4 gt = ((const float4*)(mv + 5120))[c4];
            float4 h = ha[i];
            h.x += gt.x * ys4[0]; h.y += gt.y * ys4[1]; h.z += gt.z * ys4[2]; h.w += gt.w * ys4[3];
            hh[i] = h;
            if (!FINAL) ((float4*)(p.H + (size_t)r * DM))[c4] = h;
            ss += h.x * h.x + h.y * h.y + h.z * h.z + h.w * h.w;
        }
        const float rs = rsqrtf(wave_sum(ss) * (1.0f / DM) + EPSF);
        if (FINAL) {
#pragma unroll
            for (int i = 0; i < 4; ++i) {
                const int c4 = lane + 64 * i;
                const float4 g = ((const float4*)p.norm_final)[c4];
                ((float4*)(p.out + (size_t)(r - NCTX) * DM))[c4] = make_float4(hh[i].x * rs * g.x, hh[i].y * rs * g.y, hh[i].z * rs * g.z, hh[i].w * rs * g.w);
            }
        } else {
            const float* mv1 = p.mvec + (size_t)(layer + 1) * 5 * 6144 + (size_t)row_mrow(r) * 6144;
            const float* gain = p.norm_mix + (layer + 1) * DM;
#pragma unroll
            for (int i = 0; i < 4; ++i) {
                const int c4 = lane + 64 * i;
                const float4 g = ((const float4*)gain)[c4], sh = ((const float4*)mv1)[c4], sc = ((const float4*)(mv1 + 1024))[c4];
                st_bf16x4(p.Ub + (size_t)r * DM + c4 * 4, hh[i].x * rs * g.x * (1.0f + sc.x) + sh.x, hh[i].y * rs * g.y * (1.0f + sc.y) + sh.y,
                          hh[i].z * rs * g.z * (1.0f + sc.z) + sh.z, hh[i].w * rs * g.w * (1.0f + sc.w) + sh.w);
            }
        }
#pragma unroll
        for (int k = 0; k < 4; ++k)
#pragma unroll
            for (int i = 0; i < 4; ++i) ya[k][i] = yn[k][i];
#pragma unroll
        for (int i = 0; i < 4; ++i) ha[i] = hnx[i];
        twa = twn;
    }
}

__global__ void __launch_bounds__(NTHR, 2) k_fwd(FwdParams p) {
    volatile LAS unsigned* xbw = (volatile LAS unsigned*)(g_shm + LDS_BYTES - 16);
    if (threadIdx.x == 0) { xbw[0] = 0u; xbw[1] = 0u; xbw[2] = 0u; xbw[3] = 0u; }
    __syncthreads();
    XcdBarrier bar = xcd_barrier_post(p.bar, xbw);
    {
        int base = 0;
        const int bi = blockIdx.x, nb = gridDim.x;
        base = convert_matrix<2>(p.cv.ab_in, AB_IN, 3328, p.cv.ab_inT, base, bi, nb);
        base = convert_matrix<0>(p.cv.ab_out, 1024, 1024, p.cv.ab_outT, base, bi, nb);
        base = convert_matrix<2>(p.cv.cd_in, CD_IN, 4608, p.cv.cd_inT, base, bi, nb);
        base = convert_matrix<0>(p.cv.cd_out, 1024, 1024, p.cv.cd_outT, base, bi, nb);
        convert_experts(p.cv.wgu, p.cv.wdn, p.cv.wguT, p.cv.wdnT, 0, NEXP, bi, nb);
        ph_mod(p);
        ph_l1_wlr(p.l1);
    }
    xcd_barrier(bar);
    ph_normmod(p.ctx, p.x, p.norm_mix, p.mvec, 0, NTOK, p.Ub);
    xcd_barrier(bar);
    ph_gemm_bf16out(p.Ub, 0, NTOK, p.ab_inT, AB_IN, 3328, p.ZB, AB_IN);
    xcd_barrier(bar);
    ph_l0_prep(p.l0);
    xcd_barrier(bar);
    ph_l0_local(p.l0);
    xcd_barrier(bar);
    ph_l0_prop(p.l0);
    xcd_barrier(bar);
    ph_l0_out(p.l0);
    xcd_barrier(bar);
    ph_gemm_resid(p.Ub, 0, NTOK, p.ab_outT, p.ctx, p.x, p.mvec + 2048, p.H);
    xcd_barrier(bar);
    ph_norm_router(p, 0, 0, NTOK);
    xcd_barrier(bar);
    ph_assign(p, 0, 0, NTOK);
    xcd_barrier(bar);
    ph_moe_gu(p.Ub, p.meta, p.list, p.wguT, p.bgu, p.ZB);
    xcd_barrier(bar);
    ph_moe_dn(p.ZB, p.meta, p.wdnT, p.bdn, (bf16_t*)p.P, p.slot_w);
    xcd_barrier(bar);
    ph_combine<false>(p, 0, 0, NTOK);
    xcd_barrier(bar);
    ph_gemm_bf16out(p.Ub, 0, NTOK, p.cd_inT, CD_IN, 4608, p.ZB, CD_IN);
    xcd_barrier(bar);
    ph_l1_rwprep(p.l1);
    xcd_barrier(bar);
    {
        const int nrw = (int)gridDim.x >> 1;
        if ((int)blockIdx.x < nrw) ph_l1_rwkv2(p.l1, blockIdx.x, nrw);
        else {
            const int bi = (int)blockIdx.x - nrw, nb = (int)gridDim.x - nrw;
            ph_l1_local(p.l1, bi, nb);
            sub_barrier(p.bar, 0, (unsigned)nb);
            ph_l1_prop(p.l1, bi, nb);
            sub_barrier(p.bar, 64, (unsigned)nb);
            ph_l1_out(p.l1, bi, nb);
            convert_experts(p.cv.wgu, p.cv.wdn, p.cv.wguT, p.cv.wdnT, NEXP, 2 * NEXP, bi, nb);
            ph_l1_gate(p.l1, bi, nb);
        }
    }
    xcd_barrier(bar);
    ph_l1_rwmerge(p.l1);
    xcd_barrier(bar);
    ph_gemm_resid(p.Ub, NCTX, NLAT, p.cd_outT, p.H, p.H + (size_t)NCTX * DM, p.mvec + 5 * 6144 + 2048, p.H);
    xcd_barrier(bar);
    ph_norm_router(p, 1, NCTX, NTOK);
    xcd_barrier(bar);
    ph_assign(p, 1, NCTX, NTOK);
    xcd_barrier(bar);
    ph_moe_gu(p.Ub, p.meta + 128, p.list + LIST_INTS, p.wguT + (size_t)NEXP * 2048 * 1024, p.bgu + NEXP * 2048, p.ZB);
    xcd_barrier(bar);
    ph_moe_dn(p.ZB, p.meta + 128, p.wdnT + (size_t)NEXP * 1024 * 1024, p.bdn + NEXP * 1024, (bf16_t*)p.P, p.slot_w);
    xcd_barrier(bar);
    ph_combine<true>(p, 1, NCTX, NTOK);
}

extern "C" void kernel_launch(void* const* d_in, const int* in_sizes, int n_in, void* d_out, int out_size, void* d_ws, size_t ws_size,
                              hipStream_t stream) {
    const size_t NT1024 = (size_t)NTOK * 1024, NT512 = (size_t)NTOK * 512;
    char* wp = (char*)d_ws;
    auto carve = [&](size_t bytes) { char* q = wp; wp += (bytes + 255) & ~(size_t)255; return q; };
    const size_t CTL_BYTES = (size_t)XCD_BAR_WORDS * 4 + 256 * 4 + (size_t)2 * LIST_INTS * 4;
    char* ctl = carve(CTL_BYTES);
    unsigned* bar = (unsigned*)ctl;
    int* meta = (int*)(ctl + (size_t)XCD_BAR_WORDS * 4);
    int* list = (int*)(ctl + (size_t)XCD_BAR_WORDS * 4 + 256 * 4);
    FwdParams p{};
    p.x = (const float*)d_in[0]; p.c = (const float*)d_in[1]; p.ctx = (const float*)d_in[2]; p.c_ctx = (const float*)d_in[3];
    p.mod_w = (const float*)d_in[4]; p.mod_b = (const float*)d_in[5]; p.norm_mix = (const float*)d_in[6]; p.norm_ffn = (const float*)d_in[7];
    p.norm_final = (const float*)d_in[8];
    p.router_w = (const float*)d_in[30]; p.router_b = (const float*)d_in[31]; p.bgu = (const float*)d_in[33]; p.bdn = (const float*)d_in[35];
    p.out = (float*)d_out;
    p.bar = bar; p.meta = meta; p.list = list;
    p.mvec = (float*)carve((size_t)2 * 5 * 6144 * 4);
    p.ab_inT = (bf16_t*)carve((size_t)3328 * 1024 * 2);
    p.ab_outT = (bf16_t*)carve((size_t)1024 * 1024 * 2);
    p.cd_inT = (bf16_t*)carve((size_t)4608 * 1024 * 2);
    p.cd_outT = (bf16_t*)carve((size_t)1024 * 1024 * 2);
    p.wguT = (bf16_t*)carve((size_t)2 * NEXP * 2048 * 1024 * 2);
    p.wdnT = (bf16_t*)carve((size_t)2 * NEXP * 1024 * 1024 * 2);
    p.H = (float*)carve(NT1024 * 4);
    p.Ub = (bf16_t*)carve(NT1024 * 2);
    p.ZB = (bf16_t*)carve((size_t)NTOK * CD_IN * 2);
    const size_t P_BYTES = (size_t)805306368;
    p.P = (float*)carve(P_BYTES);
    float* O = (float*)carve(NT512 * 4 * 4);
    p.Y = O;
    p.top_e = (int*)carve((size_t)NTOK * 4 * 4);
    p.top_w = (float*)carve((size_t)NTOK * 4 * 4);
    p.slot_of = (int*)carve((size_t)NTOK * 4 * 4);
    bf16_t* WLR = (bf16_t*)carve((size_t)196608 * 2);
    p.slot_w = (float*)carve((size_t)LIST_INTS * 4);
    if ((size_t)(wp - (char*)d_ws) > ws_size) return;

    p.cv.ab_in = (const float*)d_in[9]; p.cv.ab_out = (const float*)d_in[10]; p.cv.cd_in = (const float*)d_in[16]; p.cv.cd_out = (const float*)d_in[17];
    p.cv.wgu = (const float*)d_in[32]; p.cv.wdn = (const float*)d_in[34];
    p.cv.ab_inT = p.ab_inT; p.cv.ab_outT = p.ab_outT; p.cv.cd_inT = p.cd_inT; p.cv.cd_outT = p.cd_outT; p.cv.wguT = p.wguT; p.cv.wdnT = p.wdnT;
    {
        char* pp = (char*)p.P;
        auto sub = [&](size_t bytes) { char* q = pp; pp += (bytes + 255) & ~(size_t)255; return q; };
        L0Args& a = p.l0;
        a.z = p.ZB; a.ml_conv = (const float*)d_in[13]; a.gate_b = (const float*)d_in[14]; a.ret_decay = (const float*)d_in[11];
        a.ret_norm = (const float*)d_in[12]; a.ml_norm = (const float*)d_in[15];
        a.RQ = (bf16_t*)sub((size_t)NTOK * 256 * 2); a.RK = (bf16_t*)sub((size_t)NTOK * 256 * 2);
        a.MQ = (bf16_t*)sub((size_t)NTOK * 256 * 2); a.MK = (bf16_t*)sub((size_t)NTOK * 256 * 2);
        a.LIF = (float*)sub((size_t)NTOK * 16 * 4);
        a.ST = (bf16_t*)sub((size_t)16 * NCHUNK * REC * 2);
        a.CM = (float*)sub((size_t)8 * NCHUNK * 2 * 4);
        a.MI = (float*)sub((size_t)8 * NCHUNK * 4);
        a.MG = p.Ub;
        if ((size_t)(pp - (char*)p.P) > P_BYTES) return;
    }
    {
        char* pp = (char*)p.P;
        auto sub = [&](size_t bytes) { char* q = pp; pp += (bytes + 255) & ~(size_t)255; return q; };
        L1Args& a = p.l1;
        a.z = p.ZB; a.hgrn_lb = (const float*)d_in[18]; a.hg_norm = (const float*)d_in[19];
        a.HST = (bf16_t*)sub((size_t)8 * NCHUNK * HREC * 2);
        a.HDEC = (float*)sub((size_t)8 * NCHUNK * 128 * 4);
        a.MG = p.Ub;
        a.shift = (const float*)d_in[20]; a.w0 = (const float*)d_in[21]; a.w2 = (const float*)d_in[22]; a.a0 = (const float*)d_in[23];
        a.a2 = (const float*)d_in[24]; a.g2 = (const float*)d_in[25]; a.kk_scale = (const float*)d_in[26]; a.k_a = (const float*)d_in[27];
        a.r_k = (const float*)d_in[28]; a.rw_norm = (const float*)d_in[29];
        a.PKK = (bf16_t*)sub(NT512 * 2); a.PV = (bf16_t*)sub(NT512 * 2);
        a.PG = (float*)sub(NT512 * 4);
        a.PW = (float*)sub(NT512 * 2 * 4);
        a.PAB = (bf16_t*)sub(NT512 * 2 * 2); a.PKE = (bf16_t*)sub(NT512 * 2 * 2); a.PWR = (bf16_t*)sub(NT512 * 2 * 2);
        a.PSC = (float*)sub((size_t)2 * NTOK * 16 * 4);
        a.PBON = (float*)sub((size_t)NTOK * 8 * 4);
        a.RWO = O; a.WLR = WLR;
        if ((size_t)(pp - (char*)p.P) > P_BYTES) return;
    }
    static int grid = 0;
    if (grid == 0) {
        int dev = 0, cus = 0;
        if (hipGetDevice(&dev) != hipSuccess || hipDeviceGetAttribute(&cus, hipDeviceAttributeMultiprocessorCount, dev) != hipSuccess) { grid = -1; return; }
        if (hipFuncSetAttribute((const void*)k_fwd, hipFuncAttributeMaxDynamicSharedMemorySize, LDS_BYTES) != hipSuccess) { grid = -1; return; }
        int per_cu = 0;
        if (hipOccupancyMaxActiveBlocksPerMultiprocessor(&per_cu, (const void*)k_fwd, NTHR, LDS_BYTES) != hipSuccess || per_cu < 1) { (void)hipGetLastError(); }
        grid = cus > 0 ? cus : 256;
    }
    if (grid < 0) return;
    (void)hipMemsetAsync(ctl, 0, CTL_BYTES, stream);
    k_fwd<<<grid, NTHR, LDS_BYTES, stream>>>(p);
}
```
